# Optimizing an MI355X kernel written in HIP

```python
import math
import jax, jax.numpy as jnp
from jax import lax
import numpy as np

D_MODEL = 1024
BATCH = 4
SEQ = 4096
DEPTH = 1

EPS = 1e-6
MLA_HEADS = 8
QK_NOPE = 64
QK_ROPE = 32
QK_HEAD = QK_NOPE + QK_ROPE
V_HEAD = 64
Q_LORA = 256
KV_LORA = 128
ROPE_THETA = 10000.0
Q_BLOCK = 128
RWKV_HEADS = 8
RWKV_HEAD = 64
RWKV_DIM = RWKV_HEADS * RWKV_HEAD
DECAY_LORA = 64
AAA_LORA = 64
GATE_LORA = 128
GN_EPS = 64e-5
PEER_HEADS = 8
N_KEYS = 128
N_EXPERTS = N_KEYS * N_KEYS
D_KEY = 256
HALF_KEY = D_KEY // 2
TOPK_HALF = 16
TOPK = 16
PEER_BLOCK = 64
N_BRANCH = 2
MLA_IN = Q_LORA + KV_LORA + QK_ROPE
RWKV_IN = 3 * RWKV_DIM + DECAY_LORA + AAA_LORA + GATE_LORA
GATE_IN = N_BRANCH * D_MODEL
IN_DIM = MLA_IN + RWKV_IN + GATE_IN
N_MOD = 6

kernel_name = "hybrid_mla_rwkv7_peer_adaln_block"


def rms_norm(x, g, eps=EPS):
    xf = x.astype(jnp.float32)
    y = xf * lax.rsqrt(jnp.mean(xf * xf, axis=-1, keepdims=True) + eps)
    return (y * g.astype(jnp.float32)).astype(x.dtype)


def modulate(h, shift, scale):
    return h * (1.0 + scale[:, None, :]) + shift[:, None, :]


def rope(x, positions):
    half = x.shape[-1] // 2
    inv_freq = ROPE_THETA ** (-jnp.arange(half, dtype=jnp.float32) / half)
    ang = positions.astype(jnp.float32)[..., None] * inv_freq
    cos = jnp.cos(ang)[:, :, None, :]
    sin = jnp.sin(ang)[:, :, None, :]
    xf = x.astype(jnp.float32)
    x1, x2 = xf[..., :half], xf[..., half:]
    return jnp.concatenate([x1 * cos - x2 * sin, x1 * sin + x2 * cos], axis=-1).astype(x.dtype)


def causal_block_attention(q, k, v):
    B, S, H, Dq = q.shape
    nb = S // Q_BLOCK
    scale = Dq ** -0.5
    qb = q.reshape(B, nb, Q_BLOCK, H, Dq).transpose(1, 0, 2, 3, 4)
    kpos = jnp.arange(S)

    def one_block(args):
        i, q_blk = args
        s = jnp.einsum('bqhd,bkhd->bhqk', q_blk, k).astype(jnp.float32) * scale
        qpos = i * Q_BLOCK + jnp.arange(Q_BLOCK)
        mask = kpos[None, :] <= qpos[:, None]
        s = jnp.where(mask[None, None], s, -jnp.inf)
        p = jax.nn.softmax(s, axis=-1).astype(v.dtype)
        return jnp.einsum('bhqk,bkhd->bqhd', p, v)

    out = lax.map(one_block, (jnp.arange(nb), qb))
    return out.transpose(1, 0, 2, 3, 4).reshape(B, S, H, v.shape[-1])


def mla_branch(q_a, kv_a, k_rope_raw, positions, q_a_norm, w_uq, kv_a_norm, w_ukv, q_norm, k_norm, w_o_mla):
    B, S, _ = q_a.shape
    cq = rms_norm(q_a, q_a_norm)
    q = (cq @ w_uq).reshape(B, S, MLA_HEADS, QK_HEAD)
    ckv = rms_norm(kv_a, kv_a_norm)
    kv = (ckv @ w_ukv).reshape(B, S, MLA_HEADS, QK_NOPE + V_HEAD)
    k_nope, v = kv[..., :QK_NOPE], kv[..., QK_NOPE:]
    q_nope = rms_norm(q[..., :QK_NOPE], q_norm[:QK_NOPE])
    q_pe = rope(rms_norm(q[..., QK_NOPE:], q_norm[QK_NOPE:]), positions)
    k_nope = rms_norm(k_nope, k_norm[:QK_NOPE])
    k_pe = rope(rms_norm(k_rope_raw[:, :, None, :], k_norm[QK_NOPE:]), positions)
    k_pe = jnp.broadcast_to(k_pe, (B, S, MLA_HEADS, QK_ROPE))
    qh = jnp.concatenate([q_nope, q_pe], axis=-1)
    kh = jnp.concatenate([k_nope, k_pe], axis=-1)
    o = causal_block_attention(qh, kh, v)
    return o.reshape(B, S, MLA_HEADS * V_HEAD) @ w_o_mla


def token_shift(p, mu):
    prev = jnp.pad(p, ((0, 0), (1, 0), (0, 0)))[:, :-1]
    return p + (prev - p) * mu


def rwkv7_scan(r, decay, k, v, kk, a):
    B, S, H, N = r.shape
    b = kk * a

    def step(state, inp):
        r_t, w_t, k_t, v_t, kk_t, b_t = inp
        sa = jnp.einsum('bhvk,bhk->bhv', state, -kk_t)
        state = (state * w_t[:, :, None, :] + sa[..., None] * b_t[:, :, None, :]
                 + v_t[..., None] * k_t[:, :, None, :])
        y = jnp.einsum('bhvk,bhk->bhv', state, r_t)
        return state, y

    xs = tuple(t.transpose(1, 0, 2, 3) for t in (r, decay, k, v, kk, b))
    s0 = jnp.zeros((B, H, N, N), jnp.float32)
    _, y = lax.scan(step, s0, xs)
    return y.transpose(1, 0, 2, 3)


def rwkv7_branch(p, mu_shift, w_decay_up, decay_base, w_aaa_up, aaa_base, w_gate_up,
                 k_k, k_a, r_k, ln_x_w, ln_x_b, w_o_rwkv):
    B, S, _ = p.shape
    p = token_shift(p, mu_shift)
    splits = [RWKV_DIM, 2 * RWKV_DIM, 3 * RWKV_DIM, 3 * RWKV_DIM + DECAY_LORA,
              3 * RWKV_DIM + DECAY_LORA + AAA_LORA]
    r, k, v, wd, ad, gd = jnp.split(p, splits, axis=-1)
    w = -jax.nn.softplus(-(decay_base + jnp.tanh(wd) @ w_decay_up)) - 0.5
    decay = jnp.exp(-jnp.exp(w.astype(jnp.float32)))
    a = jax.nn.sigmoid(aaa_base + ad @ w_aaa_up)
    g = jax.nn.sigmoid(gd) @ w_gate_up

    def heads(t):
        return t.reshape(B, S, RWKV_HEADS, RWKV_HEAD).astype(jnp.float32)

    kk = heads(k * k_k)
    kk = kk / jnp.maximum(jnp.linalg.norm(kk, axis=-1, keepdims=True), 1e-12)
    a_h = heads(a)
    k_h = heads(k) * (1.0 + (a_h - 1.0) * k_a.reshape(RWKV_HEADS, RWKV_HEAD).astype(jnp.float32))
    r_h, v_h = heads(r), heads(v)
    y = rwkv7_scan(r_h, heads(decay), k_h, v_h, kk, a_h)
    mu = jnp.mean(y, axis=-1, keepdims=True)
    var = jnp.mean(jnp.square(y - mu), axis=-1, keepdims=True)
    y = (y - mu) * lax.rsqrt(var + GN_EPS)
    y = y * ln_x_w.reshape(RWKV_HEADS, RWKV_HEAD) + ln_x_b.reshape(RWKV_HEADS, RWKV_HEAD)
    y = y + jnp.sum(r_h * k_h * r_k, axis=-1, keepdims=True) * v_h
    y = y.reshape(B, S, RWKV_DIM).astype(p.dtype) * g
    return y @ w_o_rwkv


def token_mixer(h, positions, w_in, mu_shift, q_a_norm, w_uq, kv_a_norm, w_ukv, q_norm, k_norm, w_o_mla,
                w_decay_up, decay_base, w_aaa_up, aaa_base, w_gate_up, k_k, k_a, r_k, ln_x_w, ln_x_b,
                w_o_rwkv, w_out):
    proj = h @ w_in
    q_a, kv_a, k_rope_raw, rwkv_in, gate_logits = jnp.split(
        proj, [Q_LORA, Q_LORA + KV_LORA, MLA_IN, MLA_IN + RWKV_IN], axis=-1)
    o_mla = mla_branch(q_a, kv_a, k_rope_raw, positions, q_a_norm, w_uq, kv_a_norm, w_ukv,
                       q_norm, k_norm, w_o_mla)
    o_rwkv = rwkv7_branch(rwkv_in, mu_shift, w_decay_up, decay_base, w_aaa_up, aaa_base, w_gate_up,
                          k_k, k_a, r_k, ln_x_w, ln_x_b, w_o_rwkv)
    g_mla, g_rwkv = jnp.split(jax.nn.sigmoid(gate_logits), 2, axis=-1)
    return (g_mla * o_mla + g_rwkv * o_rwkv) @ w_out


def peer_ffn(h, w_query, sub_keys1, sub_keys2, expert_down, expert_up):
    B, S, D = h.shape
    q = (h @ w_query).reshape(B, S, PEER_HEADS, 2, HALF_KEY)
    s1 = jnp.einsum('bshd,nd->bshn', q[..., 0, :], sub_keys1).astype(jnp.float32)
    s2 = jnp.einsum('bshd,nd->bshn', q[..., 1, :], sub_keys2).astype(jnp.float32)
    v1, i1 = lax.top_k(s1, TOPK_HALF)
    v2, i2 = lax.top_k(s2, TOPK_HALF)
    cand = (v1[..., :, None] + v2[..., None, :]).reshape(B, S, PEER_HEADS, TOPK_HALF * TOPK_HALF)
    cand_idx = (i1[..., :, None] * N_KEYS + i2[..., None, :]).reshape(B, S, PEER_HEADS, TOPK_HALF * TOPK_HALF)
    top_v, pos = lax.top_k(cand, TOPK)
    expert_idx = jnp.take_along_axis(cand_idx, pos, axis=-1)
    gates = jax.nn.softmax(top_v, axis=-1).astype(h.dtype)
    nb = S // PEER_BLOCK
    hb = h.reshape(B, nb, PEER_BLOCK, D).transpose(1, 0, 2, 3)
    idxb = expert_idx.reshape(B, nb, PEER_BLOCK, PEER_HEADS, TOPK).transpose(1, 0, 2, 3, 4)
    gb = gates.reshape(B, nb, PEER_BLOCK, PEER_HEADS, TOPK).transpose(1, 0, 2, 3, 4)

    def one_block(args):
        h_blk, idx_blk, g_blk = args
        u = jnp.take(expert_down, idx_blk, axis=0)
        act = jax.nn.gelu(jnp.einsum('bpd,bphkd->bphk', h_blk, u))
        vv = jnp.take(expert_up, idx_blk, axis=0)
        return jnp.einsum('bphk,bphkd->bpd', g_blk * act, vv)

    out = lax.map(one_block, (hb, idxb, gb))
    return out.transpose(1, 0, 2, 3).reshape(B, S, D)


def setup_inputs(seed: int = 0) -> dict:
    key = jax.random.key(seed)
    ks = jax.random.split(key, 40)
    f32 = jnp.float32

    def nrm(k, shape, scale):
        return jax.random.normal(k, (DEPTH,) + shape, f32) * scale

    def gain(k, shape):
        return 1.0 + 0.1 * jax.random.normal(k, (DEPTH,) + shape, f32)

    x = jax.random.normal(ks[0], (BATCH, SEQ, D_MODEL), f32)
    c = jax.random.normal(ks[1], (BATCH, D_MODEL), f32)
    offsets = jax.random.randint(ks[2], (BATCH, 1), 0, 1024, dtype=jnp.int32)
    positions = offsets + jnp.arange(SEQ, dtype=jnp.int32)[None, :]
    return {
        "x": x, "c": c, "positions": positions,
        "w_ada": nrm(ks[3], (D_MODEL, N_MOD * D_MODEL), 0.3 * D_MODEL ** -0.5),
        "b_ada": nrm(ks[4], (N_MOD * D_MODEL,), 0.05),
        "norm_mix": gain(ks[5], (D_MODEL,)),
        "w_in": nrm(ks[6], (D_MODEL, IN_DIM), D_MODEL ** -0.5),
        "mu_shift": jax.random.uniform(ks[7], (DEPTH, RWKV_IN), f32),
        "q_a_norm": gain(ks[8], (Q_LORA,)),
        "w_uq": nrm(ks[9], (Q_LORA, MLA_HEADS * QK_HEAD), Q_LORA ** -0.5),
        "kv_a_norm": gain(ks[10], (KV_LORA,)),
        "w_ukv": nrm(ks[11], (KV_LORA, MLA_HEADS * (QK_NOPE + V_HEAD)), KV_LORA ** -0.5),
        "q_norm": gain(ks[12], (QK_HEAD,)),
        "k_norm": gain(ks[13], (QK_HEAD,)),
        "w_o_mla": nrm(ks[14], (MLA_HEADS * V_HEAD, D_MODEL), (MLA_HEADS * V_HEAD) ** -0.5),
        "w_decay_up": nrm(ks[15], (DECAY_LORA, RWKV_DIM), 0.1),
        "decay_base": jax.random.uniform(ks[16], (DEPTH, RWKV_DIM), f32, -6.0, 2.0),
        "w_aaa_up": nrm(ks[17], (AAA_LORA, RWKV_DIM), 0.1),
        "aaa_base": nrm(ks[18], (RWKV_DIM,), 0.5),
        "w_gate_up": nrm(ks[19], (GATE_LORA, RWKV_DIM), GATE_LORA ** -0.5),
        "k_k": 0.85 + nrm(ks[20], (RWKV_DIM,), 0.1),
        "k_a": gain(ks[21], (RWKV_DIM,)),
        "r_k": nrm(ks[22], (RWKV_HEADS, RWKV_HEAD), 0.1),
        "ln_x_w": gain(ks[23], (RWKV_DIM,)),
        "ln_x_b": nrm(ks[24], (RWKV_DIM,), 0.02),
        "w_o_rwkv": nrm(ks[25], (RWKV_DIM, D_MODEL), RWKV_DIM ** -0.5),
        "w_out": nrm(ks[26], (D_MODEL, D_MODEL), D_MODEL ** -0.5),
        "norm_ffn": gain(ks[27], (D_MODEL,)),
        "w_query": nrm(ks[28], (D_MODEL, PEER_HEADS * D_KEY), D_MODEL ** -0.5),
        "sub_keys1": nrm(ks[29], (N_KEYS, HALF_KEY), HALF_KEY ** -0.5),
        "sub_keys2": nrm(ks[30], (N_KEYS, HALF_KEY), HALF_KEY ** -0.5),
        "expert_down": nrm(ks[31], (N_EXPERTS, D_MODEL), D_MODEL ** -0.5),
        "expert_up": nrm(ks[32], (N_EXPERTS, D_MODEL), PEER_HEADS ** -0.5),
    }


def reference(x, c, positions, w_ada, b_ada, norm_mix, w_in, mu_shift, q_a_norm, w_uq, kv_a_norm, w_ukv,
              q_norm, k_norm, w_o_mla, w_decay_up, decay_base, w_aaa_up, aaa_base, w_gate_up, k_k, k_a, r_k,
              ln_x_w, ln_x_b, w_o_rwkv, w_out, norm_ffn, w_query, sub_keys1, sub_keys2, expert_down, expert_up):
    for l in range(DEPTH):
        mod = jax.nn.silu(c) @ w_ada[l] + b_ada[l]
        sh1, sc1, gt1, sh2, sc2, gt2 = jnp.split(mod, N_MOD, axis=-1)
        h = modulate(rms_norm(x, norm_mix[l]), sh1, sc1)
        mix = token_mixer(h, positions, w_in[l], mu_shift[l], q_a_norm[l], w_uq[l], kv_a_norm[l], w_ukv[l],
                          q_norm[l], k_norm[l], w_o_mla[l], w_decay_up[l], decay_base[l], w_aaa_up[l],
                          aaa_base[l], w_gate_up[l], k_k[l], k_a[l], r_k[l], ln_x_w[l], ln_x_b[l],
                          w_o_rwkv[l], w_out[l])
        x = x + gt1[:, None, :] * mix
        h = modulate(rms_norm(x, norm_ffn[l]), sh2, sc2)
        x = x + gt2[:, None, :] * peer_ffn(h, w_query[l], sub_keys1[l], sub_keys2[l], expert_down[l], expert_up[l])
    return x
```

```cpp
#include <hip/hip_runtime.h>
#include <hip/hip_cooperative_groups.h>
#include <cstdio>
#include <cstdint>
namespace cg = cooperative_groups;

typedef unsigned short bf16_t;
typedef short bf16x8 __attribute__((ext_vector_type(8)));
typedef float f32x16 __attribute__((ext_vector_type(16)));
typedef float f32x4 __attribute__((ext_vector_type(4)));
typedef unsigned u32x4 __attribute__((ext_vector_type(4)));
typedef unsigned u32x2 __attribute__((ext_vector_type(2)));

#define NTHREADS 512
#ifndef DBG_FFN
#define DBG_FFN 1.f
#endif
#define MFMA32(a, b, c) __builtin_amdgcn_mfma_f32_32x32x16_bf16((a), (b), (c), 0, 0, 0)

constexpr int T_TOK = 16384, SEQ = 4096, NB = 4, DM = 1024;
constexpr int NPA = 2304;
constexpr int C_QA = 0, C_KVA = 256, C_KR = 384, C_RW = 416;
constexpr int C_R = C_RW, C_K = C_RW + 512, C_V = C_RW + 1024, C_WD = C_RW + 1536, C_AD = C_RW + 1600, C_GD = C_RW + 1664;
constexpr size_t MiB = 1u << 20;
constexpr size_t OFF_WINA = 0, OFF_WG = OFF_WINA + (size_t)NPA * 1024 * 2, OFF_WUQ = OFF_WG + 2048 * 1024 * 2, OFF_WUKV = OFF_WUQ + 768 * 256 * 2,
                 OFF_WDEC = OFF_WUKV + 1024 * 128 * 2, OFF_WAAA = OFF_WDEC + 512 * 64 * 2, OFF_WGATE = OFF_WAAA + 512 * 64 * 2,
                 OFF_WOMLA = OFF_WGATE + 512 * 128 * 2, OFF_WORWKV = OFF_WOMLA + 1024 * 512 * 2, OFF_WOUT = OFF_WORWKV + 1024 * 512 * 2,
                 OFF_WQRY = OFF_WOUT + 1024 * 1024 * 2, OFF_SK1 = OFF_WQRY + 2048 * 1024 * 2, OFF_SK2 = OFF_SK1 + 128 * 128 * 2,
                 OFF_MODP = OFF_SK2 + 128 * 128 * 2, OFF_MOD = OFF_MODP + 16 * 4 * 6144 * 4, OFF_ROPE = OFF_MOD + 4 * 6144 * 4,
                 OFF_CTR = OFF_ROPE + (size_t)T_TOK * 32 * 4, OFF_END_W = OFF_CTR + 4096;
static_assert(OFF_END_W <= 24 * MiB, "weights region");
constexpr size_t OFF_H = 24 * MiB;
constexpr size_t OFF_G8 = OFF_H;
constexpr size_t OFF_P = 56 * MiB;
constexpr size_t OFF_OMLA = OFF_P, OFF_YG = OFF_P + 16 * MiB, OFF_X1 = OFF_P;
constexpr size_t OFF_S = 128 * MiB;
constexpr size_t OFF_SR = OFF_S, OFF_SE = OFF_S + 16 * MiB, OFF_SKH = OFF_S + 32 * MiB, OFF_SV = OFF_S + 48 * MiB, OFF_SKK = OFF_S + 64 * MiB,
                 OFF_SB = OFF_S + 80 * MiB, OFF_SG = OFF_S + 96 * MiB;
constexpr size_t OFF_MERGED = OFF_S, OFF_EDOWN = OFF_S + 32 * MiB, OFF_EUP = OFF_S + 64 * MiB;
constexpr size_t OFF_IDX = 240 * MiB, OFF_GATES = 248 * MiB;
constexpr size_t DO_Q = 0, DO_K = 24 * MiB, DO_VT = 48 * MiB, DO_Q2 = 0, DO_H = 0;

struct Params {
    const float* in[33];
    float* out;
    unsigned char* ws;
    int phase_lo, phase_hi;
};

__device__ __forceinline__ float bf2f(bf16_t h) { return __uint_as_float((unsigned)h << 16); }
__device__ __forceinline__ bf16_t f2bf(float f) { unsigned u = __float_as_uint(f); u += 0x7fffu + ((u >> 16) & 1u); return (bf16_t)(u >> 16); }
__device__ __forceinline__ unsigned pk2(float lo, float hi) { return (unsigned)f2bf(lo) | ((unsigned)f2bf(hi) << 16); }
__device__ __forceinline__ float lo_f(unsigned w) { return __uint_as_float(w << 16); }
__device__ __forceinline__ float hi_f(unsigned w) { return __uint_as_float(w & 0xffff0000u); }
__device__ __forceinline__ float wave_sum(float v) { for (int o = 32; o; o >>= 1) v += __shfl_xor(v, o); return v; }
__device__ __forceinline__ float xhalf_sum(float v) { return v + __shfl_xor(v, 32); }
__device__ __forceinline__ float xhalf_max(float v) { return fmaxf(v, __shfl_xor(v, 32)); }
__device__ __forceinline__ float sigmoidf_(float x) { return 1.f / (1.f + __expf(-x)); }
__device__ __forceinline__ float tanhf_(float x) { float e = __expf(-2.f * fabsf(x)); float t = (1.f - e) / (1.f + e); return x < 0.f ? -t : t; }
__device__ __forceinline__ int crow(int reg, int hi) { return (reg & 3) + 8 * (reg >> 2) + 4 * hi; }
__device__ __forceinline__ bf16x8 as_bf16x8(u32x4 w) { return *reinterpret_cast<bf16x8*>(&w); }

__device__ __forceinline__ void p0_mod_partials(const Params& p, unsigned char* lds, int task) {
    const int jb = task % 12, ks = task / 12, tid = threadIdx.x;
    const float* c = p.in[1]; const float* w_ada = p.in[3];
    float* sc = (float*)lds;
    __syncthreads();
    if (tid < 256) { const int b = tid >> 6, k = tid & 63; const float v = c[b * 1024 + ks * 64 + k]; sc[tid] = v * sigmoidf_(v); }
    __syncthreads();
    const int j = jb * 512 + tid;
    float a0 = 0.f, a1 = 0.f, a2 = 0.f, a3 = 0.f;
    for (int k = 0; k < 64; ++k) { const float w = w_ada[(size_t)(ks * 64 + k) * 6144 + j]; a0 += sc[k] * w; a1 += sc[64 + k] * w; a2 += sc[128 + k] * w; a3 += sc[192 + k] * w; }
    float* modp = (float*)(p.ws + OFF_MODP) + (size_t)ks * 4 * 6144;
    modp[0 * 6144 + j] = a0; modp[1 * 6144 + j] = a1; modp[2 * 6144 + j] = a2; modp[3 * 6144 + j] = a3;
}
__device__ __forceinline__ void cvt_tile(const float* __restrict__ src, int ld, int K, int N, const float* __restrict__ g, bf16_t* __restrict__ dst, int tile, unsigned char* lds) {
    const int ntk = K / 64, tk = tile % ntk, tn = tile / ntk, k0 = tk * 64, n0 = tn * 64, tid = threadIdx.x;
    bf16_t* tl = (bf16_t*)lds;
    __syncthreads();
    for (int i = 0; i < 2; ++i) {
        const int kr = (tid >> 4) + 32 * i, nc = (tid & 15) * 4, k = k0 + kr, n = n0 + nc;
        f32x4 v = {0.f, 0.f, 0.f, 0.f};
        if (n < N) v = *(const f32x4*)(src + (size_t)k * ld + n);
        const float gg = g ? g[k] : 1.f;
        tl[(nc + 0) * 72 + kr] = f2bf(v[0] * gg); tl[(nc + 1) * 72 + kr] = f2bf(v[1] * gg); tl[(nc + 2) * 72 + kr] = f2bf(v[2] * gg); tl[(nc + 3) * 72 + kr] = f2bf(v[3] * gg);
    }
    __syncthreads();
    { const int nl = tid >> 3, kc = tid & 7; *(u32x4*)(dst + (size_t)(n0 + nl) * K + k0 + kc * 8) = *(const u32x4*)(tl + nl * 72 + kc * 8); }
}
constexpr int NJOBS = 11;
__device__ constexpr int J_IN[NJOBS]   = {6, 6, 9, 11, 15, 17, 19, 14, 25, 26, 28};
__device__ constexpr int J_COFF[NJOBS] = {0, 2208, 0, 0, 0, 0, 0, 0, 0, 0, 0};
__device__ constexpr int J_LD[NJOBS]   = {4256, 4256, 768, 1024, 512, 512, 512, 1024, 1024, 1024, 2048};
__device__ constexpr int J_K[NJOBS]    = {1024, 1024, 256, 128, 64, 64, 128, 512, 512, 1024, 1024};
__device__ constexpr int J_N[NJOBS]    = {2208, 2048, 768, 1024, 512, 512, 512, 1024, 1024, 1024, 2048};
__device__ constexpr int J_NPAD[NJOBS] = {NPA, 2048, 768, 1024, 512, 512, 512, 1024, 1024, 1024, 2048};
__device__ constexpr int J_G[NJOBS]    = {-1, -1, 8, 10, -1, -1, -1, -1, -1, -1, -1};
__device__ constexpr unsigned J_DST[NJOBS] = {(unsigned)OFF_WINA, (unsigned)OFF_WG, (unsigned)OFF_WUQ, (unsigned)OFF_WUKV, (unsigned)OFF_WDEC, (unsigned)OFF_WAAA, (unsigned)OFF_WGATE,
                                              (unsigned)OFF_WOMLA, (unsigned)OFF_WORWKV, (unsigned)OFF_WOUT, (unsigned)OFF_WQRY};
__device__ __forceinline__ void p0_prep(const Params& p, unsigned char* lds) {
    const int tid = threadIdx.x, nblk = gridDim.x, bid = blockIdx.x;
    if (bid == 0 && tid < 64) ((unsigned*)(p.ws + OFF_CTR))[tid] = 0u;
    for (int i = bid * NTHREADS + tid; i < T_TOK * 16; i += nblk * NTHREADS) {
        const int t = i >> 4, f = i & 15;
        const float inv_freq = exp2f(-(float)f * (13.287712379549449f / 16.f));
        const float ang = (float)((const int*)p.in[2])[t] * inv_freq;
        const float n = rintf(ang * 0.15915494309189535f);
        float r = fmaf(-n, 6.28318548202514648f, ang); r = fmaf(-n, -1.7484555e-7f, r);
        float* rp = (float*)(p.ws + OFF_ROPE) + (size_t)t * 32;
        rp[f] = __cosf(r); rp[16 + f] = __sinf(r);
    }
    for (int i = bid * NTHREADS + tid; i < 2 * 128 * 128; i += nblk * NTHREADS) {
        const int which = i >> 14, e = i & 16383;
        ((bf16_t*)(p.ws + (which ? OFF_SK2 : OFF_SK1)))[e] = f2bf(p.in[which ? 30 : 29][e]);
    }
    int total = 192;
    for (int j = 0; j < NJOBS; ++j) total += (J_NPAD[j] / 64) * (J_K[j] / 64);
    for (int task = bid; task < total; task += nblk) {
        if (task < 192) { p0_mod_partials(p, lds, task); continue; }
        int tt = task - 192;
        for (int j = 0; j < NJOBS; ++j) {
            const int nt = (J_NPAD[j] / 64) * (J_K[j] / 64);
            if (tt < nt) { cvt_tile(p.in[J_IN[j]] + J_COFF[j], J_LD[j], J_K[j], J_N[j], J_G[j] >= 0 ? p.in[J_G[j]] : nullptr, (bf16_t*)(p.ws + J_DST[j]), tt, lds); break; }
            tt -= nt;
        }
    }
}

template <bool FROM_PART>
__device__ __forceinline__ void modnorm_phase(const Params& p, const float* __restrict__ src, const float* __restrict__ gain, int sh_col, bf16_t* __restrict__ dst, unsigned char* lds) {
    const int tid = threadIdx.x, lane = tid & 63, wid = tid >> 6;
    float* mul = (float*)lds; float* add = mul + 1024;
    for (int blk = blockIdx.x; blk < T_TOK / 64; blk += gridDim.x) {
        const int b = (blk * 64) / SEQ;
        __syncthreads();
        for (int cidx = tid; cidx < 1024; cidx += NTHREADS) {
            float sh, sc;
            if (FROM_PART) {
                sh = p.in[4][sh_col + cidx]; sc = p.in[4][sh_col + 1024 + cidx];
                const float* mp = (const float*)(p.ws + OFF_MODP) + b * 6144;
                for (int ks = 0; ks < 16; ++ks) { sh += mp[(size_t)ks * 4 * 6144 + sh_col + cidx]; sc += mp[(size_t)ks * 4 * 6144 + sh_col + 1024 + cidx]; }
            } else {
                const float* m = (const float*)(p.ws + OFF_MOD) + b * 6144;
                sh = m[sh_col + cidx]; sc = m[sh_col + 1024 + cidx];
            }
            mul[cidx] = gain[cidx] * (1.f + sc); add[cidx] = sh;
        }
        __syncthreads();
        for (int tt = wid; tt < 64; tt += 8) {
            const int t = blk * 64 + tt;
            const float* xr = src + (size_t)t * 1024;
            f32x4 v[4]; float ss = 0.f;
            for (int i = 0; i < 4; ++i) { v[i] = *(const f32x4*)(xr + i * 256 + lane * 4); ss += v[i][0] * v[i][0] + v[i][1] * v[i][1] + v[i][2] * v[i][2] + v[i][3] * v[i][3]; }
            ss = wave_sum(ss);
            const float rstd = rsqrtf(ss * (1.f / 1024.f) + 1e-6f);
            for (int i = 0; i < 4; ++i) {
                const int c0 = i * 256 + lane * 4;
                const f32x4 m = *(const f32x4*)(mul + c0), a = *(const f32x4*)(add + c0);
                u32x2 w; w.x = pk2(v[i][0] * rstd * m[0] + a[0], v[i][1] * rstd * m[1] + a[1]); w.y = pk2(v[i][2] * rstd * m[2] + a[2], v[i][3] * rstd * m[3] + a[3]);
                *(u32x2*)(dst + (size_t)t * 1024 + c0) = w;
            }
        }
    }
}
__device__ __forceinline__ void p1_finalize_mod(const Params& p) {
    for (int i = blockIdx.x * NTHREADS + threadIdx.x; i < 4 * 6144; i += gridDim.x * NTHREADS) {
        const int j = i % 6144;
        float s = p.in[4][j];
        const float* mp = (const float*)(p.ws + OFF_MODP) + i;
        for (int ks = 0; ks < 16; ++ks) s += mp[(size_t)ks * 4 * 6144];
        ((float*)(p.ws + OFF_MOD))[i] = s;
    }
}

constexpr int G_LDR = 144;
constexpr int G_ABYTES = 256 * G_LDR, G_BBYTES = 128 * G_LDR, G_STAGE = G_ABYTES + G_BBYTES;
struct ALoadPlain { const bf16_t* A; int lda; __device__ __forceinline__ u32x4 operator()(int row, int k) const { return *(const u32x4*)(A + (size_t)row * lda + k); } };

template <class AL>
__device__ __forceinline__ void gemm_accum(f32x16 (&acc)[2][2], const AL& al, const bf16_t* __restrict__ Bt, int ldb, int K, int m0, int n0, unsigned char* lds) {
    const int tid = threadIdx.x, lane = tid & 63, wid = tid >> 6, wm = wid >> 1, wn = wid & 1, r32 = lane & 31, hi = lane >> 5;
    u32x4 ra[4], rb[2];
    const int nk = K / 64;
    auto gload = [&](int kt) {
#pragma unroll
        for (int i = 0; i < 4; ++i) { const int c = tid + NTHREADS * i; ra[i] = al(m0 + (c >> 3), kt * 64 + (c & 7) * 8); }
#pragma unroll
        for (int i = 0; i < 2; ++i) { const int c = tid + NTHREADS * i; rb[i] = *(const u32x4*)(Bt + (size_t)(n0 + (c >> 3)) * ldb + kt * 64 + (c & 7) * 8); }
    };
    auto swrite = [&](int buf) {
        unsigned char* sa = lds + buf * G_STAGE; unsigned char* sb = sa + G_ABYTES;
#pragma unroll
        for (int i = 0; i < 4; ++i) { const int c = tid + NTHREADS * i; *(u32x4*)(sa + (c >> 3) * G_LDR + (c & 7) * 16) = ra[i]; }
#pragma unroll
        for (int i = 0; i < 2; ++i) { const int c = tid + NTHREADS * i; *(u32x4*)(sb + (c >> 3) * G_LDR + (c & 7) * 16) = rb[i]; }
    };
    __syncthreads();
    gload(0); swrite(0);
    __syncthreads();
    for (int kt = 0; kt < nk; ++kt) {
        if (kt + 1 < nk) gload(kt + 1);
        const unsigned char* sa = lds + (kt & 1) * G_STAGE + (wm * 64 + r32) * G_LDR + hi * 16;
        const unsigned char* sb = lds + (kt & 1) * G_STAGE + G_ABYTES + (wn * 64 + r32) * G_LDR + hi * 16;
#pragma unroll
        for (int s = 0; s < 4; ++s) {
            const bf16x8 a0 = *(const bf16x8*)(sa + s * 32), a1 = *(const bf16x8*)(sa + 32 * G_LDR + s * 32);
            const bf16x8 b0 = *(const bf16x8*)(sb + s * 32), b1 = *(const bf16x8*)(sb + 32 * G_LDR + s * 32);
            acc[0][0] = MFMA32(a0, b0, acc[0][0]); acc[0][1] = MFMA32(a0, b1, acc[0][1]);
            acc[1][0] = MFMA32(a1, b0, acc[1][0]); acc[1][1] = MFMA32(a1, b1, acc[1][1]);
        }
        if (kt + 1 < nk) swrite((kt + 1) & 1);
        __syncthreads();
    }
}
__device__ __forceinline__ void zero_acc(f32x16 (&acc)[2][2]) {
#pragma unroll
    for (int i = 0; i < 2; ++i)
#pragma unroll
        for (int j = 0; j < 2; ++j)
#pragma unroll
            for (int r = 0; r < 16; ++r) acc[i][j][r] = 0.f;
}

constexpr int E_LDR = 272;
__device__ __forceinline__ void store_tile_bf16(const f32x16 (&v)[2][2], bf16_t* __restrict__ C, int ldc, int m0, int n0, unsigned char* lds) {
    const int tid = threadIdx.x, lane = tid & 63, wid = tid >> 6, wm = wid >> 1, wn = wid & 1, r32 = lane & 31, hi = lane >> 5;
    __syncthreads();
    unsigned char* base = lds + (wm * 64 + 4 * hi) * E_LDR + (wn * 64 + r32) * 2;
#pragma unroll
    for (int i = 0; i < 2; ++i)
#pragma unroll
        for (int j = 0; j < 2; ++j)
#pragma unroll
            for (int r = 0; r < 16; ++r) *(bf16_t*)(base + (i * 32 + (r & 3) + 8 * (r >> 2)) * E_LDR + j * 64) = f2bf(v[i][j][r]);
    __syncthreads();
#pragma unroll
    for (int i = 0; i < 8; ++i) { const int c = tid + NTHREADS * i, row = c >> 4, ch = c & 15;
        *(u32x4*)(C + (size_t)(m0 + row) * ldc + n0 + ch * 8) = *(const u32x4*)(lds + row * E_LDR + ch * 16); }
}
__device__ __forceinline__ void p2_proj(const Params& p, unsigned char* lds) {
    const int tid = threadIdx.x, lane = tid & 63, wid = tid >> 6, wm = wid >> 1, wn = wid & 1, r32 = lane & 31, hi = lane >> 5;
    const ALoadPlain al{(const bf16_t*)((const unsigned char*)p.out + DO_H), 1024};
    constexpr int NTN = NPA / 128 + 16, NTM = T_TOK / 256;
    for (int u = blockIdx.x; u < NTN * NTM; u += gridDim.x) {
        const int tn = u % NTN, tm = u / NTN, m0 = tm * 256;
        f32x16 acc[2][2]; zero_acc(acc);
        if (tn < NPA / 128) {
            const int n0 = tn * 128;
            gemm_accum(acc, al, (const bf16_t*)(p.ws + OFF_WINA), 1024, 1024, m0, n0, lds);
            store_tile_bf16(acc, (bf16_t*)(p.ws + OFF_P), NPA, m0, n0, lds);
        } else {
            const int n0 = (tn - NPA / 128) * 128;
            gemm_accum(acc, al, (const bf16_t*)(p.ws + OFF_WG), 1024, 1024, m0, n0, lds);
            __syncthreads();
            unsigned char* base = lds + (wm * 64 + 4 * hi) * 144 + wn * 64 + r32;
#pragma unroll
            for (int i = 0; i < 2; ++i)
#pragma unroll
                for (int j = 0; j < 2; ++j)
#pragma unroll
                    for (int r = 0; r < 16; ++r) base[(i * 32 + (r & 3) + 8 * (r >> 2)) * 144 + j * 32] = (unsigned char)__float2int_rn(255.f * sigmoidf_(acc[i][j][r]));
            __syncthreads();
#pragma unroll
            for (int i = 0; i < 4; ++i) { const int c = tid + NTHREADS * i, row = c >> 3, ch = c & 7;
                *(u32x4*)(p.ws + OFF_G8 + (size_t)(m0 + row) * 2048 + n0 + ch * 16) = *(const u32x4*)(lds + row * 144 + ch * 16); }
        }
    }
}
constexpr float EPSN = 1e-6f;
constexpr float QSCALE = 0.10206207261596575f * 1.4426950408889634f;
__device__ __forceinline__ float sumsq8(u32x4 w) {
    float s = 0.f;
#pragma unroll
    for (int i = 0; i < 4; ++i) { const float a = lo_f(w[i]), b = hi_f(w[i]); s += a * a + b * b; }
    return s;
}
__device__ __forceinline__ void p3_q_task(const Params& p, int task, int lane) {
    const int head = task & 7, tile = task >> 3, r32 = lane & 31, hi = lane >> 5, t = tile * 32 + r32;
    const bf16_t* arow = (const bf16_t*)(p.ws + OFF_P) + (size_t)t * NPA + C_QA + hi * 8;
    const bf16_t* wrow = (const bf16_t*)(p.ws + OFF_WUQ) + (size_t)(head * 96 + r32) * 256 + hi * 8;
    f32x16 acc[3];
#pragma unroll
    for (int f = 0; f < 3; ++f)
#pragma unroll
        for (int r = 0; r < 16; ++r) acc[f][r] = 0.f;
    float ss = 0.f;
#pragma unroll 4
    for (int s = 0; s < 16; ++s) {
        const u32x4 av = *(const u32x4*)(arow + s * 16);
        ss += sumsq8(av);
        const bf16x8 a = as_bf16x8(av);
#pragma unroll
        for (int f = 0; f < 3; ++f) { const bf16x8 w = *(const bf16x8*)(wrow + (size_t)f * 32 * 256 + s * 16); acc[f] = MFMA32(w, a, acc[f]); }
    }
    ss = xhalf_sum(ss);
    const float rstd = rsqrtf(ss * (1.f / 256.f) + EPSN);
    float sn = 0.f, sr = 0.f;
#pragma unroll
    for (int r = 0; r < 16; ++r) { acc[0][r] *= rstd; acc[1][r] *= rstd; acc[2][r] *= rstd; sn += acc[0][r] * acc[0][r] + acc[1][r] * acc[1][r]; sr += acc[2][r] * acc[2][r]; }
    sn = xhalf_sum(sn); sr = xhalf_sum(sr);
    const float rn = rsqrtf(sn * (1.f / 64.f) + EPSN) * QSCALE, rr = rsqrtf(sr * (1.f / 32.f) + EPSN) * QSCALE;
    const float* qn = p.in[12];
    bf16_t* qo = (bf16_t*)((unsigned char*)p.out + DO_Q) + (size_t)t * 768 + head * 96;
#pragma unroll
    for (int f = 0; f < 2; ++f)
#pragma unroll
        for (int rq = 0; rq < 4; ++rq) {
            const int f0 = f * 32 + 8 * rq + 4 * hi;
            const f32x4 g = *(const f32x4*)(qn + f0);
            u32x2 w; w.x = pk2(acc[f][rq * 4 + 0] * rn * g[0], acc[f][rq * 4 + 1] * rn * g[1]); w.y = pk2(acc[f][rq * 4 + 2] * rn * g[2], acc[f][rq * 4 + 3] * rn * g[3]);
            *(u32x2*)(qo + f0) = w;
        }
    const float* rope = (const float*)(p.ws + OFF_ROPE) + (size_t)t * 32;
#pragma unroll
    for (int rq = 0; rq < 2; ++rq) {
        const int i0 = 8 * rq + 4 * hi;
        const f32x4 g1 = *(const f32x4*)(qn + 64 + i0), g2 = *(const f32x4*)(qn + 80 + i0), cs = *(const f32x4*)(rope + i0), sn4 = *(const f32x4*)(rope + 16 + i0);
        float o1[4], o2[4];
#pragma unroll
        for (int j = 0; j < 4; ++j) { const float x1 = acc[2][rq * 4 + j] * rr * g1[j], x2 = acc[2][8 + rq * 4 + j] * rr * g2[j]; o1[j] = x1 * cs[j] - x2 * sn4[j]; o2[j] = x1 * sn4[j] + x2 * cs[j]; }
        u32x2 w1, w2; w1.x = pk2(o1[0], o1[1]); w1.y = pk2(o1[2], o1[3]); w2.x = pk2(o2[0], o2[1]); w2.y = pk2(o2[2], o2[3]);
        *(u32x2*)(qo + 64 + i0) = w1; *(u32x2*)(qo + 80 + i0) = w2;
    }
}
__device__ __forceinline__ int vperm(int s) { return (s & ~12) | ((s & 4) << 1) | ((s & 8) >> 1); }
__device__ __forceinline__ void p3_kv_task(const Params& p, int task, int lane) {
    const int head = task & 7, tile = task >> 3, r32 = lane & 31, hi = lane >> 5, t = tile * 32 + r32;
    const bf16_t* prow = (const bf16_t*)(p.ws + OFF_P) + (size_t)t * NPA;
    const bf16_t* arow = prow + C_KVA + hi * 8;
    const bf16_t* wrow = (const bf16_t*)(p.ws + OFF_WUKV) + (size_t)(head * 128 + r32) * 128 + hi * 8;
    f32x16 acc[4];
#pragma unroll
    for (int f = 0; f < 4; ++f)
#pragma unroll
        for (int r = 0; r < 16; ++r) acc[f][r] = 0.f;
    float ss = 0.f;
#pragma unroll 4
    for (int s = 0; s < 8; ++s) {
        const u32x4 av = *(const u32x4*)(arow + s * 16);
        ss += sumsq8(av);
        const bf16x8 a = as_bf16x8(av);
#pragma unroll
        for (int f = 0; f < 4; ++f) { const bf16x8 w = *(const bf16x8*)(wrow + (size_t)f * 32 * 128 + s * 16); acc[f] = MFMA32(w, a, acc[f]); }
    }
    ss = xhalf_sum(ss);
    const float rstd = rsqrtf(ss * (1.f / 128.f) + EPSN);
    float sn = 0.f;
#pragma unroll
    for (int r = 0; r < 16; ++r) { acc[0][r] *= rstd; acc[1][r] *= rstd; sn += acc[0][r] * acc[0][r] + acc[1][r] * acc[1][r]; }
    sn = xhalf_sum(sn);
    const float rn = rsqrtf(sn * (1.f / 64.f) + EPSN);
    const float* kn = p.in[13];
    bf16_t* ko = (bf16_t*)((unsigned char*)p.out + DO_K) + (size_t)t * 768 + head * 96;
#pragma unroll
    for (int f = 0; f < 2; ++f)
#pragma unroll
        for (int rq = 0; rq < 4; ++rq) {
            const int f0 = f * 32 + 8 * rq + 4 * hi;
            const f32x4 g = *(const f32x4*)(kn + f0);
            u32x2 w; w.x = pk2(acc[f][rq * 4 + 0] * rn * g[0], acc[f][rq * 4 + 1] * rn * g[1]); w.y = pk2(acc[f][rq * 4 + 2] * rn * g[2], acc[f][rq * 4 + 3] * rn * g[3]);
            *(u32x2*)(ko + f0) = w;
        }
    {
        const float* rope = (const float*)(p.ws + OFF_ROPE) + (size_t)t * 32;
        float x1[2][4], x2[2][4]; float sr = 0.f;
#pragma unroll
        for (int rq = 0; rq < 2; ++rq) {
            const int i0 = 8 * rq + 4 * hi;
            const u32x2 a = *(const u32x2*)(prow + C_KR + i0), b = *(const u32x2*)(prow + C_KR + 16 + i0);
            x1[rq][0] = lo_f(a.x); x1[rq][1] = hi_f(a.x); x1[rq][2] = lo_f(a.y); x1[rq][3] = hi_f(a.y);
            x2[rq][0] = lo_f(b.x); x2[rq][1] = hi_f(b.x); x2[rq][2] = lo_f(b.y); x2[rq][3] = hi_f(b.y);
#pragma unroll
            for (int j = 0; j < 4; ++j) sr += x1[rq][j] * x1[rq][j] + x2[rq][j] * x2[rq][j];
        }
        sr = xhalf_sum(sr);
        const float rr = rsqrtf(sr * (1.f / 32.f) + EPSN);
#pragma unroll
        for (int rq = 0; rq < 2; ++rq) {
            const int i0 = 8 * rq + 4 * hi;
            const f32x4 g1 = *(const f32x4*)(kn + 64 + i0), g2 = *(const f32x4*)(kn + 80 + i0), cs = *(const f32x4*)(rope + i0), sn4 = *(const f32x4*)(rope + 16 + i0);
            float o1[4], o2[4];
#pragma unroll
            for (int j = 0; j < 4; ++j) { const float a = x1[rq][j] * rr * g1[j], b = x2[rq][j] * rr * g2[j]; o1[j] = a * cs[j] - b * sn4[j]; o2[j] = a * sn4[j] + b * cs[j]; }
            u32x2 w1, w2; w1.x = pk2(o1[0], o1[1]); w1.y = pk2(o1[2], o1[3]); w2.x = pk2(o2[0], o2[1]); w2.y = pk2(o2[2], o2[3]);
            *(u32x2*)(ko + 64 + i0) = w1; *(u32x2*)(ko + 80 + i0) = w2;
        }
    }
    const int b = t >> 12, sp = vperm(t & 4095);
    bf16_t* vo = (bf16_t*)((unsigned char*)p.out + DO_VT) + ((size_t)(b * 8 + head) * 64) * 4096 + sp;
#pragma unroll
    for (int f = 0; f < 2; ++f)
#pragma unroll
        for (int r = 0; r < 16; ++r) vo[(size_t)(f * 32 + (r & 3) + 8 * (r >> 2) + 4 * hi) * 4096] = f2bf(acc[2 + f][r] * rstd);
}
template <int LORA>
__device__ __forceinline__ void p3_lora_task(const Params& p, int tile, int fg, int lane) {
    constexpr int CIN = LORA == 0 ? C_WD : (LORA == 1 ? C_AD : C_GD), KL = LORA == 2 ? 128 : 64;
    constexpr size_t WOFF = LORA == 0 ? OFF_WDEC : (LORA == 1 ? OFF_WAAA : OFF_WGATE), OOFF = LORA == 0 ? OFF_SE : (LORA == 1 ? OFF_SB : OFF_SG);
    const int r32 = lane & 31, hi = lane >> 5, t = tile * 32 + r32;
    const bf16_t* prow = (const bf16_t*)(p.ws + OFF_P) + (size_t)t * NPA + CIN + hi * 8;
    const float* mu = p.in[7] + (CIN - C_RW) + hi * 8;
    const bool first = (t & 4095) == 0;
    const bf16_t* wrow = (const bf16_t*)(p.ws + WOFF) + (size_t)(fg * 128 + r32) * KL + hi * 8;
    f32x16 acc[4];
#pragma unroll
    for (int f = 0; f < 4; ++f)
#pragma unroll
        for (int r = 0; r < 16; ++r) acc[f][r] = 0.f;
#pragma unroll
    for (int s = 0; s < KL / 16; ++s) {
        const u32x4 cur = *(const u32x4*)(prow + s * 16);
        u32x4 prv = {0u, 0u, 0u, 0u};
        if (!first) prv = *(const u32x4*)(prow - NPA + s * 16);
        const f32x4 m0 = *(const f32x4*)(mu + s * 16), m1 = *(const f32x4*)(mu + s * 16 + 4);
        float v[8];
#pragma unroll
        for (int i = 0; i < 4; ++i) {
            const float c0 = lo_f(cur[i]), c1 = hi_f(cur[i]), p0 = lo_f(prv[i]), p1 = hi_f(prv[i]);
            const float ma = (i < 2) ? m0[2 * i] : m1[2 * i - 4], mb = (i < 2) ? m0[2 * i + 1] : m1[2 * i - 3];
            v[2 * i] = c0 + (p0 - c0) * ma; v[2 * i + 1] = c1 + (p1 - c1) * mb;
        }
#pragma unroll
        for (int i = 0; i < 8; ++i) v[i] = LORA == 0 ? tanhf_(v[i]) : (LORA == 2 ? sigmoidf_(v[i]) : v[i]);
        u32x4 aw; aw.x = pk2(v[0], v[1]); aw.y = pk2(v[2], v[3]); aw.z = pk2(v[4], v[5]); aw.w = pk2(v[6], v[7]);
        const bf16x8 a = as_bf16x8(aw);
#pragma unroll
        for (int f = 0; f < 4; ++f) { const bf16x8 w = *(const bf16x8*)(wrow + (size_t)f * 32 * KL + s * 16); acc[f] = MFMA32(a, w, acc[f]); }
    }
    bf16_t* o = (bf16_t*)(p.ws + OOFF) + (size_t)(tile * 32 + 4 * hi) * 512 + fg * 128 + r32;
#pragma unroll
    for (int f = 0; f < 4; ++f)
#pragma unroll
        for (int r = 0; r < 16; ++r) o[(size_t)((r & 3) + 8 * (r >> 2)) * 512 + f * 32] = f2bf(acc[f][r]);
}
__device__ __forceinline__ void p3_small(const Params& p) {
    const int lane = threadIdx.x & 63, gw = blockIdx.x * 8 + (threadIdx.x >> 6), nw = gridDim.x * 8;
    constexpr int NQ = 512 * 8, NKV = 512 * 8, NL = 512 * 12;
    for (int task = gw; task < NQ + NKV + NL; task += nw) {
        if (task < NQ) p3_q_task(p, task, lane);
        else if (task < NQ + NKV) p3_kv_task(p, task - NQ, lane);
        else {
            const int tt = task - NQ - NKV, tile = tt / 12, sub = tt % 12, lora = sub >> 2, fg = sub & 3;
            if (lora == 0) p3_lora_task<0>(p, tile, fg, lane); else if (lora == 1) p3_lora_task<1>(p, tile, fg, lane); else p3_lora_task<2>(p, tile, fg, lane);
        }
    }
}

__device__ __forceinline__ void p4_rwkv_prep(const Params& p) {
    const int lane = threadIdx.x & 63, gw = blockIdx.x * 8 + (threadIdx.x >> 6), nw = gridDim.x * 8;
    const bf16_t* P = (const bf16_t*)(p.ws + OFF_P);
    bf16_t* SR = (bf16_t*)(p.ws + OFF_SR); bf16_t* SE = (bf16_t*)(p.ws + OFF_SE); bf16_t* SKH = (bf16_t*)(p.ws + OFF_SKH); bf16_t* SV = (bf16_t*)(p.ws + OFF_SV);
    bf16_t* SKK = (bf16_t*)(p.ws + OFF_SKK); bf16_t* SB = (bf16_t*)(p.ws + OFF_SB);
    for (int task = gw; task < T_TOK * 8; task += nw) {
        const int t = task >> 3, hd = task & 7, ch = hd * 64 + lane;
        const bf16_t* row = P + (size_t)t * NPA;
        const bool first = (t & 4095) == 0;
        const float r0 = bf2f(row[C_R + ch]), k0 = bf2f(row[C_K + ch]), v0 = bf2f(row[C_V + ch]);
        float rp = 0.f, kp = 0.f, vp = 0.f;
        if (!first) { rp = bf2f(row[C_R + ch - NPA]); kp = bf2f(row[C_K + ch - NPA]); vp = bf2f(row[C_V + ch - NPA]); }
        const float* mu = p.in[7];
        const float r = r0 + (rp - r0) * mu[ch], k = k0 + (kp - k0) * mu[512 + ch], v = v0 + (vp - v0) * mu[1024 + ch];
        const size_t o = (size_t)t * 512 + ch;
        const float dec = p.in[16][ch] + bf2f(SE[o]);
        const float nd = -dec, sp = fmaxf(nd, 0.f) + log1pf(__expf(-fabsf(nd)));
        const float e = __expf(-sp - 0.5f);
        const float a = sigmoidf_(p.in[18][ch] + bf2f(SB[o]));
        const float kkr = k * p.in[20][ch];
        const float n2 = wave_sum(kkr * kkr);
        const float kk = kkr / fmaxf(sqrtf(n2), 1e-12f);
        const float kh = k * (1.f + (a - 1.f) * p.in[21][ch]);
        SR[o] = f2bf(r); SE[o] = f2bf(e); SKH[o] = f2bf(kh); SV[o] = f2bf(v); SKK[o] = f2bf(kk); SB[o] = f2bf(kk * a);
    }
}

template <int CTRL> __device__ __forceinline__ float dpp_f(float v) { return __int_as_float(__builtin_amdgcn_update_dpp(0, __float_as_int(v), CTRL, 0xf, 0xf, false)); }
__device__ __forceinline__ float reduce16(float v) { v += dpp_f<0xB1>(v); v += dpp_f<0x4E>(v); v += dpp_f<0x141>(v); v += dpp_f<0x140>(v); return v; }
constexpr int SC_CH = 32;
__device__ __forceinline__ void scan_block(const Params& p, int bh, unsigned char* lds) {
    const int b = bh >> 3, hd = bh & 7, tid = threadIdx.x, lane = tid & 63, wid = tid >> 6, kq = lane & 15, rp = lane >> 4, row0 = wid * 8 + rp * 2;
    float* buf = (float*)lds;
    float* ybuf = buf + 2 * 6 * SC_CH * 64;
    const size_t arr_off[6] = {OFF_SE, OFF_SKK, OFF_SB, OFF_SKH, OFF_SR, OFF_SV};
    float s0[4] = {0.f, 0.f, 0.f, 0.f}, s1[4] = {0.f, 0.f, 0.f, 0.f};
    u32x4 st[3];
    auto gload = [&](int c) {
#pragma unroll
        for (int i = 0; i < 3; ++i) { const int cc = tid + NTHREADS * i, arr = cc >> 8, rem = cc & 255, tok = rem >> 3, c8 = rem & 7;
            const size_t off = arr == 0 ? OFF_SE : arr == 1 ? OFF_SKK : arr == 2 ? OFF_SB : arr == 3 ? OFF_SKH : arr == 4 ? OFF_SR : OFF_SV;
            st[i] = *(const u32x4*)((const bf16_t*)(p.ws + off) + ((size_t)(b * 4096 + c * SC_CH + tok)) * 512 + hd * 64 + c8 * 8); }
    };
    auto swrite = [&](int bsel) {
#pragma unroll
        for (int i = 0; i < 3; ++i) { const int cc = tid + NTHREADS * i, arr = cc >> 8, rem = cc & 255, tok = rem >> 3, c8 = rem & 7;
            float v[8];
#pragma unroll
            for (int j = 0; j < 4; ++j) { v[2 * j] = lo_f(st[i][j]); v[2 * j + 1] = hi_f(st[i][j]); }
            if (arr == 0) {
#pragma unroll
                for (int j = 0; j < 8; ++j) v[j] = __expf(-v[j]);
            } else if (arr == 1) {
#pragma unroll
                for (int j = 0; j < 8; ++j) v[j] = -v[j];
            }
            float* d = buf + ((size_t)(bsel * 6 + arr) * SC_CH + tok) * 64 + c8 * 8;
            *(f32x4*)d = (f32x4){v[0], v[1], v[2], v[3]}; *(f32x4*)(d + 4) = (f32x4){v[4], v[5], v[6], v[7]}; }
    };
    (void)arr_off;
    __syncthreads();
    gload(0); swrite(0);
    __syncthreads();
    constexpr int NCH = SEQ / SC_CH;
    for (int c = 0; c < NCH; ++c) {
        if (c + 1 < NCH) gload(c + 1);
        const float* bb = buf + (size_t)(c & 1) * 6 * SC_CH * 64;
#pragma unroll 2
        for (int t = 0; t < SC_CH; ++t) {
            const f32x4 w = *(const f32x4*)(bb + (0 * SC_CH + t) * 64 + kq * 4), nk = *(const f32x4*)(bb + (1 * SC_CH + t) * 64 + kq * 4), bv = *(const f32x4*)(bb + (2 * SC_CH + t) * 64 + kq * 4),
                        kv = *(const f32x4*)(bb + (3 * SC_CH + t) * 64 + kq * 4), rv = *(const f32x4*)(bb + (4 * SC_CH + t) * 64 + kq * 4);
            const float v0 = bb[(5 * SC_CH + t) * 64 + row0], v1 = bb[(5 * SC_CH + t) * 64 + row0 + 1];
            float sa0 = s0[0] * nk[0] + s0[1] * nk[1] + s0[2] * nk[2] + s0[3] * nk[3];
            float sa1 = s1[0] * nk[0] + s1[1] * nk[1] + s1[2] * nk[2] + s1[3] * nk[3];
            sa0 = reduce16(sa0); sa1 = reduce16(sa1);
            float y0 = 0.f, y1 = 0.f;
#pragma unroll
            for (int j = 0; j < 4; ++j) {
                s0[j] = s0[j] * w[j] + sa0 * bv[j] + v0 * kv[j]; s1[j] = s1[j] * w[j] + sa1 * bv[j] + v1 * kv[j];
                y0 += s0[j] * rv[j]; y1 += s1[j] * rv[j];
            }
            y0 = reduce16(y0); y1 = reduce16(y1);
            if (kq == 0) { ybuf[t * 64 + row0] = y0; ybuf[t * 64 + row0 + 1] = y1; }
        }
        if (c + 1 < NCH) swrite((c + 1) & 1);
        __syncthreads();
        for (int tt = wid; tt < SC_CH; tt += 8) {
            const int tg = b * 4096 + c * SC_CH + tt, ch = hd * 64 + lane;
            const float y = ybuf[tt * 64 + lane];
            const float mean = wave_sum(y) * (1.f / 64.f);
            const float d = y - mean;
            const float var = wave_sum(d * d) * (1.f / 64.f);
            float yn = d * rsqrtf(var + 64e-5f) * p.in[23][ch] + p.in[24][ch];
            const float rr = bb[(4 * SC_CH + tt) * 64 + lane], kh = bb[(3 * SC_CH + tt) * 64 + lane], vv = bb[(5 * SC_CH + tt) * 64 + lane];
            const float bonus = wave_sum(rr * kh * p.in[22][ch]);
            yn += bonus * vv;
            const float g = bf2f(((const bf16_t*)(p.ws + OFF_SG))[(size_t)tg * 512 + ch]);
            ((bf16_t*)(p.ws + OFF_YG))[(size_t)tg * 512 + ch] = f2bf(yn * g);
        }
        __syncthreads();
    }
}
__device__ __forceinline__ void attn_task(const Params& p, int bh, int qt, int lane) {
    const int b = bh >> 3, hd = bh & 7, r32 = lane & 31, hi = lane >> 5;
    const bf16_t* Q = (const bf16_t*)((const unsigned char*)p.out + DO_Q) + ((size_t)(b * 4096 + qt * 32 + r32)) * 768 + hd * 96 + hi * 8;
    const bf16_t* Kb = (const bf16_t*)((const unsigned char*)p.out + DO_K) + ((size_t)(b * 4096 + r32)) * 768 + hd * 96 + hi * 8;
    const bf16_t* Vb = (const bf16_t*)((const unsigned char*)p.out + DO_VT) + ((size_t)(b * 8 + hd) * 64 + r32) * 4096 + hi * 8;
    bf16x8 qf[6];
#pragma unroll
    for (int s = 0; s < 6; ++s) qf[s] = *(const bf16x8*)(Q + s * 16);
    f32x16 o0, o1;
#pragma unroll
    for (int r = 0; r < 16; ++r) { o0[r] = 0.f; o1[r] = 0.f; }
    float m = -1e30f, l = 0.f;
    for (int kt = 0; kt <= qt; ++kt) {
        f32x16 sc;
#pragma unroll
        for (int r = 0; r < 16; ++r) sc[r] = 0.f;
        const bf16_t* Kt = Kb + (size_t)kt * 32 * 768;
#pragma unroll
        for (int s = 0; s < 6; ++s) { const bf16x8 kf = *(const bf16x8*)(Kt + s * 16); sc = MFMA32(kf, qf[s], sc); }
        if (kt == qt) {
#pragma unroll
            for (int r = 0; r < 16; ++r) if (crow(r, hi) > r32) sc[r] = -1e30f;
        }
        float mx = sc[0];
#pragma unroll
        for (int r = 1; r < 16; ++r) mx = fmaxf(mx, sc[r]);
        mx = xhalf_max(mx);
        const float mn = fmaxf(m, mx), alpha = __builtin_amdgcn_exp2f(m - mn);
        m = mn;
        float ps = 0.f;
#pragma unroll
        for (int r = 0; r < 16; ++r) { sc[r] = __builtin_amdgcn_exp2f(sc[r] - mn); ps += sc[r]; }
        l = l * alpha + ps;
#pragma unroll
        for (int r = 0; r < 16; ++r) { o0[r] *= alpha; o1[r] *= alpha; }
        u32x4 pw0, pw1;
        pw0.x = pk2(sc[0], sc[1]); pw0.y = pk2(sc[2], sc[3]); pw0.z = pk2(sc[4], sc[5]); pw0.w = pk2(sc[6], sc[7]);
        pw1.x = pk2(sc[8], sc[9]); pw1.y = pk2(sc[10], sc[11]); pw1.z = pk2(sc[12], sc[13]); pw1.w = pk2(sc[14], sc[15]);
        const bf16x8 pf0 = as_bf16x8(pw0), pf1 = as_bf16x8(pw1);
        const bf16_t* Vt = Vb + kt * 32;
        const bf16x8 v00 = *(const bf16x8*)(Vt), v01 = *(const bf16x8*)(Vt + 16), v10 = *(const bf16x8*)(Vt + (size_t)32 * 4096), v11 = *(const bf16x8*)(Vt + (size_t)32 * 4096 + 16);
        o0 = MFMA32(v00, pf0, o0); o0 = MFMA32(v01, pf1, o0);
        o1 = MFMA32(v10, pf0, o1); o1 = MFMA32(v11, pf1, o1);
    }
    l = xhalf_sum(l);
    const float il = 1.f / l;
    bf16_t* O = (bf16_t*)(p.ws + OFF_OMLA) + ((size_t)(b * 4096 + qt * 32 + r32)) * 512 + hd * 64 + 4 * hi;
#pragma unroll
    for (int rq = 0; rq < 4; ++rq) {
        u32x2 w0, w1;
        w0.x = pk2(o0[rq * 4 + 0] * il, o0[rq * 4 + 1] * il); w0.y = pk2(o0[rq * 4 + 2] * il, o0[rq * 4 + 3] * il);
        w1.x = pk2(o1[rq * 4 + 0] * il, o1[rq * 4 + 1] * il); w1.y = pk2(o1[rq * 4 + 2] * il, o1[rq * 4 + 3] * il);
        *(u32x2*)(O + 8 * rq) = w0; *(u32x2*)(O + 32 + 8 * rq) = w1;
    }
}
__device__ __forceinline__ void p5_attn_scan(const Params& p, unsigned char* lds) {
    const int lane = threadIdx.x & 63;
    if (blockIdx.x < 32) scan_block(p, blockIdx.x, lds);
    unsigned* ctr = (unsigned*)(p.ws + OFF_CTR);
    for (;;) {
        unsigned n = 0;
        if (lane == 0) n = atomicAdd(ctr, 1u);
        n = __builtin_amdgcn_readfirstlane(n);
        if (n >= 4096u) break;
        attn_task(p, n & 31, 127 - (n >> 5), lane);
    }
}

__device__ __forceinline__ void tile_to_lds_bf16(const f32x16 (&v)[2][2], unsigned char* lds) {
    const int lane = threadIdx.x & 63, wid = threadIdx.x >> 6, wm = wid >> 1, wn = wid & 1, r32 = lane & 31, hi = lane >> 5;
    __syncthreads();
    unsigned char* base = lds + (wm * 64 + 4 * hi) * E_LDR + (wn * 64 + r32) * 2;
#pragma unroll
    for (int i = 0; i < 2; ++i)
#pragma unroll
        for (int j = 0; j < 2; ++j)
#pragma unroll
            for (int r = 0; r < 16; ++r) *(bf16_t*)(base + (i * 32 + (r & 3) + 8 * (r >> 2)) * E_LDR + j * 64) = f2bf(v[i][j][r]);
    __syncthreads();
}
__device__ __forceinline__ void p6_merge(const Params& p, unsigned char* lds) {
    const int tid = threadIdx.x;
    const ALoadPlain ao{(const bf16_t*)(p.ws + OFF_OMLA), 512}, ay{(const bf16_t*)(p.ws + OFF_YG), 512};
    const unsigned char* G8 = p.ws + OFF_G8;
    for (int u = blockIdx.x; u < 8 * 64; u += gridDim.x) {
        const int tn = u & 7, tm = u >> 3, m0 = tm * 256, n0 = tn * 128;
        f32x16 acc[2][2]; u32x4 rp[8];
        zero_acc(acc); gemm_accum(acc, ao, (const bf16_t*)(p.ws + OFF_WOMLA), 512, 512, m0, n0, lds);
        tile_to_lds_bf16(acc, lds);
#pragma unroll
        for (int q = 0; q < 8; ++q) { const int c = tid + NTHREADS * q, row = c >> 4, ch = c & 15;
            const u32x4 v = *(const u32x4*)(lds + row * E_LDR + ch * 16);
            const u32x2 g = *(const u32x2*)(G8 + (size_t)(m0 + row) * 2048 + n0 + ch * 8);
            u32x4 o;
#pragma unroll
            for (int e = 0; e < 4; ++e) { const unsigned gw = e < 2 ? g.x : g.y; const int sh = (e & 1) * 16;
                o[e] = pk2(lo_f(v[e]) * (float)((gw >> sh) & 255u) * (1.f / 255.f), hi_f(v[e]) * (float)((gw >> (sh + 8)) & 255u) * (1.f / 255.f)); }
            rp[q] = o; }
        zero_acc(acc); gemm_accum(acc, ay, (const bf16_t*)(p.ws + OFF_WORWKV), 512, 512, m0, n0, lds);
        tile_to_lds_bf16(acc, lds);
#pragma unroll
        for (int q = 0; q < 8; ++q) { const int c = tid + NTHREADS * q, row = c >> 4, ch = c & 15;
            const u32x4 v = *(const u32x4*)(lds + row * E_LDR + ch * 16);
            const u32x2 g = *(const u32x2*)(G8 + (size_t)(m0 + row) * 2048 + 1024 + n0 + ch * 8);
            u32x4 o;
#pragma unroll
            for (int e = 0; e < 4; ++e) { const unsigned gw = e < 2 ? g.x : g.y; const int sh = (e & 1) * 16;
                o[e] = pk2(lo_f(rp[q][e]) + lo_f(v[e]) * (float)((gw >> sh) & 255u) * (1.f / 255.f), hi_f(rp[q][e]) + hi_f(v[e]) * (float)((gw >> (sh + 8)) & 255u) * (1.f / 255.f)); }
            *(u32x4*)((bf16_t*)(p.ws + OFF_MERGED) + (size_t)(m0 + row) * 1024 + n0 + ch * 8) = o; }
    }
}
__device__ __forceinline__ void p7_mix(const Params& p, unsigned char* lds) {
    const int tid = threadIdx.x, lane = tid & 63, wid = tid >> 6, wm = wid >> 1, wn = wid & 1, r32 = lane & 31, hi = lane >> 5;
    const ALoadPlain am{(const bf16_t*)(p.ws + OFF_MERGED), 1024};
    const float* x = p.in[0]; float* x1 = (float*)(p.ws + OFF_X1);
    for (int u = blockIdx.x; u < 8 * 64; u += gridDim.x) {
        const int tn = u & 7, tm = u >> 3, m0 = tm * 256, n0 = tn * 128, b = m0 >> 12;
        const float* gt1 = (const float*)(p.ws + OFF_MOD) + b * 6144 + 2048;
        f32x16 acc[2][2];
        zero_acc(acc); gemm_accum(acc, am, (const bf16_t*)(p.ws + OFF_WOUT), 1024, 1024, m0, n0, lds);
#pragma unroll
        for (int i = 0; i < 2; ++i) {
            __syncthreads();
            float* base = (float*)lds + (wm * 32 + 4 * hi) * 132 + wn * 64 + r32;
#pragma unroll
            for (int j = 0; j < 2; ++j)
#pragma unroll
                for (int r = 0; r < 16; ++r) base[((r & 3) + 8 * (r >> 2)) * 132 + j * 32] = acc[i][j][r];
            __syncthreads();
#pragma unroll
            for (int q = 0; q < 8; ++q) {
                const int c = tid + NTHREADS * q, lr = c >> 5, ch = c & 31;
                const int grow = m0 + (lr >> 5) * 64 + i * 32 + (lr & 31), gcol = n0 + ch * 4;
                const f32x4 mv = *(const f32x4*)((const float*)lds + lr * 132 + ch * 4), xv = *(const f32x4*)(x + (size_t)grow * 1024 + gcol), gv = *(const f32x4*)(gt1 + gcol);
                *(f32x4*)(x1 + (size_t)grow * 1024 + gcol) = xv + gv * mv;
            }
        }
    }
}
__device__ __forceinline__ void p8_cvt_experts(const Params& p) {
    const size_t n8 = (size_t)16384 * 1024 / 8;
    for (size_t i = (size_t)blockIdx.x * NTHREADS + threadIdx.x; i < 2 * n8; i += (size_t)gridDim.x * NTHREADS) {
        const int which = i >= n8; const size_t e = (which ? i - n8 : i) * 8;
        const float* src = p.in[which ? 32 : 31] + e;
        const f32x4 a = *(const f32x4*)src, b = *(const f32x4*)(src + 4);
        u32x4 w; w.x = pk2(a[0], a[1]); w.y = pk2(a[2], a[3]); w.z = pk2(b[0], b[1]); w.w = pk2(b[2], b[3]);
        *(u32x4*)((bf16_t*)(p.ws + (which ? OFF_EUP : OFF_EDOWN)) + e) = w;
    }
}
__device__ __forceinline__ void p9_query(const Params& p, unsigned char* lds) {
    const ALoadPlain al{(const bf16_t*)(p.ws + OFF_H), 1024};
    for (int u = blockIdx.x; u < 16 * 64; u += gridDim.x) {
        const int tn = u & 15, tm = u >> 4, m0 = tm * 256, n0 = tn * 128;
        f32x16 acc[2][2]; zero_acc(acc);
        gemm_accum(acc, al, (const bf16_t*)(p.ws + OFF_WQRY), 1024, 1024, m0, n0, lds);
        store_tile_bf16(acc, (bf16_t*)((unsigned char*)p.out + DO_Q2), 2048, m0, n0, lds);
    }
}
__device__ constexpr int CAND_A[50] = {0,0,0,0,0,0,0,0,0,0,0,0,0,0,0,0, 1,1,1,1,1,1,1,1, 2,2,2,2,2, 3,3,3,3, 4,4,4, 5,5, 6,6, 7,7, 8, 9, 10, 11, 12, 13, 14, 15};
__device__ constexpr int CAND_B[50] = {0,1,2,3,4,5,6,7,8,9,10,11,12,13,14,15, 0,1,2,3,4,5,6,7, 0,1,2,3,4, 0,1,2,3, 0,1,2, 0,1, 0,1, 0,1, 0, 0, 0, 0, 0, 0, 0, 0};
__device__ __forceinline__ float knock(float v, float m, float neg) { float o; asm volatile("v_cmp_eq_f32 vcc, %1, %2\n\tv_cndmask_b32 %0, %1, %3, vcc" : "=v"(o) : "v"(v), "v"(m), "v"(neg) : "vcc"); return o; }
__device__ __forceinline__ void knock_sel(float& v, int& e, float m, float neg, int ce) { asm volatile("v_cmp_eq_f32 vcc, %0, %2\n\tv_cndmask_b32 %0, %0, %3, vcc\n\tv_cndmask_b32 %1, %1, %4, vcc" : "+v"(v), "+v"(e) : "v"(m), "v"(neg), "v"(ce) : "vcc"); }
template <int J>
__device__ __forceinline__ void p10_half(const Params& p, int t, int head, int r32, int hi, float (&tvj)[16], int (&tij)[16]) {
    const float NEG = -3.0e38f;
    const bf16_t* qrow = (const bf16_t*)((const unsigned char*)p.out + DO_Q2) + (size_t)t * 2048 + head * 256 + J * 128 + hi * 8;
    const bf16_t* krow = (const bf16_t*)(p.ws + (J ? OFF_SK2 : OFF_SK1)) + (size_t)r32 * 128 + hi * 8;
    f32x16 acc[4];
#pragma unroll
    for (int f = 0; f < 4; ++f)
#pragma unroll
        for (int r = 0; r < 16; ++r) acc[f][r] = 0.f;
#pragma unroll 2
    for (int s = 0; s < 8; ++s) {
        const bf16x8 bq = *(const bf16x8*)(qrow + s * 16);
#pragma unroll
        for (int f = 0; f < 4; ++f) { const bf16x8 ak = *(const bf16x8*)(krow + (size_t)f * 32 * 128 + s * 16); acc[f] = MFMA32(ak, bq, acc[f]); }
    }
    float v[64];
#pragma unroll
    for (int f = 0; f < 4; ++f)
#pragma unroll
        for (int r = 0; r < 16; ++r) v[f * 16 + r] = __uint_as_float((__float_as_uint(acc[f][r]) & ~0x7Fu) | (unsigned)(f * 32 + (r & 3) + 8 * (r >> 2) + 4 * hi));
    float cand[32];
#pragma unroll
    for (int it = 0; it < 16; ++it) {
        float m = v[0];
#pragma unroll
        for (int i = 1; i < 64; ++i) m = fmaxf(m, v[i]);
        cand[it] = m;
#pragma unroll
        for (int i = 0; i < 64; ++i) v[i] = knock(v[i], m, NEG);
    }
#pragma unroll
    for (int it = 0; it < 16; ++it) cand[16 + it] = __shfl_xor(cand[it], 32);
#pragma unroll
    for (int it = 0; it < 16; ++it) {
        float m = cand[0];
#pragma unroll
        for (int i = 1; i < 32; ++i) m = fmaxf(m, cand[i]);
        const unsigned mb = __float_as_uint(m);
        tvj[it] = __uint_as_float(mb & ~0x7Fu); tij[it] = (int)(mb & 0x7Fu);
#pragma unroll
        for (int i = 0; i < 32; ++i) cand[i] = knock(cand[i], m, NEG);
    }
}
__device__ __forceinline__ void p10_task(const Params& p, int task, int lane) {
    const int head = task & 7, tile = task >> 3, r32 = lane & 31, hi = lane >> 5, t = tile * 32 + r32;
    const float NEG = -3.0e38f;
    float tv0[16], tv1[16]; int ti0[16], ti1[16];
    p10_half<0>(p, t, head, r32, hi, tv0, ti0);
    p10_half<1>(p, t, head, r32, hi, tv1, ti1);
    float cs[50]; int ce[50];
#pragma unroll
    for (int c = 0; c < 50; ++c) { cs[c] = tv0[CAND_A[c]] + tv1[CAND_B[c]]; ce[c] = ti0[CAND_A[c]] * 128 + ti1[CAND_B[c]]; }
    float gv[16]; int ge[16];
#pragma unroll
    for (int it = 0; it < 16; ++it) {
        float m = cs[0];
#pragma unroll
        for (int i = 1; i < 50; ++i) m = fmaxf(m, cs[i]);
        int e = 0;
#pragma unroll
        for (int i = 0; i < 50; ++i) knock_sel(cs[i], e, m, NEG, ce[i]);
        gv[it] = m; ge[it] = e;
    }
    float sum = 0.f; const float gmax = gv[0];
#pragma unroll
    for (int it = 0; it < 16; ++it) { gv[it] = __expf(gv[it] - gmax); sum += gv[it]; }
    const float inv = 1.f / sum;
    if (hi == 0) {
        int* io = (int*)(p.ws + OFF_IDX) + (size_t)t * 128 + head * 16; float* go = (float*)(p.ws + OFF_GATES) + (size_t)t * 128 + head * 16;
#pragma unroll
        for (int q = 0; q < 4; ++q) {
            *(int4*)(io + 4 * q) = make_int4(ge[4 * q], ge[4 * q + 1], ge[4 * q + 2], ge[4 * q + 3]);
            *(f32x4*)(go + 4 * q) = (f32x4){gv[4 * q] * inv, gv[4 * q + 1] * inv, gv[4 * q + 2] * inv, gv[4 * q + 3] * inv};
        }
    }
}
__device__ __forceinline__ void p10_route(const Params& p) {
    const int lane = threadIdx.x & 63, gw = blockIdx.x * 8 + (threadIdx.x >> 6), nw = gridDim.x * 8;
    for (int task = gw; task < 512 * 8; task += nw) p10_task(p, task, lane);
}
__device__ __forceinline__ float gelu_tanh(float x) { const float u = 0.7978845608028654f * (x + 0.044715f * x * x * x); return 0.5f * x * (1.f + tanhf_(u)); }
__device__ __forceinline__ void p11_gather(const Params& p) {
    const int lane = threadIdx.x & 63, gw = blockIdx.x * 8 + (threadIdx.x >> 6), nw = gridDim.x * 8;
    const bf16_t* ED = (const bf16_t*)(p.ws + OFF_EDOWN); const bf16_t* EU = (const bf16_t*)(p.ws + OFF_EUP);
    for (int t = gw; t < T_TOK; t += nw) {
        const bf16_t* hrow = (const bf16_t*)(p.ws + OFF_H) + (size_t)t * 1024;
        const u32x4 h0 = *(const u32x4*)(hrow + lane * 8), h1 = *(const u32x4*)(hrow + 512 + lane * 8);
        float hv[16], acc[16];
#pragma unroll
        for (int i = 0; i < 4; ++i) { hv[2 * i] = lo_f(h0[i]); hv[2 * i + 1] = hi_f(h0[i]); hv[8 + 2 * i] = lo_f(h1[i]); hv[8 + 2 * i + 1] = hi_f(h1[i]); }
#pragma unroll
        for (int i = 0; i < 16; ++i) acc[i] = 0.f;
        const int* ip = (const int*)(p.ws + OFF_IDX) + (size_t)t * 128; const float* gp = (const float*)(p.ws + OFF_GATES) + (size_t)t * 128;
        const int i0 = ip[lane], i1 = ip[64 + lane]; const float g0 = gp[lane], g1 = gp[64 + lane];
        for (int pg = 0; pg < 32; ++pg) {
            int e[4]; float g[4]; u32x4 d[4][2], uu[4][2];
#pragma unroll
            for (int k = 0; k < 4; ++k) {
                const int pi = pg * 4 + k;
                e[k] = __shfl(pi < 64 ? i0 : i1, pi & 63); g[k] = __shfl(pi < 64 ? g0 : g1, pi & 63);
                const bf16_t* dr = ED + (size_t)e[k] * 1024; const bf16_t* ur = EU + (size_t)e[k] * 1024;
                d[k][0] = *(const u32x4*)(dr + lane * 8); d[k][1] = *(const u32x4*)(dr + 512 + lane * 8);
                uu[k][0] = *(const u32x4*)(ur + lane * 8); uu[k][1] = *(const u32x4*)(ur + 512 + lane * 8);
            }
            float dot[4];
#pragma unroll
            for (int k = 0; k < 4; ++k) {
                float s = 0.f;
#pragma unroll
                for (int i = 0; i < 4; ++i) { s += hv[2 * i] * lo_f(d[k][0][i]) + hv[2 * i + 1] * hi_f(d[k][0][i]) + hv[8 + 2 * i] * lo_f(d[k][1][i]) + hv[8 + 2 * i + 1] * hi_f(d[k][1][i]); }
                dot[k] = s;
            }
#pragma unroll
            for (int o = 32; o; o >>= 1) {
#pragma unroll
                for (int k = 0; k < 4; ++k) dot[k] += __shfl_xor(dot[k], o);
            }
#pragma unroll
            for (int k = 0; k < 4; ++k) {
                const float a = gelu_tanh(dot[k]) * g[k];
#pragma unroll
                for (int i = 0; i < 4; ++i) { acc[2 * i] += a * lo_f(uu[k][0][i]); acc[2 * i + 1] += a * hi_f(uu[k][0][i]); acc[8 + 2 * i] += a * lo_f(uu[k][1][i]); acc[8 + 2 * i + 1] += a * hi_f(uu[k][1][i]); }
            }
        }
        const int b = t >> 12;
        const float* gt2 = (const float*)(p.ws + OFF_MOD) + b * 6144 + 5120;
        const float* x1 = (const float*)(p.ws + OFF_X1) + (size_t)t * 1024; float* o = p.out + (size_t)t * 1024;
#pragma unroll
        for (int half = 0; half < 2; ++half)
#pragma unroll
            for (int q = 0; q < 2; ++q) {
                const int c0 = half * 512 + lane * 8 + q * 4;
                const f32x4 xv = *(const f32x4*)(x1 + c0), gv = *(const f32x4*)(gt2 + c0);
                const f32x4 av = {acc[half * 8 + q * 4], acc[half * 8 + q * 4 + 1], acc[half * 8 + q * 4 + 2], acc[half * 8 + q * 4 + 3]};
                *(f32x4*)(o + c0) = xv + gv * av * DBG_FFN;
            }
    }
}

__global__ void __launch_bounds__(NTHREADS) mega(Params p) {
    __shared__ __attribute__((aligned(16))) unsigned char lds[2 * G_STAGE];
    cg::grid_group grid = cg::this_grid();
    const bool multi = (p.phase_hi - p.phase_lo) > 1;
#define PHASE(N, BODY) if (p.phase_lo <= N && N < p.phase_hi) { BODY; if (multi && N + 1 < p.phase_hi) grid.sync(); }
    PHASE(0, p0_prep(p, lds))
    PHASE(1, (modnorm_phase<true>(p, p.in[0], p.in[5], 0, (bf16_t*)((unsigned char*)p.out + DO_H), lds), p1_finalize_mod(p)))
    PHASE(2, p2_proj(p, lds))
    PHASE(3, p3_small(p))
    PHASE(4, p4_rwkv_prep(p))
    PHASE(5, p5_attn_scan(p, lds))
    PHASE(6, p6_merge(p, lds))
    PHASE(7, p7_mix(p, lds))
    PHASE(8, (modnorm_phase<false>(p, (const float*)(p.ws + OFF_X1), p.in[27], 3072, (bf16_t*)(p.ws + OFF_H), lds), p8_cvt_experts(p)))
    PHASE(9, p9_query(p, lds))
    PHASE(10, p10_route(p))
    PHASE(11, p11_gather(p))
}

extern "C" void kernel_launch(void* const* d_in, const int* in_sizes, int n_in,
                              void* d_out, int out_size, void* d_ws, size_t ws_size,
                              hipStream_t stream) {
    static int grid_blocks = 0;
    if (!grid_blocks) {
        int dev = 0, cus = 0, per_cu = 0;
        (void)hipGetDevice(&dev);
        (void)hipDeviceGetAttribute(&cus, hipDeviceAttributeMultiprocessorCount, dev);
        (void)hipOccupancyMaxActiveBlocksPerMultiprocessor(&per_cu, mega, NTHREADS, 0);
        if (per_cu > 1) per_cu = 1;
        grid_blocks = cus * per_cu;
    }
    Params p{};
    for (int i = 0; i < 33; ++i) p.in[i] = (const float*)d_in[i];
    p.out = (float*)d_out; p.ws = (unsigned char*)d_ws; p.phase_lo = 0; p.phase_hi = 12;
    void* args[] = {&p};
    hipError_t e = hipLaunchCooperativeKernel((void*)mega, dim3(grid_blocks), dim3(NTHREADS), args, 0, stream);
    if (e != hipSuccess) fprintf(stderr, "cooperative launch failed: %s (grid %d)\n", hipGetErrorString(e), grid_blocks);
}
```

```cpp
#include <hip/hip_runtime.h>
#include <hip/hip_cooperative_groups.h>
#include <cstdio>
#include <cstdint>
namespace cg = cooperative_groups;

typedef unsigned short bf16_t;
typedef short bf16x8 __attribute__((ext_vector_type(8)));
typedef float f32x16 __attribute__((ext_vector_type(16)));
typedef float f32x4 __attribute__((ext_vector_type(4)));
typedef unsigned u32x4 __attribute__((ext_vector_type(4)));
typedef unsigned u32x2 __attribute__((ext_vector_type(2)));
typedef float f32x2 __attribute__((ext_vector_type(2)));

#define NTHREADS 512
#ifndef SB_NOSTORE
#define SB_NOSTORE 0
#endif
#define CHUNKED 1
#ifndef DBG_FFN
#define DBG_FFN 1.f
#endif
#define MFMA32(a, b, c) __builtin_amdgcn_mfma_f32_32x32x16_bf16((a), (b), (c), 0, 0, 0)

constexpr int T_TOK = 16384, SEQ = 4096, NB = 4, DM = 1024;
constexpr int NPA = 2304;
constexpr int C_QA = 0, C_KVA = 256, C_KR = 384, C_RW = 416;
constexpr int C_R = C_RW, C_K = C_RW + 512, C_V = C_RW + 1024, C_WD = C_RW + 1536, C_AD = C_RW + 1600, C_GD = C_RW + 1664;
constexpr size_t MiB = 1u << 20;
constexpr size_t OFF_WINA = 0, OFF_WG = OFF_WINA + (size_t)NPA * 1024 * 2, OFF_WUQ = OFF_WG + 2048 * 1024 * 2, OFF_WUKV = OFF_WUQ + 768 * 256 * 2,
                 OFF_WDEC = OFF_WUKV + 1024 * 128 * 2, OFF_WAAA = OFF_WDEC + 512 * 64 * 2, OFF_WGATE = OFF_WAAA + 512 * 64 * 2,
                 OFF_WOMLA = OFF_WGATE + 512 * 128 * 2, OFF_WORWKV = OFF_WOMLA + 1024 * 512 * 2, OFF_WOUT = OFF_WORWKV + 1024 * 512 * 2,
                 OFF_WQRY = OFF_WOUT + 1024 * 1024 * 2, OFF_SK1 = OFF_WQRY + 2048 * 1024 * 2, OFF_SK2 = OFF_SK1 + 128 * 128 * 2,
                 OFF_MODP = OFF_SK2 + 128 * 128 * 2, OFF_MOD = OFF_MODP + 16 * 4 * 6144 * 4, OFF_ROPE = OFF_MOD + 4 * 6144 * 4,
                 OFF_CTR = OFF_ROPE + (size_t)T_TOK * 32 * 4, OFF_BAR = OFF_CTR + 4096, OFF_GC = OFF_BAR + 16384, OFF_BONUS = OFF_GC + (size_t)(T_TOK / 32) * 512 * 4, OFF_END_W = OFF_BONUS + (size_t)T_TOK * 8 * 4;
static_assert(OFF_END_W <= 24 * MiB, "weights region");
constexpr size_t OFF_H = 24 * MiB;
constexpr size_t OFF_G8 = OFF_H;
constexpr size_t OFF_P = 56 * MiB;
constexpr size_t OFF_OMLA = OFF_P, OFF_YG = OFF_P + 16 * MiB, OFF_X1 = OFF_P;
constexpr size_t OFF_S = 128 * MiB;
constexpr size_t OFF_SR = OFF_S, OFF_SE = OFF_S + 16 * MiB, OFF_SKH = OFF_S + 32 * MiB, OFF_SV = OFF_S + 48 * MiB, OFF_SKK = OFF_S + 64 * MiB,
                 OFF_SB = OFF_S + 80 * MiB, OFF_SG = OFF_S + 96 * MiB;
constexpr size_t OFF_MERGED = OFF_S, OFF_EDOWN = OFF_S + 32 * MiB, OFF_EUP = OFF_S + 64 * MiB;
constexpr size_t OFF_IDX = 240 * MiB, OFF_GATES = 248 * MiB;
constexpr size_t DO_Q = 0, DO_K = 24 * MiB, DO_VT = 48 * MiB, DO_Q2 = 0, DO_H = 0;

struct Params {
    const float* in[33];
    float* out;
    unsigned char* ws;
    int pad0, pad1;
};

__device__ __forceinline__ int otid() { int t = threadIdx.x; asm volatile("" : "+v"(t)); return t; }
__device__ __forceinline__ float bf2f(bf16_t h) { return __uint_as_float((unsigned)h << 16); }
typedef __bf16 bf16v2_t __attribute__((ext_vector_type(2)));
__device__ __forceinline__ unsigned pk2(float lo, float hi) { const f32x2 v = {lo, hi}; bf16v2_t r = __builtin_convertvector(v, bf16v2_t); return *reinterpret_cast<unsigned*>(&r); }
__device__ __forceinline__ bf16_t f2bf(float f) { return (bf16_t)(pk2(f, 0.f) & 0xffffu); }
__device__ __forceinline__ float lo_f(unsigned w) { return __uint_as_float(w << 16); }
__device__ __forceinline__ float hi_f(unsigned w) { return __uint_as_float(w & 0xffff0000u); }
__device__ __forceinline__ f32x4 bf4(u32x2 w) { return (f32x4){lo_f(w.x), hi_f(w.x), lo_f(w.y), hi_f(w.y)}; }
__device__ __forceinline__ u32x2 pk4(f32x4 v) { u32x2 w; w.x = pk2(v[0], v[1]); w.y = pk2(v[2], v[3]); return w; }
__device__ __forceinline__ float wave_sum(float v) { for (int o = 32; o; o >>= 1) v += __shfl_xor(v, o); return v; }
__device__ __forceinline__ float xhalf_sum(float v) { return v + __shfl_xor(v, 32); }
__device__ __forceinline__ float xhalf_max(float v) { return fmaxf(v, __shfl_xor(v, 32)); }
__device__ __forceinline__ float sigmoidf_(float x) { return __builtin_amdgcn_rcpf(1.f + __expf(-x)); }
__device__ __forceinline__ float tanhf_(float x) { float e = __expf(-2.f * fabsf(x)); float t = (1.f - e) * __builtin_amdgcn_rcpf(1.f + e); return x < 0.f ? -t : t; }
__device__ __forceinline__ int crow(int reg, int hi) { return (reg & 3) + 8 * (reg >> 2) + 4 * hi; }
__device__ __forceinline__ bf16x8 as_bf16x8(u32x4 w) { return *reinterpret_cast<bf16x8*>(&w); }


#define XB_TMO      128
#define XB_XCNT(j)  (256  + 64 * (j))
#define XB_XSUB(j)  (1280 + 64 * (j))
#define XB_XGEN(j)  (2304 + 64 * (j))
#define XB_TOP      3328
#define XB_TOPGEN   3392
#define XCD_BAR_WORDS 3456
#define XB_SPIN_CAP (1u << 18)
#define LAS __attribute__((address_space(3)))
__device__ __forceinline__ unsigned xb_ld(unsigned* p)              { return __hip_atomic_load(p, __ATOMIC_RELAXED, __HIP_MEMORY_SCOPE_AGENT); }
__device__ __forceinline__ unsigned xb_add(unsigned* p, unsigned v) { return __hip_atomic_fetch_add(p, v, __ATOMIC_RELAXED, __HIP_MEMORY_SCOPE_AGENT); }
__device__ __forceinline__ unsigned xb_xcc_id() { return (unsigned)__builtin_amdgcn_s_getreg((3 << 11) | 20) & 0xFu; }
#define XB_SPIN(cond, bar) do { unsigned _sp = 0; while (cond) { __builtin_amdgcn_s_sleep(1); \
    if ((++_sp & 255u) == 0u) { if (xb_ld(&(bar)[XB_TMO])) break; if (_sp > XB_SPIN_CAP) { atomicAdd(&(bar)[XB_TMO], 1u); break; } } } } while (0)
struct XcdBarrier { unsigned* bar; unsigned x; volatile LAS unsigned* st; };
__device__ __forceinline__ XcdBarrier xcd_barrier_post(unsigned* bar, volatile LAS unsigned* st) {
    XcdBarrier b; b.bar = bar; b.x = xb_xcc_id(); b.st = st;
    if (threadIdx.x == 0) (void)xb_add(&bar[XB_XCNT(b.x)], 1u);
    return b;
}
__device__ __forceinline__ void xcd_barrier_complete(unsigned* bar, unsigned x, unsigned& nloc, unsigned& nx) {
    const unsigned G = gridDim.x * gridDim.y * gridDim.z;
    unsigned sum, cnt, mine, sp = 0u;
    for (;;) {
        sum = 0u; cnt = 0u; mine = 0u;
#pragma unroll
        for (unsigned j = 0; j < 16; ++j) { const unsigned c = xb_ld(&bar[XB_XCNT(j)]); sum += c; cnt += (c > 0u) ? 1u : 0u; mine = (j == x) ? c : mine; }
        if (sum == G) break;
        __builtin_amdgcn_s_sleep(1);
        if ((++sp & 255u) == 0u) { if (xb_ld(&bar[XB_TMO])) break; if (sp > XB_SPIN_CAP) { atomicAdd(&bar[XB_TMO], 1u); break; } }
    }
    nloc = mine > 0u ? mine : 1u; nx = cnt > 0u ? cnt : 1u;
}
__device__ __forceinline__ void xcd_barrier(const XcdBarrier& b) {
    asm volatile("s_waitcnt vmcnt(0)" ::: "memory");
    __syncthreads();
    if (threadIdx.x == 0) {
        unsigned* bar = b.bar;
        __builtin_amdgcn_s_waitcnt(0);
        unsigned nloc = b.st[0], nx = b.st[1];
        if (nloc == 0u) { xcd_barrier_complete(bar, b.x, nloc, nx); b.st[0] = nloc; b.st[1] = nx; }
        const unsigned old = xb_add(&bar[XB_XSUB(b.x)], 1u);
        const unsigned gen = old / nloc;
        if (old + 1u == (gen + 1u) * nloc) {
            __builtin_amdgcn_fence(__ATOMIC_RELEASE, "agent");
            asm volatile("s_waitcnt vmcnt(0)" ::: "memory");
            const unsigned og = xb_add(&bar[XB_TOP], 1u);
            const unsigned tg = og / nx;
            if (og + 1u == (tg + 1u) * nx) xb_add(&bar[XB_TOPGEN], 1u);
            else XB_SPIN(xb_ld(&bar[XB_TOPGEN]) == tg, bar);
            __builtin_amdgcn_fence(__ATOMIC_ACQUIRE, "agent");
            xb_add(&bar[XB_XGEN(b.x)], 1u);
            asm volatile("s_waitcnt vmcnt(0)" ::: "memory");
        } else {
            XB_SPIN(xb_ld(&bar[XB_XGEN(b.x)]) == gen, bar);
            __builtin_amdgcn_fence(__ATOMIC_ACQUIRE, "agent");
            asm volatile("s_waitcnt vmcnt(0)" ::: "memory");
        }
    }
    __syncthreads();
}


namespace pg8 {
#define PG8_LAS __attribute__((address_space(3)))
constexpr int BM = 256, BK = 64, HALF = 128, HTB = HALF * BK * 2, STAGE_BYTES = 8 * HTB, NXCD = 8, WGM = 8;
__host__ __device__ __forceinline__ int lds_byte(int r, int c) { const int st = (r >> 4) * 2 + (c >> 5), rr = r & 15, cc = c & 31, ob = rr * 64 + cc * 2; return st * 1024 + (ob ^ (((ob >> 9) & 1) << 5)); }
__host__ __device__ __forceinline__ void stage_rc(int b, int& R, int& C) { const int st = b / 1024, sb = b % 1024, swz = sb ^ (((sb >> 9) & 1) << 5); R = (st >> 1) * 16 + swz / 64; C = (st & 1) * 32 + (swz % 64) / 2; }
__host__ __device__ __forceinline__ int perm32(int rho) { const int n = rho >> 4, i = rho & 15; return 8 * (i >> 2) + 4 * n + (i & 3); }
struct Unit { int pm, pn; };
struct Gemm { const bf16_t* A; const bf16_t* Bt; int M, N, K; };
struct StaticOrder {
    int nM, nN, nwg, G, c;
    __host__ __device__ void init(int M, int N, int G_, int c_) { nM = M / BM; nN = N / BM; nwg = nM * nN; G = G_; c = c_; }
    __host__ __device__ bool next(int i, Unit& u) const {
        const long L = (long)i * G + c; if (L >= nwg) return false;
        int wgid = (int)L; { const int q = nwg / NXCD, r = nwg % NXCD, xcd = wgid % NXCD, off = wgid / NXCD; wgid = (xcd < r ? xcd * (q + 1) : r * (q + 1) + (xcd - r) * q) + off; }
        const int nig = WGM * nN, gid = wgid / nig, fm = gid * WGM, gsz = (nM - fm) < WGM ? (nM - fm) : WGM;
        u.pm = fm + ((wgid % nig) % gsz); u.pn = (wgid % nig) / gsz; return true;
    }
    __device__ __forceinline__ void a_ready(const Unit&) const {}
    __device__ __forceinline__ void done(const Unit&) const {}
};
template <class Epi, class Sched>
__device__ __forceinline__ void gemm_phase(PG8_LAS unsigned char* lds, const Gemm g, const Sched& S, const Epi& E) {
    int tid_ = threadIdx.x; asm volatile("" : "+v"(tid_));
    const int tid = tid_, wid = __builtin_amdgcn_readfirstlane(tid >> 6), lane = tid & 63, wr = wid >> 2, wc = wid & 3, fr = lane & 15, fq = lane >> 4;
    const int K = g.K, nt = K / BK;
    unsigned voffA[2], voffB[2];
#pragma unroll
    for (int i = 0; i < 2; ++i) { int R, C; stage_rc(tid * 16 + i * 8192, R, C); const int Rb = Epi::PERM ? ((R & ~31) + perm32(R & 31)) : R;
        voffA[i] = (unsigned)(R * K + C) * 2u; voffB[i] = (unsigned)(Rb * K + C) * 2u; }
    const size_t kstep = (size_t)(BK * 2);
    const size_t hstep = (size_t)HALF * K * 2;
    const size_t tstep = 2 * hstep;
    const unsigned ldsw = (unsigned)wid * 1024u;
    const int aoff = lds_byte(wr * 64 + fr, fq * 8), boff = lds_byte(wc * 32 + fr, fq * 8);
#define PG8_SA(b, h) (((b) * 2 + (h)) * HTB)
#define PG8_SB(b, h) ((4 + (b) * 2 + (h)) * HTB)
#define PG8_STAGE(bufoff, gbase, voff) do { _Pragma("unroll") for (int _i = 0; _i < 2; ++_i) \
        __builtin_amdgcn_global_load_lds((const unsigned*)((const char*)(gbase) + (voff)[_i]), (PG8_LAS unsigned*)(lds + (bufoff) + ldsw + _i * 8192), 16, 0, 0); } while (0)
#define PG8_LDA(dst, b, h) do { _Pragma("unroll") for (int m = 0; m < 4; ++m) _Pragma("unroll") for (int k = 0; k < 2; ++k) dst[m][k] = *(const PG8_LAS bf16x8*)(lds + PG8_SA(b, h) + aoff + m * 2048 + k * 1024); } while (0)
#define PG8_LDB(dst, b, h) do { _Pragma("unroll") for (int n = 0; n < 2; ++n) _Pragma("unroll") for (int k = 0; k < 2; ++k) dst[n][k] = *(const PG8_LAS bf16x8*)(lds + PG8_SB(b, h) + boff + n * 2048 + k * 1024); } while (0)
#define PG8_MMA(ai, bj, At, Bt) do { __builtin_amdgcn_s_setprio(1); _Pragma("unroll") for (int m = 0; m < 4; ++m) _Pragma("unroll") for (int n = 0; n < 2; ++n) _Pragma("unroll") for (int k = 0; k < 2; ++k) \
        acc[ai][bj][m][n] = __builtin_amdgcn_mfma_f32_16x16x32_bf16(Bt[n][k], At[m][k], acc[ai][bj][m][n], 0, 0, 0); __builtin_amdgcn_s_setprio(0); } while (0)
#define PG8_WAIT_V(n) asm volatile("s_waitcnt vmcnt(" #n ")" ::: "memory")
#define PG8_WAIT_L(n) asm volatile("s_waitcnt lgkmcnt(" #n ")" ::: "memory")
#define PG8_BAR __builtin_amdgcn_s_barrier()
#define PG8_SCHED __builtin_amdgcn_sched_barrier(0)
    Unit cur, nxt; int ui = 0;
    if (!S.next(0, cur)) return;
    f32x4 acc[2][2][4][2];
#pragma unroll
    for (int a = 0; a < 2; ++a)
#pragma unroll
        for (int b = 0; b < 2; ++b)
#pragma unroll
            for (int m = 0; m < 4; ++m)
#pragma unroll
                for (int n = 0; n < 2; ++n) acc[a][b][m][n] = (f32x4){0.f, 0.f, 0.f, 0.f};
    bf16x8 At[4][2], B0[2][2], B1[2][2];
    const char* cA = (const char*)g.A + (size_t)cur.pm * tstep; const char* cB = (const char*)g.Bt + (size_t)cur.pn * tstep;
    S.a_ready(cur);
    PG8_STAGE(PG8_SB(0, 0), cB, voffB); PG8_STAGE(PG8_SA(0, 0), cA, voffA); PG8_STAGE(PG8_SB(0, 1), cB + hstep, voffB); PG8_STAGE(PG8_SA(0, 1), cA + hstep, voffA);
    if (wr == 1) PG8_BAR;
    PG8_WAIT_V(4); PG8_BAR;
    PG8_STAGE(PG8_SB(1, 0), cB + kstep, voffB); PG8_STAGE(PG8_SA(1, 0), cA + kstep, voffA); PG8_STAGE(PG8_SB(1, 1), cB + hstep + kstep, voffB);
    PG8_WAIT_V(6); PG8_BAR;
    for (;;) {
        const bool has_next = S.next(ui + 1, nxt);
        const char* nA = has_next ? (const char*)g.A + (size_t)nxt.pm * tstep : cA; const char* nB = has_next ? (const char*)g.Bt + (size_t)nxt.pn * tstep : cB;
        for (int t = 0; t < nt; t += 2) {
            const bool last = (t == nt - 2);
            const char* a1 = cA + (size_t)(t + 1) * kstep;
            const char* a2 = last ? nA : cA + (size_t)(t + 2) * kstep; const char* b2 = last ? nB : cB + (size_t)(t + 2) * kstep;
            const char* a3 = a2 + kstep; const char* b3 = b2 + kstep;
            if (last && has_next) S.a_ready(nxt);
            PG8_LDB(B0, 0, 0); PG8_SCHED; PG8_LDA(At, 0, 0); PG8_STAGE(PG8_SA(1, 1), a1 + hstep, voffA);
            PG8_WAIT_L(8); PG8_BAR; PG8_WAIT_L(0); PG8_MMA(0, 0, At, B0); PG8_BAR; PG8_SCHED;
            PG8_LDB(B1, 0, 1); PG8_STAGE(PG8_SB(0, 0), b2, voffB);
            PG8_BAR; PG8_WAIT_L(0); PG8_MMA(0, 1, At, B1); PG8_BAR;
            PG8_LDA(At, 0, 1); PG8_STAGE(PG8_SA(0, 0), a2, voffA);
            PG8_BAR; PG8_WAIT_L(0); PG8_MMA(1, 0, At, B0); PG8_BAR; PG8_SCHED;
            PG8_STAGE(PG8_SB(0, 1), b2 + hstep, voffB);
            PG8_WAIT_V(6); PG8_BAR; PG8_MMA(1, 1, At, B1); PG8_BAR;
            PG8_LDB(B0, 1, 0); PG8_SCHED; PG8_LDA(At, 1, 0); PG8_STAGE(PG8_SA(0, 1), a2 + hstep, voffA);
            PG8_WAIT_L(8); PG8_BAR; PG8_WAIT_L(0); PG8_MMA(0, 0, At, B0); PG8_BAR; PG8_SCHED;
            PG8_LDB(B1, 1, 1); PG8_STAGE(PG8_SB(1, 0), b3, voffB);
            PG8_BAR; PG8_WAIT_L(0); PG8_MMA(0, 1, At, B1); PG8_BAR;
            PG8_LDA(At, 1, 1); PG8_STAGE(PG8_SA(1, 0), a3, voffA);
            PG8_BAR; PG8_WAIT_L(0); PG8_MMA(1, 0, At, B0); PG8_BAR; PG8_SCHED;
            PG8_STAGE(PG8_SB(1, 1), b3 + hstep, voffB);
            PG8_WAIT_V(6); PG8_BAR; PG8_MMA(1, 1, At, B1); PG8_BAR;
        }
        if constexpr (Epi::CHAIN) { if ((ui & 1) == 0) E.mid(acc, cur, wr, wc, fr, fq); else E(acc, cur, wr, wc, fr, fq); }
        else if constexpr (!Epi::AFTER_DRAIN) { E(acc, cur, wr, wc, fr, fq); S.done(cur); }
        if (!has_next) break;
        if (!(Epi::CHAIN && (ui & 1) == 0))
#pragma unroll
        for (int a = 0; a < 2; ++a)
#pragma unroll
            for (int b = 0; b < 2; ++b)
#pragma unroll
                for (int m = 0; m < 4; ++m)
#pragma unroll
                    for (int n = 0; n < 2; ++n) acc[a][b][m][n] = (f32x4){0.f, 0.f, 0.f, 0.f};
        cur = nxt; cA = nA; cB = nB; ++ui;
    }
    PG8_WAIT_V(0);
    if (wr == 0) PG8_BAR;
    PG8_BAR;
    if constexpr (Epi::AFTER_DRAIN) { E.fused(acc, cur, wr, wc, fr, fq, lds, wid, lane); S.done(cur); }
#undef PG8_SA
#undef PG8_SB
#undef PG8_STAGE
#undef PG8_LDA
#undef PG8_LDB
#undef PG8_MMA
#undef PG8_WAIT_V
#undef PG8_WAIT_L
#undef PG8_BAR
#undef PG8_SCHED
}

__device__ __forceinline__ u32x4 pk8(f32x4 a, f32x4 b) { u32x4 w; w.x = pk2(a[0], a[1]); w.y = pk2(a[2], a[3]); w.z = pk2(b[0], b[1]); w.w = pk2(b[2], b[3]); return w; }
__device__ __forceinline__ unsigned u8x4_sig(f32x4 v) { return (unsigned)__float2int_rn(255.f * sigmoidf_(v[0])) | ((unsigned)__float2int_rn(255.f * sigmoidf_(v[1])) << 8) | ((unsigned)__float2int_rn(255.f * sigmoidf_(v[2])) << 16) | ((unsigned)__float2int_rn(255.f * sigmoidf_(v[3])) << 24); }
__device__ __forceinline__ f32x4 u8x4_f(unsigned w) { return (f32x4){(float)(w & 255u), (float)((w >> 8) & 255u), (float)((w >> 16) & 255u), (float)(w >> 24)} * (1.f / 255.f); }
struct EpiStoreBf16 {
    static constexpr bool PERM = true, AFTER_DRAIN = false, CHAIN = false;
    bf16_t* O; int ldc;
    __device__ __forceinline__ void operator()(const f32x4 (&acc)[2][2][4][2], const Unit& u, int wr, int wc, int fr, int fq) const {
        const int row0 = u.pm * BM + wr * 64 + fr, col0 = u.pn * BM + wc * 32 + 8 * fq;
#pragma unroll
        for (int ai = 0; ai < 2; ++ai)
#pragma unroll
            for (int m = 0; m < 4; ++m) { bf16_t* rowp = O + (size_t)(row0 + ai * HALF + m * 16) * ldc + col0;
#pragma unroll
                for (int bj = 0; bj < 2; ++bj) *(u32x4*)(rowp + bj * HALF) = pk8(acc[ai][bj][m][0], acc[ai][bj][m][1]); }
    }
};
struct EpiProj {
    static constexpr bool PERM = true, AFTER_DRAIN = false, CHAIN = false;
    bf16_t* P; unsigned char* G8;
    __device__ __forceinline__ void operator()(const f32x4 (&acc)[2][2][4][2], const Unit& u, int wr, int wc, int fr, int fq) const {
        const int row0 = u.pm * BM + wr * 64 + fr;
        if (u.pn < NPA / 256) {
            const int col0 = u.pn * BM + wc * 32 + 8 * fq;
#pragma unroll
            for (int ai = 0; ai < 2; ++ai)
#pragma unroll
                for (int m = 0; m < 4; ++m) { bf16_t* rowp = P + (size_t)(row0 + ai * HALF + m * 16) * NPA + col0;
#pragma unroll
                    for (int bj = 0; bj < 2; ++bj) *(u32x4*)(rowp + bj * HALF) = pk8(acc[ai][bj][m][0], acc[ai][bj][m][1]); }
        } else {
            const int col0 = (u.pn - NPA / 256) * BM + wc * 32 + 8 * fq;
#pragma unroll
            for (int ai = 0; ai < 2; ++ai)
#pragma unroll
                for (int m = 0; m < 4; ++m) { unsigned char* rowp = G8 + (size_t)(row0 + ai * HALF + m * 16) * 2048 + col0;
#pragma unroll
                    for (int bj = 0; bj < 2; ++bj) { u32x2 w; w.x = u8x4_sig(acc[ai][bj][m][0]); w.y = u8x4_sig(acc[ai][bj][m][1]); *(u32x2*)(rowp + bj * HALF) = w; } }
        }
    }
};
template <bool SECOND> struct EpiMerge {
    static constexpr bool PERM = true, AFTER_DRAIN = false, CHAIN = false;
    bf16_t* Mg; const unsigned char* G8; int gcol;
    __device__ __forceinline__ void operator()(const f32x4 (&acc)[2][2][4][2], const Unit& u, int wr, int wc, int fr, int fq) const {
        const int row0 = u.pm * BM + wr * 64 + fr, col0 = u.pn * BM + wc * 32 + 8 * fq;
#pragma unroll
        for (int ai = 0; ai < 2; ++ai)
#pragma unroll
            for (int m = 0; m < 4; ++m) { const size_t row = (size_t)(row0 + ai * HALF + m * 16);
                __builtin_amdgcn_sched_barrier(0);
#pragma unroll
                for (int bj = 0; bj < 2; ++bj) {
                    const int c = col0 + bj * HALF;
                    const u32x2 g = *(const u32x2*)(G8 + row * 2048 + gcol + c);
                    f32x4 v0 = acc[ai][bj][m][0] * u8x4_f(g.x), v1 = acc[ai][bj][m][1] * u8x4_f(g.y);
                    if (SECOND) { const u32x4 pr = *(const u32x4*)(Mg + row * 1024 + c);
                        v0 += (f32x4){lo_f(pr.x), hi_f(pr.x), lo_f(pr.y), hi_f(pr.y)}; v1 += (f32x4){lo_f(pr.z), hi_f(pr.z), lo_f(pr.w), hi_f(pr.w)}; }
                    *(u32x4*)(Mg + row * 1024 + c) = pk8(v0, v1);
                } }
    }
};
struct EpiMergeChain {
    static constexpr bool PERM = true, AFTER_DRAIN = false, CHAIN = true;
    bf16_t* Mg; const unsigned char* G8;
    static __device__ __forceinline__ f32x4 g2e(unsigned w) { const f32x4 g = u8x4_f(w); return (f32x4){fmaxf(g[0], 1e-6f), fmaxf(g[1], 1e-6f), fmaxf(g[2], 1e-6f), fmaxf(g[3], 1e-6f)}; }
    static __device__ __forceinline__ f32x4 rcp4(f32x4 v) { return (f32x4){__builtin_amdgcn_rcpf(v[0]), __builtin_amdgcn_rcpf(v[1]), __builtin_amdgcn_rcpf(v[2]), __builtin_amdgcn_rcpf(v[3])}; }
    __device__ __forceinline__ void mid(f32x4 (&acc)[2][2][4][2], const Unit& u, int wr, int wc, int fr, int fq) const {
        const int row0 = u.pm * BM + wr * 64 + fr, col0 = u.pn * BM + wc * 32 + 8 * fq;
#pragma unroll
        for (int ai = 0; ai < 2; ++ai) {
            u32x2 G1[4][2], G2[4][2];
#pragma unroll
            for (int m = 0; m < 4; ++m)
#pragma unroll
                for (int bj = 0; bj < 2; ++bj) { const unsigned char* gp = G8 + (size_t)(row0 + ai * HALF + m * 16) * 2048 + col0 + bj * HALF; G1[m][bj] = *(const u32x2*)gp; G2[m][bj] = *(const u32x2*)(gp + 1024); }
#pragma unroll
            for (int m = 0; m < 4; ++m)
#pragma unroll
                for (int bj = 0; bj < 2; ++bj) { acc[ai][bj][m][0] *= u8x4_f(G1[m][bj].x) * rcp4(g2e(G2[m][bj].x)); acc[ai][bj][m][1] *= u8x4_f(G1[m][bj].y) * rcp4(g2e(G2[m][bj].y)); }
        }
    }
    __device__ __forceinline__ void operator()(const f32x4 (&acc)[2][2][4][2], const Unit& u, int wr, int wc, int fr, int fq) const {
        const int row0 = (u.pm - 64) * BM + wr * 64 + fr, col0 = (u.pn - 4) * BM + wc * 32 + 8 * fq;
#pragma unroll
        for (int ai = 0; ai < 2; ++ai) {
            u32x2 G2[4][2];
#pragma unroll
            for (int m = 0; m < 4; ++m)
#pragma unroll
                for (int bj = 0; bj < 2; ++bj) G2[m][bj] = *(const u32x2*)(G8 + (size_t)(row0 + ai * HALF + m * 16) * 2048 + 1024 + col0 + bj * HALF);
#pragma unroll
            for (int m = 0; m < 4; ++m)
#pragma unroll
                for (int bj = 0; bj < 2; ++bj)
                    *(u32x4*)(Mg + (size_t)(row0 + ai * HALF + m * 16) * 1024 + col0 + bj * HALF) = pk8(acc[ai][bj][m][0] * g2e(G2[m][bj].x), acc[ai][bj][m][1] * g2e(G2[m][bj].y));
        }
    }
};
struct ChainOrder {
    StaticOrder S;
    __host__ __device__ bool next(int i, Unit& u) const { if (!S.next(i >> 1, u)) return false; if (i & 1) { u.pm += 64; u.pn += 4; } return true; }
    __device__ __forceinline__ void a_ready(const Unit&) const {}
    __device__ __forceinline__ void done(const Unit&) const {}
};
struct EpiMix {
    static constexpr bool PERM = true, AFTER_DRAIN = false, CHAIN = false;
    const float* x; bf16_t* x1; const float* mod;
    __device__ __forceinline__ void operator()(const f32x4 (&acc)[2][2][4][2], const Unit& u, int wr, int wc, int fr, int fq) const {
        const int row0 = u.pm * BM + wr * 64 + fr, col0 = u.pn * BM + wc * 32 + 8 * fq;
        const float* gt1 = mod + ((u.pm * BM) >> 12) * 6144 + 2048;
        f32x4 g[2][2];
#pragma unroll
        for (int bj = 0; bj < 2; ++bj) { g[bj][0] = *(const f32x4*)(gt1 + col0 + bj * HALF); g[bj][1] = *(const f32x4*)(gt1 + col0 + bj * HALF + 4); }
#pragma unroll
        for (int am = 0; am < 4; ++am) {
            const int ai = am >> 1, m0 = (am & 1) * 2;
            f32x4 xv[2][2][2];
#pragma unroll
            for (int m = 0; m < 2; ++m)
#pragma unroll
                for (int bj = 0; bj < 2; ++bj) { const float* xp = x + (size_t)(row0 + ai * HALF + (m0 + m) * 16) * 1024 + col0 + bj * HALF; xv[m][bj][0] = *(const f32x4*)xp; xv[m][bj][1] = *(const f32x4*)(xp + 4); }
#pragma unroll
            for (int m = 0; m < 2; ++m)
#pragma unroll
                for (int bj = 0; bj < 2; ++bj)
                    *(u32x4*)(x1 + (size_t)(row0 + ai * HALF + (m0 + m) * 16) * 1024 + col0 + bj * HALF) = pk8(xv[m][bj][0] + g[bj][0] * acc[ai][bj][m0 + m][0], xv[m][bj][1] + g[bj][1] * acc[ai][bj][m0 + m][1]);
        }
    }
};
}

__device__ __forceinline__ void p0_mod_partials(const Params& p, unsigned char* lds, int task) {
    const int jb = task % 12, ks = task / 12, tid = otid();
    const float* c = p.in[1]; const float* w_ada = p.in[3];
    float* sc = (float*)lds;
    __syncthreads();
    if (tid < 256) { const int b = tid >> 6, k = tid & 63; const float v = c[b * 1024 + ks * 64 + k]; sc[tid] = v * sigmoidf_(v); }
    __syncthreads();
    const int j = jb * 512 + tid;
    float a0 = 0.f, a1 = 0.f, a2 = 0.f, a3 = 0.f;
    for (int k = 0; k < 64; ++k) { const float w = w_ada[(size_t)(ks * 64 + k) * 6144 + j]; a0 += sc[k] * w; a1 += sc[64 + k] * w; a2 += sc[128 + k] * w; a3 += sc[192 + k] * w; }
    float* modp = (float*)(p.ws + OFF_MODP) + (size_t)ks * 4 * 6144;
    modp[0 * 6144 + j] = a0; modp[1 * 6144 + j] = a1; modp[2 * 6144 + j] = a2; modp[3 * 6144 + j] = a3;
}
__device__ __forceinline__ void cvt_tile(const float* __restrict__ src, int ld, int K, int N, const float* __restrict__ g, bf16_t* __restrict__ dst, int tile, unsigned char* lds) {
    const int ntk = K / 64, tk = tile % ntk, tn = tile / ntk, k0 = tk * 64, n0 = tn * 256, tid = otid();
    bf16_t* tl = (bf16_t*)lds;
    f32x4 v[8];
#pragma unroll
    for (int i = 0; i < 8; ++i) {
        const int kr = (tid >> 4) + 32 * (i & 1), nc = (i >> 1) * 64 + (tid & 15) * 4, k = k0 + kr, n = n0 + nc;
        v[i] = (f32x4){0.f, 0.f, 0.f, 0.f};
        if (n < N) v[i] = *(const f32x4*)(src + (size_t)k * ld + n);
    }
    __syncthreads();
#pragma unroll
    for (int i = 0; i < 8; ++i) {
        const int kr = (tid >> 4) + 32 * (i & 1), nc = (i >> 1) * 64 + (tid & 15) * 4;
        const float gg = g ? g[k0 + kr] : 1.f;
        tl[(nc + 0) * 72 + kr] = f2bf(v[i][0] * gg); tl[(nc + 1) * 72 + kr] = f2bf(v[i][1] * gg); tl[(nc + 2) * 72 + kr] = f2bf(v[i][2] * gg); tl[(nc + 3) * 72 + kr] = f2bf(v[i][3] * gg);
    }
    __syncthreads();
#pragma unroll
    for (int i = 0; i < 4; ++i) { const int nl = (tid >> 3) + 64 * i, kc = tid & 7; *(u32x4*)(dst + (size_t)(n0 + nl) * K + k0 + kc * 8) = *(const u32x4*)(tl + nl * 72 + kc * 8); }
}
constexpr int NJOBS = 11; constexpr int NJOBS_EARLY = 2;
__device__ constexpr int J_IN[NJOBS]   = {6, 6, 9, 11, 15, 17, 19, 14, 25, 26, 28};
__device__ constexpr int J_COFF[NJOBS] = {0, 2208, 0, 0, 0, 0, 0, 0, 0, 0, 0};
__device__ constexpr int J_LD[NJOBS]   = {4256, 4256, 768, 1024, 512, 512, 512, 1024, 1024, 1024, 2048};
__device__ constexpr int J_K[NJOBS]    = {1024, 1024, 256, 128, 64, 64, 128, 512, 512, 1024, 1024};
__device__ constexpr int J_N[NJOBS]    = {2208, 2048, 768, 1024, 512, 512, 512, 1024, 1024, 1024, 2048};
__device__ constexpr int J_NPAD[NJOBS] = {NPA, 2048, 768, 1024, 512, 512, 512, 1024, 1024, 1024, 2048};
__device__ constexpr int J_G[NJOBS]    = {-1, -1, 8, 10, -1, -1, -1, -1, -1, -1, -1};
__device__ constexpr unsigned J_DST[NJOBS] = {(unsigned)OFF_WINA, (unsigned)OFF_WG, (unsigned)OFF_WUQ, (unsigned)OFF_WUKV, (unsigned)OFF_WDEC, (unsigned)OFF_WAAA, (unsigned)OFF_WGATE,
                                              (unsigned)OFF_WOMLA, (unsigned)OFF_WORWKV, (unsigned)OFF_WOUT, (unsigned)OFF_WQRY};
__device__ __forceinline__ void p0_prep(const Params& p, unsigned char* lds) {
    const int tid = otid(), nblk = gridDim.x, bid = blockIdx.x;
    if (bid == 0 && tid < 64) ((unsigned*)(p.ws + OFF_CTR))[tid] = 0u;
    int total = 192;
    for (int j = 0; j < NJOBS_EARLY; ++j) total += (J_NPAD[j] / 256) * (J_K[j] / 64);
    for (int task = bid; task < total; task += nblk) {
        if (task < 192) { p0_mod_partials(p, lds, task); continue; }
        int tt = task - 192;
        for (int j = 0; j < NJOBS_EARLY; ++j) {
            const int nt = (J_NPAD[j] / 256) * (J_K[j] / 64);
            if (tt < nt) { cvt_tile(p.in[J_IN[j]] + J_COFF[j], J_LD[j], J_K[j], J_N[j], J_G[j] >= 0 ? p.in[J_G[j]] : nullptr, (bf16_t*)(p.ws + J_DST[j]), tt, lds); break; }
            tt -= nt;
        }
    }
}
__device__ __forceinline__ void p0_late_weights(const Params& p, unsigned char* lds) {
    const int G = gridDim.x, nwg = (T_TOK / 256) * ((NPA + 2048) / 256), extra = nwg % G, c = blockIdx.x;
    const bool mine = extra == 0 || c >= extra; const int nb = extra == 0 ? G : G - extra, ci = extra == 0 ? c : c - extra;
    if (!mine) return;
    const int tid = otid();
    for (int i = ci * NTHREADS + tid; i < T_TOK * 16; i += nb * NTHREADS) {
        const int t = i >> 4, f = i & 15;
        const float inv_freq = exp2f(-(float)f * (13.287712379549449f / 16.f));
        const float ang = (float)((const int*)p.in[2])[t] * inv_freq;
        const float n = rintf(ang * 0.15915494309189535f);
        float r = fmaf(-n, 6.28318548202514648f, ang); r = fmaf(-n, -1.7484555e-7f, r);
        float* rp = (float*)(p.ws + OFF_ROPE) + (size_t)t * 32;
        rp[f] = __cosf(r); rp[16 + f] = __sinf(r);
    }
    for (int i = ci * NTHREADS + tid; i < 2 * 128 * 128; i += nb * NTHREADS) {
        const int which = i >> 14, e = i & 16383;
        ((bf16_t*)(p.ws + (which ? OFF_SK2 : OFF_SK1)))[e] = f2bf(p.in[which ? 30 : 29][e]);
    }
    int total = 0;
    for (int j = NJOBS_EARLY; j < NJOBS; ++j) total += (J_NPAD[j] / 256) * (J_K[j] / 64);
    for (int task = ci; task < total; task += nb) {
        int tt = task;
        for (int j = NJOBS_EARLY; j < NJOBS; ++j) {
            const int nt = (J_NPAD[j] / 256) * (J_K[j] / 64);
            if (tt < nt) { cvt_tile(p.in[J_IN[j]] + J_COFF[j], J_LD[j], J_K[j], J_N[j], J_G[j] >= 0 ? p.in[J_G[j]] : nullptr, (bf16_t*)(p.ws + J_DST[j]), tt, lds); break; }
            tt -= nt;
        }
    }
}

template <bool FROM_PART>
__device__ __forceinline__ void modnorm_phase(const Params& p, const float* __restrict__ src, const float* __restrict__ gain, int sh_col, bf16_t* __restrict__ dst, unsigned char* lds) {
    const int tid = otid(), lane = tid & 63, wid = tid >> 6;
    float* mul = (float*)lds; float* add = mul + 1024;
    for (int blk = blockIdx.x; blk < T_TOK / 64; blk += gridDim.x) {
        const int b = (blk * 64) / SEQ;
        f32x4 v[4][4];
        auto loadrows = [&](int tb) {
#pragma unroll
            for (int r = 0; r < 4; ++r) { const int t = blk * 64 + wid + 8 * (tb * 4 + r);
#pragma unroll
                for (int i = 0; i < 4; ++i) v[r][i] = FROM_PART ? *(const f32x4*)(src + (size_t)t * 1024 + i * 256 + lane * 4) : bf4(*(const u32x2*)((const bf16_t*)src + (size_t)t * 1024 + i * 256 + lane * 4)); }
        };
        auto process = [&](int tb) {
#pragma unroll
            for (int r = 0; r < 4; ++r) { const int t = blk * 64 + wid + 8 * (tb * 4 + r);
                float ss = 0.f;
#pragma unroll
                for (int i = 0; i < 4; ++i) ss += v[r][i][0] * v[r][i][0] + v[r][i][1] * v[r][i][1] + v[r][i][2] * v[r][i][2] + v[r][i][3] * v[r][i][3];
                ss = wave_sum(ss);
                const float rstd = rsqrtf(ss * (1.f / 1024.f) + 1e-6f);
#pragma unroll
                for (int i = 0; i < 4; ++i) {
                    const int c0 = i * 256 + lane * 4;
                    const f32x4 m = *(const f32x4*)(mul + c0), a = *(const f32x4*)(add + c0);
                    u32x2 w; w.x = pk2(v[r][i][0] * rstd * m[0] + a[0], v[r][i][1] * rstd * m[1] + a[1]); w.y = pk2(v[r][i][2] * rstd * m[2] + a[2], v[r][i][3] * rstd * m[3] + a[3]);
                    *(u32x2*)(dst + (size_t)t * 1024 + c0) = w;
                }
            }
        };
        loadrows(0);
        __syncthreads();
        for (int cidx = tid; cidx < 1024; cidx += NTHREADS) {
            float sh, sc;
            if (FROM_PART) {
                sh = p.in[4][sh_col + cidx]; sc = p.in[4][sh_col + 1024 + cidx];
                const float* mp = (const float*)(p.ws + OFF_MODP) + b * 6144;
                for (int ks = 0; ks < 16; ++ks) { sh += mp[(size_t)ks * 4 * 6144 + sh_col + cidx]; sc += mp[(size_t)ks * 4 * 6144 + sh_col + 1024 + cidx]; }
            } else {
                const float* m = (const float*)(p.ws + OFF_MOD) + b * 6144;
                sh = m[sh_col + cidx]; sc = m[sh_col + 1024 + cidx];
            }
            mul[cidx] = gain[cidx] * (1.f + sc); add[cidx] = sh;
        }
        __syncthreads();
        process(0);
        loadrows(1);
        process(1);
    }
}
__device__ __forceinline__ void p1_finalize_mod(const Params& p) {
    for (int i = blockIdx.x * NTHREADS + otid(); i < 4 * 6144; i += gridDim.x * NTHREADS) {
        const int j = i % 6144;
        float s = p.in[4][j];
        const float* mp = (const float*)(p.ws + OFF_MODP) + i;
        for (int ks = 0; ks < 16; ++ks) s += mp[(size_t)ks * 4 * 6144];
        ((float*)(p.ws + OFF_MOD))[i] = s;
    }
}

constexpr int LDS_MAIN = 155648;
constexpr int G_LDR = 144;
constexpr int G_ABYTES = 256 * G_LDR, G_BBYTES = 128 * G_LDR, G_STAGE = G_ABYTES + G_BBYTES;
struct ALoadPlain { const bf16_t* A; int lda; __device__ __forceinline__ u32x4 operator()(int row, int k) const { return *(const u32x4*)(A + (size_t)row * lda + k); } };

template <class AL>
__device__ __forceinline__ void gemm_accum(f32x16 (&acc)[2][2], const AL& al, const bf16_t* __restrict__ Bt, int ldb, int K, int m0, int n0, unsigned char* lds) {
    const int tid = threadIdx.x, lane = tid & 63, wid = tid >> 6, wm = wid >> 1, wn = wid & 1, r32 = lane & 31, hi = lane >> 5;
    u32x4 ra[4], rb[2];
    const int nk = K / 64;
    auto gload = [&](int kt) {
#pragma unroll
        for (int i = 0; i < 4; ++i) { const int c = tid + NTHREADS * i; ra[i] = al(m0 + (c >> 3), kt * 64 + (c & 7) * 8); }
#pragma unroll
        for (int i = 0; i < 2; ++i) { const int c = tid + NTHREADS * i; rb[i] = *(const u32x4*)(Bt + (size_t)(n0 + (c >> 3)) * ldb + kt * 64 + (c & 7) * 8); }
    };
    auto swrite = [&](int buf) {
        unsigned char* sa = lds + buf * G_STAGE; unsigned char* sb = sa + G_ABYTES;
#pragma unroll
        for (int i = 0; i < 4; ++i) { const int c = tid + NTHREADS * i; *(u32x4*)(sa + (c >> 3) * G_LDR + (c & 7) * 16) = ra[i]; }
#pragma unroll
        for (int i = 0; i < 2; ++i) { const int c = tid + NTHREADS * i; *(u32x4*)(sb + (c >> 3) * G_LDR + (c & 7) * 16) = rb[i]; }
    };
    __syncthreads();
    gload(0); swrite(0);
    __syncthreads();
    for (int kt = 0; kt < nk; ++kt) {
        if (kt + 1 < nk) gload(kt + 1);
        const unsigned char* sa = lds + (kt & 1) * G_STAGE + (wm * 64 + r32) * G_LDR + hi * 16;
        const unsigned char* sb = lds + (kt & 1) * G_STAGE + G_ABYTES + (wn * 64 + r32) * G_LDR + hi * 16;
#pragma unroll
        for (int s = 0; s < 4; ++s) {
            const bf16x8 a0 = *(const bf16x8*)(sa + s * 32), a1 = *(const bf16x8*)(sa + 32 * G_LDR + s * 32);
            const bf16x8 b0 = *(const bf16x8*)(sb + s * 32), b1 = *(const bf16x8*)(sb + 32 * G_LDR + s * 32);
            acc[0][0] = MFMA32(a0, b0, acc[0][0]); acc[0][1] = MFMA32(a0, b1, acc[0][1]);
            acc[1][0] = MFMA32(a1, b0, acc[1][0]); acc[1][1] = MFMA32(a1, b1, acc[1][1]);
        }
        if (kt + 1 < nk) swrite((kt + 1) & 1);
        __syncthreads();
    }
}
__device__ __forceinline__ void zero_acc(f32x16 (&acc)[2][2]) {
#pragma unroll
    for (int i = 0; i < 2; ++i)
#pragma unroll
        for (int j = 0; j < 2; ++j)
#pragma unroll
            for (int r = 0; r < 16; ++r) acc[i][j][r] = 0.f;
}

constexpr int E_LDR = 272;
__device__ __forceinline__ void store_tile_bf16(const f32x16 (&v)[2][2], bf16_t* __restrict__ C, int ldc, int m0, int n0, unsigned char* lds) {
    const int tid = threadIdx.x, lane = tid & 63, wid = tid >> 6, wm = wid >> 1, wn = wid & 1, r32 = lane & 31, hi = lane >> 5;
    __syncthreads();
    unsigned char* base = lds + (wm * 64 + 4 * hi) * E_LDR + (wn * 64 + r32) * 2;
#pragma unroll
    for (int i = 0; i < 2; ++i)
#pragma unroll
        for (int j = 0; j < 2; ++j)
#pragma unroll
            for (int r = 0; r < 16; ++r) *(bf16_t*)(base + (i * 32 + (r & 3) + 8 * (r >> 2)) * E_LDR + j * 64) = f2bf(v[i][j][r]);
    __syncthreads();
#pragma unroll
    for (int i = 0; i < 8; ++i) { const int c = tid + NTHREADS * i, row = c >> 4, ch = c & 15;
        *(u32x4*)(C + (size_t)(m0 + row) * ldc + n0 + ch * 8) = *(const u32x4*)(lds + row * E_LDR + ch * 16); }
}
__device__ __forceinline__ void p2_proj(const Params& p, PG8_LAS unsigned char* ldsl, unsigned char* lds) {
    pg8::StaticOrder S; S.init(T_TOK, NPA + 2048, gridDim.x, blockIdx.x);
    const pg8::Gemm g{(const bf16_t*)((const unsigned char*)p.out + DO_H), (const bf16_t*)(p.ws + OFF_WINA), T_TOK, NPA + 2048, 1024};
    const pg8::EpiProj E{(bf16_t*)(p.ws + OFF_P), p.ws + OFF_G8};
    pg8::gemm_phase(ldsl, g, S, E);
    p0_late_weights(p, lds);
}
#ifndef P3_REP_Q
#define P3_REP_Q 1
#endif
#ifndef P3_REP_KV
#define P3_REP_KV 1
#endif
#ifndef P3_REP_L
#define P3_REP_L 1
#endif
constexpr float EPSN = 1e-6f;
constexpr float QSCALE = 0.10206207261596575f * 1.4426950408889634f;
__device__ __forceinline__ float sumsq8(u32x4 w) {
    float s = 0.f;
#pragma unroll
    for (int i = 0; i < 4; ++i) { const float a = lo_f(w[i]), b = hi_f(w[i]); s += a * a + b * b; }
    return s;
}
__device__ __forceinline__ void p3_q_load(const Params& p, int task, int lane, u32x4 (&av)[16]) {
    const int tile = task >> 3, r32 = lane & 31, hi = lane >> 5, t = tile * 32 + r32;
    const bf16_t* arow = (const bf16_t*)(p.ws + OFF_P) + (size_t)t * NPA + C_QA + hi * 8;
#pragma unroll
    for (int s = 0; s < 16; ++s) av[s] = *(const u32x4*)(arow + s * 16);
}
__device__ __forceinline__ void p3_q_task(const Params& p, int task, int lane, const unsigned char* wq  , const u32x4 (&avin)[16]) {
    const int head = task & 7, tile = task >> 3, r32 = lane & 31, hi = lane >> 5, t = tile * 32 + r32;
    const unsigned char* wrow = wq + r32 * 528 + hi * 16;
    f32x16 acc[3];
#pragma unroll
    for (int f = 0; f < 3; ++f)
#pragma unroll
        for (int r = 0; r < 16; ++r) acc[f][r] = 0.f;
    float ss = 0.f;
#pragma unroll
    for (int s = 0; s < 16; ++s) {
        const u32x4 av = avin[s];
        ss += sumsq8(av);
        const bf16x8 a = as_bf16x8(av);
#pragma unroll
        for (int f = 0; f < 3; ++f) { const bf16x8 w = *(const bf16x8*)(wrow + f * 32 * 528 + s * 32); acc[f] = MFMA32(w, a, acc[f]); }
    }
    ss = xhalf_sum(ss);
    const float rstd = rsqrtf(ss * (1.f / 256.f) + EPSN);
    float sn = 0.f, sr = 0.f;
#pragma unroll
    for (int r = 0; r < 16; ++r) { acc[0][r] *= rstd; acc[1][r] *= rstd; acc[2][r] *= rstd; sn += acc[0][r] * acc[0][r] + acc[1][r] * acc[1][r]; sr += acc[2][r] * acc[2][r]; }
    sn = xhalf_sum(sn); sr = xhalf_sum(sr);
    const float rn = rsqrtf(sn * (1.f / 64.f) + EPSN) * QSCALE, rr = rsqrtf(sr * (1.f / 32.f) + EPSN) * QSCALE;
    const float* qn = p.in[12];
    bf16_t* qo = (bf16_t*)((unsigned char*)p.out + DO_Q) + (size_t)t * 768 + head * 96;
#pragma unroll
    for (int f = 0; f < 2; ++f)
#pragma unroll
        for (int rq = 0; rq < 4; ++rq) {
            const int f0 = f * 32 + 8 * rq + 4 * hi;
            const f32x4 g = *(const f32x4*)(qn + f0);
            u32x2 w; w.x = pk2(acc[f][rq * 4 + 0] * rn * g[0], acc[f][rq * 4 + 1] * rn * g[1]); w.y = pk2(acc[f][rq * 4 + 2] * rn * g[2], acc[f][rq * 4 + 3] * rn * g[3]);
            *(u32x2*)(qo + f0) = w;
        }
    const float* rope = (const float*)(p.ws + OFF_ROPE) + (size_t)t * 32;
#pragma unroll
    for (int rq = 0; rq < 2; ++rq) {
        const int i0 = 8 * rq + 4 * hi;
        const f32x4 g1 = *(const f32x4*)(qn + 64 + i0), g2 = *(const f32x4*)(qn + 80 + i0), cs = *(const f32x4*)(rope + i0), sn4 = *(const f32x4*)(rope + 16 + i0);
        float o1[4], o2[4];
#pragma unroll
        for (int j = 0; j < 4; ++j) { const float x1 = acc[2][rq * 4 + j] * rr * g1[j], x2 = acc[2][8 + rq * 4 + j] * rr * g2[j]; o1[j] = x1 * cs[j] - x2 * sn4[j]; o2[j] = x1 * sn4[j] + x2 * cs[j]; }
        u32x2 w1, w2; w1.x = pk2(o1[0], o1[1]); w1.y = pk2(o1[2], o1[3]); w2.x = pk2(o2[0], o2[1]); w2.y = pk2(o2[2], o2[3]);
        *(u32x2*)(qo + 64 + i0) = w1; *(u32x2*)(qo + 80 + i0) = w2;
    }
}
__device__ __forceinline__ int vperm(int s) { return (s & ~12) | ((s & 4) << 1) | ((s & 8) >> 1); }
__device__ __forceinline__ void p3_kv_load(const Params& p, int task, int lane, u32x4 (&av)[8]) {
    const int tile = task >> 3, r32 = lane & 31, hi = lane >> 5, t = tile * 32 + r32;
    const bf16_t* arow = (const bf16_t*)(p.ws + OFF_P) + (size_t)t * NPA + C_KVA + hi * 8;
#pragma unroll
    for (int s = 0; s < 8; ++s) av[s] = *(const u32x4*)(arow + s * 16);
}
__device__ __forceinline__ void p3_kv_task(const Params& p, int task, int lane, unsigned char* wl, const unsigned char* wkv  , const u32x4 (&avin)[8]) {
    const int head = task & 7, tile = task >> 3, r32 = lane & 31, hi = lane >> 5, t = tile * 32 + r32;
    const bf16_t* prow = (const bf16_t*)(p.ws + OFF_P) + (size_t)t * NPA;
    const unsigned char* wrow = wkv + r32 * 272 + hi * 16;
    f32x16 acc[4];
#pragma unroll
    for (int f = 0; f < 4; ++f)
#pragma unroll
        for (int r = 0; r < 16; ++r) acc[f][r] = 0.f;
    float ss = 0.f;
#pragma unroll
    for (int s = 0; s < 8; ++s) {
        const u32x4 av = avin[s];
        ss += sumsq8(av);
        const bf16x8 a = as_bf16x8(av);
#pragma unroll
        for (int f = 0; f < 4; ++f) { const bf16x8 w = *(const bf16x8*)(wrow + f * 32 * 272 + s * 32); acc[f] = MFMA32(w, a, acc[f]); }
    }
    ss = xhalf_sum(ss);
    const float rstd = rsqrtf(ss * (1.f / 128.f) + EPSN);
    float sn = 0.f;
#pragma unroll
    for (int r = 0; r < 16; ++r) { acc[0][r] *= rstd; acc[1][r] *= rstd; sn += acc[0][r] * acc[0][r] + acc[1][r] * acc[1][r]; }
    sn = xhalf_sum(sn);
    const float rn = rsqrtf(sn * (1.f / 64.f) + EPSN);
    const float* kn = p.in[13];
    bf16_t* ko = (bf16_t*)((unsigned char*)p.out + DO_K) + (size_t)t * 768 + head * 96;
#pragma unroll
    for (int f = 0; f < 2; ++f)
#pragma unroll
        for (int rq = 0; rq < 4; ++rq) {
            const int f0 = f * 32 + 8 * rq + 4 * hi;
            const f32x4 g = *(const f32x4*)(kn + f0);
            u32x2 w; w.x = pk2(acc[f][rq * 4 + 0] * rn * g[0], acc[f][rq * 4 + 1] * rn * g[1]); w.y = pk2(acc[f][rq * 4 + 2] * rn * g[2], acc[f][rq * 4 + 3] * rn * g[3]);
            *(u32x2*)(ko + f0) = w;
        }
    {
        const float* rope = (const float*)(p.ws + OFF_ROPE) + (size_t)t * 32;
        float x1[2][4], x2[2][4]; float sr = 0.f;
#pragma unroll
        for (int rq = 0; rq < 2; ++rq) {
            const int i0 = 8 * rq + 4 * hi;
            const u32x2 a = *(const u32x2*)(prow + C_KR + i0), b = *(const u32x2*)(prow + C_KR + 16 + i0);
            x1[rq][0] = lo_f(a.x); x1[rq][1] = hi_f(a.x); x1[rq][2] = lo_f(a.y); x1[rq][3] = hi_f(a.y);
            x2[rq][0] = lo_f(b.x); x2[rq][1] = hi_f(b.x); x2[rq][2] = lo_f(b.y); x2[rq][3] = hi_f(b.y);
#pragma unroll
            for (int j = 0; j < 4; ++j) sr += x1[rq][j] * x1[rq][j] + x2[rq][j] * x2[rq][j];
        }
        sr = xhalf_sum(sr);
        const float rr = rsqrtf(sr * (1.f / 32.f) + EPSN);
#pragma unroll
        for (int rq = 0; rq < 2; ++rq) {
            const int i0 = 8 * rq + 4 * hi;
            const f32x4 g1 = *(const f32x4*)(kn + 64 + i0), g2 = *(const f32x4*)(kn + 80 + i0), cs = *(const f32x4*)(rope + i0), sn4 = *(const f32x4*)(rope + 16 + i0);
            float o1[4], o2[4];
#pragma unroll
            for (int j = 0; j < 4; ++j) { const float a = x1[rq][j] * rr * g1[j], b = x2[rq][j] * rr * g2[j]; o1[j] = a * cs[j] - b * sn4[j]; o2[j] = a * sn4[j] + b * cs[j]; }
            u32x2 w1, w2; w1.x = pk2(o1[0], o1[1]); w1.y = pk2(o1[2], o1[3]); w2.x = pk2(o2[0], o2[1]); w2.y = pk2(o2[2], o2[3]);
            *(u32x2*)(ko + 64 + i0) = w1; *(u32x2*)(ko + 80 + i0) = w2;
        }
    }
    __builtin_amdgcn_wave_barrier(); asm volatile("s_waitcnt lgkmcnt(0)" ::: "memory");
#pragma unroll
    for (int f = 0; f < 2; ++f)
#pragma unroll
        for (int r = 0; r < 16; ++r) *(bf16_t*)(wl + (f * 32 + (r & 3) + 8 * (r >> 2) + 4 * hi) * 80 + vperm(r32) * 2) = f2bf(acc[2 + f][r] * rstd);
    __builtin_amdgcn_wave_barrier(); asm volatile("s_waitcnt lgkmcnt(0)" ::: "memory");
    const int b = (tile * 32) >> 12, s0 = (tile * 32) & 4095;
    bf16_t* vo = (bf16_t*)((unsigned char*)p.out + DO_VT) + ((size_t)(b * 8 + head) * 64) * 4096 + s0;
#pragma unroll
    for (int i = 0; i < 4; ++i) { const int c = lane + 64 * i, row = c >> 2, ch = c & 3; *(u32x4*)(vo + (size_t)row * 4096 + ch * 8) = *(const u32x4*)(wl + row * 80 + ch * 16); }
}
template <int LORA, bool KEEP = false>
__device__ __forceinline__ void p3_lora_task(const Params& p, int tile, int fg, int lane, unsigned char* wl) {
    constexpr int CIN = LORA == 0 ? C_WD : (LORA == 1 ? C_AD : C_GD), KL = LORA == 2 ? 128 : 64;
    constexpr size_t WOFF = LORA == 0 ? OFF_WDEC : (LORA == 1 ? OFF_WAAA : OFF_WGATE), OOFF = LORA == 0 ? OFF_SE : (LORA == 1 ? OFF_SB : OFF_SG);
    const int r32 = lane & 31, hi = lane >> 5, t = tile * 32 + r32;
    const bf16_t* prow = (const bf16_t*)(p.ws + OFF_P) + (size_t)t * NPA + CIN + hi * 8;
    const float* mu = p.in[7] + (CIN - C_RW) + hi * 8;
    const bool first = (t & 4095) == 0;
    const bf16_t* wrow = (const bf16_t*)(p.ws + WOFF) + (size_t)(fg * 128 + r32) * KL + hi * 8;
    f32x16 acc[4];
#pragma unroll
    for (int f = 0; f < 4; ++f)
#pragma unroll
        for (int r = 0; r < 16; ++r) acc[f][r] = 0.f;
#pragma unroll
    for (int s = 0; s < KL / 16; ++s) {
        const u32x4 cur = *(const u32x4*)(prow + s * 16);
        u32x4 prv = {0u, 0u, 0u, 0u};
        if (!first) prv = *(const u32x4*)(prow - NPA + s * 16);
        const f32x4 m0 = *(const f32x4*)(mu + s * 16), m1 = *(const f32x4*)(mu + s * 16 + 4);
        float v[8];
#pragma unroll
        for (int i = 0; i < 4; ++i) {
            const float c0 = lo_f(cur[i]), c1 = hi_f(cur[i]), p0 = lo_f(prv[i]), p1 = hi_f(prv[i]);
            const float ma = (i < 2) ? m0[2 * i] : m1[2 * i - 4], mb = (i < 2) ? m0[2 * i + 1] : m1[2 * i - 3];
            v[2 * i] = c0 + (p0 - c0) * ma; v[2 * i + 1] = c1 + (p1 - c1) * mb;
        }
#pragma unroll
        for (int i = 0; i < 8; ++i) v[i] = LORA == 0 ? tanhf_(v[i]) : (LORA == 2 ? sigmoidf_(v[i]) : v[i]);
        u32x4 aw; aw.x = pk2(v[0], v[1]); aw.y = pk2(v[2], v[3]); aw.z = pk2(v[4], v[5]); aw.w = pk2(v[6], v[7]);
        const bf16x8 a = as_bf16x8(aw);
#pragma unroll
        for (int f = 0; f < 4; ++f) { const bf16x8 w = *(const bf16x8*)(wrow + (size_t)f * 32 * KL + s * 16); acc[f] = MFMA32(a, w, acc[f]); }
    }
    __builtin_amdgcn_wave_barrier(); asm volatile("s_waitcnt lgkmcnt(0)" ::: "memory");
#pragma unroll
    for (int f = 0; f < 4; ++f)
#pragma unroll
        for (int r = 0; r < 16; ++r) *(bf16_t*)(wl + ((r & 3) + 8 * (r >> 2) + 4 * hi) * 272 + (f * 32 + r32) * 2) = f2bf(acc[f][r]);
    __builtin_amdgcn_wave_barrier(); asm volatile("s_waitcnt lgkmcnt(0)" ::: "memory");
    if (KEEP) return;
    bf16_t* o = (bf16_t*)(p.ws + OOFF) + (size_t)(tile * 32) * 512 + fg * 128;
#pragma unroll
    for (int i = 0; i < 8; ++i) { const int c = lane + 64 * i, row = c >> 4, ch = c & 15; *(u32x4*)(o + (size_t)row * 512 + ch * 8) = *(const u32x4*)(wl + row * 272 + ch * 16); }
}
__device__ __forceinline__ void p4c_tile2(const Params& p, int tile, int hd0, int lane, const unsigned char* decp, const unsigned char* aprp);
__device__ __forceinline__ void p3_small(const Params& p, unsigned char* lds, bool lora_only = false) {
    const int tid = otid(), lane = tid & 63, wid = tid >> 6, gw = blockIdx.x * 8 + wid, nw = gridDim.x * 8;
    unsigned char* wl = lds + wid * 8704;
    unsigned char* wsh = lds + 8 * 8704;
    __syncthreads();
    if (!lora_only) {
        const int head = blockIdx.x & 7, tb = blockIdx.x >> 3;
        for (int c = tid; c < 96 * 32; c += NTHREADS) { const int row = c >> 5, ch = c & 31;
            *(u32x4*)(wsh + row * 528 + ch * 16) = *(const u32x4*)((const bf16_t*)(p.ws + OFF_WUQ) + (size_t)(head * 96 + row) * 256 + ch * 8); }
        __syncthreads();
        {   const int tq0 = (tb + 32 * wid) * 8 + head, tq1 = (tb + 32 * (wid + 8)) * 8 + head;
            u32x4 a0[16], a1[16];
            p3_q_load(p, tq0, lane, a0); p3_q_load(p, tq1, lane, a1);
            p3_q_task(p, tq0, lane, wsh, a0); p3_q_task(p, tq1, lane, wsh, a1); }
        __syncthreads();
        for (int c = tid; c < 128 * 16; c += NTHREADS) { const int row = c >> 4, ch = c & 15;
            *(u32x4*)(wsh + row * 272 + ch * 16) = *(const u32x4*)((const bf16_t*)(p.ws + OFF_WUKV) + (size_t)(head * 128 + row) * 128 + ch * 8); }
        __syncthreads();
        {   const int tk0 = (tb + 32 * wid) * 8 + head, tk1 = (tb + 32 * (wid + 8)) * 8 + head;
            u32x4 b0[8], b1[8];
            p3_kv_load(p, tk0, lane, b0); p3_kv_load(p, tk1, lane, b1);
            p3_kv_task(p, tk0, lane, wl, wsh, b0); p3_kv_task(p, tk1, lane, wl, wsh, b1); }
    }
#if defined(CHUNKED) && !defined(SCAN_VERIFY)
    __syncthreads();
    unsigned char* wl2 = lds + (8 + wid) * 8704;
#pragma unroll 1
    for (int tt = gw; tt < 512 * 4; tt += nw) {
        int tile = tt >> 2, fg = tt & 3;
        asm volatile("" : "+v"(tile), "+v"(fg));
        p3_lora_task<2>(p, tile, fg, lane, wl);
        __builtin_amdgcn_wave_barrier(); asm volatile("s_waitcnt lgkmcnt(0)" ::: "memory");
        asm volatile("" : "+v"(tile), "+v"(fg));
        p3_lora_task<0, true>(p, tile, fg, lane, wl);
        asm volatile("" : "+v"(tile), "+v"(fg));
        p3_lora_task<1, true>(p, tile, fg, lane, wl2);
        __builtin_amdgcn_wave_barrier(); asm volatile("s_waitcnt lgkmcnt(0)" ::: "memory");
        p4c_tile2(p, tile, 2 * fg, lane, wl, wl2);
        __builtin_amdgcn_wave_barrier(); asm volatile("s_waitcnt lgkmcnt(0)" ::: "memory");
    }
    return;
#endif
    constexpr int NL = 512 * 12;
    for (int rep_ = 0; rep_ < P3_REP_L; ++rep_) for (int tt = gw; tt < NL; tt += nw) {
        const int tile = tt / 12, sub = tt % 12, lora = sub >> 2, fg = sub & 3;
        if (lora == 0) p3_lora_task<0>(p, tile, fg, lane, wl); else if (lora == 1) p3_lora_task<1>(p, tile, fg, lane, wl); else p3_lora_task<2>(p, tile, fg, lane, wl);
    }
}

template <int CTRL> __device__ __forceinline__ float dpp_f(float v) { return __int_as_float(__builtin_amdgcn_update_dpp(0, __float_as_int(v), CTRL, 0xf, 0xf, false)); }
__device__ __forceinline__ float reduce16(float v) { v += dpp_f<0xB1>(v); v += dpp_f<0x4E>(v); v += dpp_f<0x141>(v); v += dpp_f<0x140>(v); return v; }
__device__ __forceinline__ void p4_rwkv_prep(const Params& p) {
    const int lane = otid() & 63, gw = blockIdx.x * 8 + (otid() >> 6), nw = gridDim.x * 8, ts = lane >> 4, cg = lane & 15;
    const bf16_t* P = (const bf16_t*)(p.ws + OFF_P);
    for (int task = gw; task < (T_TOK / 4) * 8; task += nw) {
        const int t = (task >> 3) * 4 + ts, hd = task & 7, ch = hd * 64 + cg * 4;
        const bf16_t* row = P + (size_t)t * NPA;
        const bool first = (t & 4095) == 0;
        const f32x4 r0 = bf4(*(const u32x2*)(row + C_R + ch)), k0 = bf4(*(const u32x2*)(row + C_K + ch)), v0 = bf4(*(const u32x2*)(row + C_V + ch));
        f32x4 rp = {0.f, 0.f, 0.f, 0.f}, kp = rp, vp = rp;
        if (!first) { rp = bf4(*(const u32x2*)(row + C_R + ch - NPA)); kp = bf4(*(const u32x2*)(row + C_K + ch - NPA)); vp = bf4(*(const u32x2*)(row + C_V + ch - NPA)); }
        const float* mu = p.in[7];
        const f32x4 r = r0 + (rp - r0) * *(const f32x4*)(mu + ch), k = k0 + (kp - k0) * *(const f32x4*)(mu + 512 + ch), v = v0 + (vp - v0) * *(const f32x4*)(mu + 1024 + ch);
        const size_t o = (size_t)t * 512 + ch;
        const f32x4 dec = *(const f32x4*)(p.in[16] + ch) + bf4(*(const u32x2*)((const bf16_t*)(p.ws + OFF_SE) + o));
        const f32x4 apre = *(const f32x4*)(p.in[18] + ch) + bf4(*(const u32x2*)((const bf16_t*)(p.ws + OFF_SB) + o));
        const f32x4 kkw = *(const f32x4*)(p.in[20] + ch), kaw = *(const f32x4*)(p.in[21] + ch);
        f32x4 e, a, kkr, kh;
        float n2 = 0.f;
#pragma unroll
        for (int i = 0; i < 4; ++i) {
            const float nd = -dec[i], sp = fmaxf(nd, 0.f) + __logf(1.f + __expf(-fabsf(nd)));
            e[i] = __expf(-sp - 0.5f);
            a[i] = sigmoidf_(apre[i]);
            kkr[i] = k[i] * kkw[i]; n2 += kkr[i] * kkr[i];
            kh[i] = k[i] * (1.f + (a[i] - 1.f) * kaw[i]);
        }
        n2 = reduce16(n2);
        const float inv = __builtin_amdgcn_rsqf(fmaxf(n2, 1e-24f));
        const f32x4 kk = kkr * inv;
        *(u32x2*)((bf16_t*)(p.ws + OFF_SR) + o) = pk4(r); *(u32x2*)((bf16_t*)(p.ws + OFF_SE) + o) = pk4(e); *(u32x2*)((bf16_t*)(p.ws + OFF_SKH) + o) = pk4(kh);
        *(u32x2*)((bf16_t*)(p.ws + OFF_SV) + o) = pk4(v); *(u32x2*)((bf16_t*)(p.ws + OFF_SKK) + o) = pk4(kk); *(u32x2*)((bf16_t*)(p.ws + OFF_SB) + o) = pk4(kk * a);
    }
}

constexpr int SC_CH = 32;
constexpr size_t OFF_YRAW = OFF_P + 32 * MiB;
#ifdef SCAN_VERIFY
#define YRAW_PTR(p) ((bf16_t*)((unsigned char*)(p).out))
#else
#define YRAW_PTR(p) ((bf16_t*)((p).ws + OFF_YRAW))
#endif
__device__ __forceinline__ void scan_task(const Params& p, int task, unsigned char* lds) {
    const int rq = task & 3, bh = task >> 2, b = bh >> 3, hd = bh & 7, tid = otid(), lane = tid & 63, wid = tid >> 6;
    constexpr int VEC_F = 9 * 16 * 64, SC_F = 16 * 4, VB_F = 32 * 64, BUF_F = VEC_F + SC_F + VB_F;
    float* buf = (float*)lds;
    float* ybuf = buf + 2 * BUF_F;
    const bool producer = wid >= 4;
    const int ptid = tid - 256, pj = ptid >> 4, pc = ptid & 15;
    u32x2 st[12];
    auto gload = [&](int c) {
        const size_t base = ((size_t)(b * 4096 + c * SC_CH + 2 * pj)) * 512 + hd * 64 + pc * 4;
#pragma unroll
        for (int i = 0; i < 6; ++i) { const size_t off = i == 0 ? OFF_SE : i == 1 ? OFF_SKK : i == 2 ? OFF_SB : i == 3 ? OFF_SKH : i == 4 ? OFF_SR : OFF_SV;
            st[2 * i] = *(const u32x2*)((const bf16_t*)(p.ws + off) + base); st[2 * i + 1] = *(const u32x2*)((const bf16_t*)(p.ws + off) + base + 512); }
    };
    auto swrite = [&](int bsel) {
        const f32x4 e0 = bf4(st[0]), e1 = bf4(st[1]), kk0 = bf4(st[2]), kk1 = bf4(st[3]), b0 = bf4(st[4]), b1 = bf4(st[5]), k0 = bf4(st[6]), k1 = bf4(st[7]), r0 = bf4(st[8]), r1 = bf4(st[9]);
        f32x4 w0, w1;
#pragma unroll
        for (int i = 0; i < 4; ++i) { w0[i] = __expf(-e0[i]); w1[i] = __expf(-e1[i]); }
        const f32x4 nk0 = -kk0, nk1 = -kk1;
        float* vb = buf + (size_t)bsel * BUF_F + pj * 64 + pc * 4;
        *(f32x4*)(vb + 0 * 1024) = nk0; *(f32x4*)(vb + 1 * 1024) = w0 * nk1; *(f32x4*)(vb + 2 * 1024) = w0 * r0; *(f32x4*)(vb + 3 * 1024) = w0 * w1; *(f32x4*)(vb + 4 * 1024) = b0 * w1;
        *(f32x4*)(vb + 5 * 1024) = k0 * w1; *(f32x4*)(vb + 6 * 1024) = b1; *(f32x4*)(vb + 7 * 1024) = k1; *(f32x4*)(vb + 8 * 1024) = r1;
        const f32x4 t0 = b0 * nk1, t1 = k0 * nk1, t2 = b0 * r0, t3 = k0 * r0;
        const float beta = reduce16((t0[0] + t0[1]) + (t0[2] + t0[3])), kappa = reduce16((t1[0] + t1[1]) + (t1[2] + t1[3]));
        const float rhob = reduce16((t2[0] + t2[1]) + (t2[2] + t2[3])), rhok = reduce16((t3[0] + t3[1]) + (t3[2] + t3[3]));
        if (pc == 0) *(f32x4*)(buf + (size_t)bsel * BUF_F + VEC_F + pj * 4) = (f32x4){beta, kappa, rhob, rhok};
        float* vv = buf + (size_t)bsel * BUF_F + VEC_F + SC_F + (2 * pj) * 64 + pc * 4;
        *(f32x4*)vv = bf4(st[10]); *(f32x4*)(vv + 64) = bf4(st[11]);
    };
    auto ydrain = [&](int c) {
        const int tok = ptid >> 3, pr = ptid & 7;
        const float* yb = ybuf + (size_t)(c & 1) * SC_CH * 16 + tok * 16 + pr * 2;
        *(unsigned*)(YRAW_PTR(p) + ((size_t)(b * 4096 + c * SC_CH + tok)) * 512 + hd * 64 + rq * 16 + pr * 2) = pk2(yb[0], yb[1]);
    };
    __syncthreads();
    if (producer) { gload(0); swrite(0); }
    __syncthreads();
    constexpr int NCH = SEQ / SC_CH;
    const int kq = lane & 15, rl = wid * 4 + (lane >> 4), row = rq * 16 + rl;
    f32x2 sA = {0.f, 0.f}, sB = {0.f, 0.f};
    for (int c = 0; c < NCH; ++c) {
        if (producer) {
            if (c + 1 < NCH) gload(c + 1);
            if (c > 0) ydrain(c - 1);
            if (c + 1 < NCH) swrite((c + 1) & 1);
        } else {
            const float* __restrict__ bb = buf + (size_t)(c & 1) * BUF_F + kq * 4;
            const float* __restrict__ scp = buf + (size_t)(c & 1) * BUF_F + VEC_F;
            const float* __restrict__ vp = buf + (size_t)(c & 1) * BUF_F + VEC_F + SC_F + row;
            float* __restrict__ yb = ybuf + (size_t)(c & 1) * SC_CH * 16 + rl;
            f32x4 q[9];
#pragma unroll
            for (int a = 0; a < 9; ++a) q[a] = *(const f32x4*)(bb + a * 1024);
            f32x4 sc = *(const f32x4*)scp; float v0 = vp[0], v1 = vp[64];
            float ykA = 0.f, ykB = 0.f;
#pragma unroll
            for (int j = 0; j < 16; ++j) {
                const int jn = j < 15 ? j + 1 : j;
                f32x4 qn[9];
#pragma unroll
                for (int a = 0; a < 9; ++a) qn[a] = *(const f32x4*)(bb + a * 1024 + jn * 64);
                const f32x4 scn = *(const f32x4*)(scp + jn * 4); const float v0n = vp[2 * jn * 64], v1n = vp[(2 * jn + 1) * 64];
                const f32x2 d1 = sA * (f32x2){q[0][0], q[0][1]} + sB * (f32x2){q[0][2], q[0][3]};
                const f32x2 d2 = sA * (f32x2){q[1][0], q[1][1]} + sB * (f32x2){q[1][2], q[1][3]};
                const f32x2 d3 = sA * (f32x2){q[2][0], q[2][1]} + sB * (f32x2){q[2][2], q[2][3]};
                float r1 = d1.x + d1.y, r2 = d2.x + d2.y, r3 = d3.x + d3.y;
                r1 += dpp_f<0xB1>(r1); r2 += dpp_f<0xB1>(r2); r3 += dpp_f<0xB1>(r3);
                r1 += dpp_f<0x4E>(r1); r2 += dpp_f<0x4E>(r2); r3 += dpp_f<0x4E>(r3);
                r1 += dpp_f<0x141>(r1); r2 += dpp_f<0x141>(r2); r3 += dpp_f<0x141>(r3);
                r1 += dpp_f<0x140>(r1); r2 += dpp_f<0x140>(r2); r3 += dpp_f<0x140>(r3);
                const float sa1 = r1, sa2 = r2 + sa1 * sc[0] + v0 * sc[1], y0 = r3 + sa1 * sc[2] + v0 * sc[3];
                const f32x2 a1 = {sa1, sa1}, a2 = {sa2, sa2}, u0 = {v0, v0}, u1 = {v1, v1};
                sA = sA * (f32x2){q[3][0], q[3][1]} + a1 * (f32x2){q[4][0], q[4][1]} + u0 * (f32x2){q[5][0], q[5][1]} + a2 * (f32x2){q[6][0], q[6][1]} + u1 * (f32x2){q[7][0], q[7][1]};
                sB = sB * (f32x2){q[3][2], q[3][3]} + a1 * (f32x2){q[4][2], q[4][3]} + u0 * (f32x2){q[5][2], q[5][3]} + a2 * (f32x2){q[6][2], q[6][3]} + u1 * (f32x2){q[7][2], q[7][3]};
                const f32x2 yy = sA * (f32x2){q[8][0], q[8][1]} + sB * (f32x2){q[8][2], q[8][3]};
                const float y1 = reduce16(yy.x + yy.y);
                ykA = (kq == j) ? y0 : ykA; ykB = (kq == j) ? y1 : ykB;
#pragma unroll
                for (int a = 0; a < 9; ++a) q[a] = qn[a];
                sc = scn; v0 = v0n; v1 = v1n;
            }
            yb[(2 * kq) * 16] = ykA; yb[(2 * kq + 1) * 16] = ykB;
        }
        __syncthreads();
    }
    if (producer) ydrain(NCH - 1);
}

constexpr size_t OFF_ABAR = OFF_SKK, OFF_BTIL = OFF_SB, OFF_KTIL = OFF_SKH, OFF_RBAR = OFF_SR;
#ifdef SCAN_VERIFY
#define SCAN_TMP(p) ((unsigned char*)(p).out)
constexpr size_t OFF_GCH = 16 * MiB, OFF_DCH = 32 * MiB, OFF_MCH = 48 * MiB;
#else
#define SCAN_TMP(p) ((p).ws)
constexpr size_t OFF_GCH = OFF_SE, OFF_DCH = 240 * MiB, OFF_MCH = OFF_WINA;
#endif
constexpr size_t OFF_YCH = OFF_SE;
constexpr size_t OFF_HST = 240 * MiB;
typedef __amdgpu_buffer_rsrc_t rsrc_t;
__device__ __forceinline__ rsrc_t mk_rsrc(const void* base, unsigned bytes) {
    const unsigned long long a = (unsigned long long)base;
    const unsigned lo = __builtin_amdgcn_readfirstlane((unsigned)a), hi = __builtin_amdgcn_readfirstlane((unsigned)(a >> 32));
    return __builtin_amdgcn_make_buffer_rsrc((void*)(((unsigned long long)hi << 32) | lo), (short)0, (int)bytes, 0x00020000); }
__device__ __forceinline__ void bstore128(u32x4 v, rsrc_t rs, int voff, int soff, int aux) { __builtin_amdgcn_raw_buffer_store_b128(v, rs, voff, soff, 0); asm volatile("s_nop 1" ::: "memory"); (void)aux; }
__device__ __forceinline__ void bstore16(short v, rsrc_t rs, int voff, int soff, int aux) { __builtin_amdgcn_raw_buffer_store_b16(v, rs, voff, soff, 0); asm volatile("s_nop 1" ::: "memory"); (void)aux; }
__device__ __forceinline__ bf16x8 rowfrag_nat(rsrc_t rs, int sb, int vrow  , int q) { return as_bf16x8(__builtin_amdgcn_raw_buffer_load_b128(rs, vrow + 32 * q, sb, 0)); }
__device__ __forceinline__ bf16x8 rowfrag_perm(rsrc_t rs, int sb, int vrow  , int q) {
    const u32x2 a = __builtin_amdgcn_raw_buffer_load_b64(rs, vrow + 32 * q, sb, 0), b = __builtin_amdgcn_raw_buffer_load_b64(rs, vrow + 32 * q + 16, sb, 0); return as_bf16x8((u32x4){a.x, a.y, b.x, b.y}); }
template <bool PERMK> __device__ __forceinline__ bf16x8 colfrag(rsrc_t rs, int sb, int vcol  , int q) {
    unsigned v[8];
#pragma unroll
    for (int e = 0; e < 8; ++e) { const int t = PERMK ? (16 * q + 8 * (e >> 2) + (e & 3)) : (16 * q + e); v[e] = (unsigned short)__builtin_amdgcn_raw_buffer_load_b16(rs, vcol, sb + t * 1024, 0); }
    return as_bf16x8((u32x4){v[0] | (v[1] << 16), v[2] | (v[3] << 16), v[4] | (v[5] << 16), v[6] | (v[7] << 16)});
}
__device__ __forceinline__ bf16x8 accfrag(const f32x16& a, int q) { return as_bf16x8((u32x4){pk2(a[8 * q], a[8 * q + 1]), pk2(a[8 * q + 2], a[8 * q + 3]), pk2(a[8 * q + 4], a[8 * q + 5]), pk2(a[8 * q + 6], a[8 * q + 7])}); }
__device__ __forceinline__ bf16x8 negfrag(bf16x8 f) { u32x4 w = *reinterpret_cast<u32x4*>(&f); w ^= 0x80008000u; return as_bf16x8(w); }
__device__ __forceinline__ void zero16(f32x16& a) {
#pragma unroll
    for (int r = 0; r < 16; ++r) a[r] = 0.f;
}
__device__ __forceinline__ void tri_inverse_rows(const f32x16& xab, int r32, float (&m)[32]) {
#pragma unroll
    for (int s = 31; s >= 0; --s) {
        float acc = (s == r32) ? 1.f : 0.f;
#pragma unroll
        for (int u = s + 1; u < 32; ++u) {
            const float l = __int_as_float(__builtin_amdgcn_readlane(__float_as_int(xab[(s & 3) + 4 * (s >> 3)]), u + 32 * ((s >> 2) & 1)));
            acc -= m[u] * l;
        }
        m[s] = acc;
    }
}
__device__ __forceinline__ bf16x8 mfrag(const float (&m)[32], int q, int hi, bool perm) {
    float v[8];
#pragma unroll
    for (int e = 0; e < 8; ++e) { const int lo = perm ? (16 * q + 8 * (e >> 2) + (e & 3)) : (16 * q + e), hio = perm ? lo + 4 : lo + 8; v[e] = hi ? m[hio] : m[lo]; }
    return as_bf16x8((u32x4){pk2(v[0], v[1]), pk2(v[2], v[3]), pk2(v[4], v[5]), pk2(v[6], v[7])});
}
__device__ __forceinline__ void scale_rows(f32x16& a, const float* gc  , int hi) {
#pragma unroll
    for (int rq = 0; rq < 4; ++rq) { const f32x4 g = *(const f32x4*)(gc + 8 * rq + 4 * hi);
#pragma unroll
        for (int j = 0; j < 4; ++j) a[rq * 4 + j] *= g[j]; }
}

struct ScanRs { rsrc_t abar, btil, ktil, rbar, sv; };
__device__ __forceinline__ void scan_stage_tiles(unsigned char* wl, const ScanRs& R, int sb, int lane) {
    __builtin_amdgcn_wave_barrier(); asm volatile("s_waitcnt lgkmcnt(0)" ::: "memory");
#pragma unroll
    for (int ap = 0; ap < 4; ap += 2) {
        u32x4 t[2][4];
#pragma unroll
        for (int a2 = 0; a2 < 2; ++a2)
#pragma unroll
            for (int i = 0; i < 4; ++i) { const int a = ap + a2, row = (lane >> 3) + 8 * i, ch = lane & 7;
                t[a2][i] = __builtin_amdgcn_raw_buffer_load_b128(a == 0 ? R.abar : a == 1 ? R.btil : a == 2 ? R.ktil : R.sv, row * 1024 + ch * 16, sb, 0); }
#pragma unroll
        for (int a2 = 0; a2 < 2; ++a2)
#pragma unroll
            for (int i = 0; i < 4; ++i) { const int a = ap + a2, row = (lane >> 3) + 8 * i, ch = lane & 7; *(u32x4*)(wl + a * 4608 + row * 144 + ch * 16) = t[a2][i]; }
    }
    __builtin_amdgcn_wave_barrier(); asm volatile("s_waitcnt lgkmcnt(0)" ::: "memory");
}
__device__ __forceinline__ bf16x8 lrow_nat(const unsigned char* wl, int a, int r32, int hi, int q) { return *(const bf16x8*)(wl + a * 4608 + r32 * 144 + (2 * q + hi) * 16); }
template <bool PERMK> __device__ __forceinline__ bf16x8 lcol(const unsigned char* wl, int a, int col, int hi, int q) {
    unsigned v[8];
#pragma unroll
    for (int e = 0; e < 8; ++e) { const int t = (PERMK ? (16 * q + 8 * (e >> 2) + (e & 3) + 4 * hi) : (16 * q + e + 8 * hi));
        v[e] = *(const unsigned short*)(wl + a * 4608 + t * 144 + col * 2); }
    return as_bf16x8((u32x4){v[0] | (v[1] << 16), v[2] | (v[3] << 16), v[4] | (v[5] << 16), v[6] | (v[7] << 16)});
}
__device__ __forceinline__ void scanA_pq(const Params& p, const ScanRs& R, unsigned char* wl, int sb  , int sub  , int lane,
                                         bf16x8 (&Pf)[2][2], bf16x8 (&Qf)[2][2]) {
    const int r32 = lane & 31, hi = lane >> 5;
    scan_stage_tiles(wl, R, sb, lane);
    f32x16 xab, xak; zero16(xab); zero16(xak);
#pragma unroll
    for (int q = 0; q < 4; ++q) {
        const bf16x8 fa = lrow_nat(wl, 0, r32, hi, q), fb = lrow_nat(wl, 1, r32, hi, q), fk = lrow_nat(wl, 2, r32, hi, q);
        xab = MFMA32(fb, fa, xab); xak = MFMA32(fk, fa, xak);
    }
#pragma unroll
    for (int r = 0; r < 16; ++r) { const bool keep = crow(r, hi) < r32; xab[r] = keep ? xab[r] : 0.f; xak[r] = keep ? xak[r] : 0.f; }
    float m[32];
    tri_inverse_rows(xab, r32, m);
    if (hi == 0) {
        bf16_t* Mg = (bf16_t*)(SCAN_TMP(p) + OFF_MCH) + (size_t)sub * 1024 + r32 * 32;
#pragma unroll
        for (int i = 0; i < 4; ++i) *(u32x4*)(Mg + 8 * i) = (u32x4){pk2(m[8 * i], m[8 * i + 1]), pk2(m[8 * i + 2], m[8 * i + 3]), pk2(m[8 * i + 4], m[8 * i + 5]), pk2(m[8 * i + 6], m[8 * i + 7])};
    }
    const bf16x8 mn0 = mfrag(m, 0, hi, false), mn1 = mfrag(m, 1, hi, false), mp0 = mfrag(m, 0, hi, true), mp1 = mfrag(m, 1, hi, true);
    const bf16x8 ak0 = accfrag(xak, 0), ak1 = accfrag(xak, 1);
#pragma unroll
    for (int ct = 0; ct < 2; ++ct) {
        __builtin_amdgcn_sched_barrier(0);
        f32x16 Pt; zero16(Pt);
        Pt = MFMA32(mn0, lcol<false>(wl, 0, r32 + 32 * ct, hi, 0), Pt); Pt = MFMA32(mn1, lcol<false>(wl, 0, r32 + 32 * ct, hi, 1), Pt);
        Pf[ct][0] = accfrag(Pt, 0); Pf[ct][1] = accfrag(Pt, 1);
        f32x16 W; zero16(W);
        W = MFMA32(ak0, lcol<true>(wl, 3, r32 + 32 * ct, hi, 0), W); W = MFMA32(ak1, lcol<true>(wl, 3, r32 + 32 * ct, hi, 1), W);
        f32x16 Qt; zero16(Qt);
        Qt = MFMA32(mp0, accfrag(W, 0), Qt); Qt = MFMA32(mp1, accfrag(W, 1), Qt);
        Qf[ct][0] = accfrag(Qt, 0); Qf[ct][1] = accfrag(Qt, 1);
    }
}
__device__ __forceinline__ void scan_stageA(const Params& p, int task_, int lane, unsigned char* wl) {
    const int task = __builtin_amdgcn_readfirstlane(task_);
    const int bh = task >> 6, c64 = task & 63, b = bh >> 3, hd = bh & 7, r32 = lane & 31, hi = lane >> 5;
    const int sb0 = (int)((((size_t)(b * 4096 + c64 * 64)) * 512 + hd * 64) * 2), sb1 = sb0 + 32 * 1024;
    const int vcn = r32 * 2 + hi * 8192, vcp = r32 * 2 + hi * 4096;
    const ScanRs R{mk_rsrc(p.ws + OFF_ABAR, 16u << 20), mk_rsrc(p.ws + OFF_BTIL, 16u << 20), mk_rsrc(p.ws + OFF_KTIL, 16u << 20), mk_rsrc(p.ws + OFF_RBAR, 16u << 20), mk_rsrc(p.ws + OFF_SV, 16u << 20)};
    const int sub0 = (b * 4096 + c64 * 64) / 32;
    const float* gc0 = (const float*)(p.ws + OFF_GC) + (size_t)sub0 * 512 + hd * 64; const float* gc1 = gc0 + 512;
    const rsrc_t rsD = mk_rsrc(SCAN_TMP(p) + OFF_DCH, 16u << 20);
    const rsrc_t rsT = mk_rsrc(p.ws + OFF_HST, 16u << 20);
    const rsrc_t rsG = mk_rsrc(SCAN_TMP(p) + OFF_GCH, 16u << 20);
    const int so = task * 8192, vl = lane * 32;
    unsigned char* Dgp = SCAN_TMP(p) + OFF_DCH + (size_t)task * 8192 + lane * 32;
    unsigned char* Tgp = p.ws + OFF_HST + (size_t)task * 8192 + lane * 32;
    unsigned char* Ggp = SCAN_TMP(p) + OFF_GCH + (size_t)task * 8192 + lane * 32;
    {
        bf16x8 Pf[2][2], Qf[2][2];
        scanA_pq(p, R, wl, sb0, bh * 128 + c64 * 2, lane, Pf, Qf);
        const int sb = sb0;
#pragma unroll
        for (int kt = 0; kt < 2; ++kt) {
        __builtin_amdgcn_sched_barrier(0);
            const bf16x8 nb0 = negfrag(lcol<true>(wl, 1, r32 + 32 * kt, hi, 0)), nb1 = negfrag(lcol<true>(wl, 1, r32 + 32 * kt, hi, 1));
            const bf16x8 kn0 = lcol<false>(wl, 2, r32 + 32 * kt, hi, 0), kn1 = lcol<false>(wl, 2, r32 + 32 * kt, hi, 1);
#pragma unroll
            for (int ct = 0; ct < 2; ++ct) {
        __builtin_amdgcn_sched_barrier(0);
                f32x16 T; zero16(T);
                T = MFMA32(nb0, Pf[ct][0], T); T = MFMA32(nb1, Pf[ct][1], T);
                if (kt == ct) {
#pragma unroll
                    for (int r = 0; r < 16; ++r) T[r] += (crow(r, hi) == r32) ? 1.f : 0.f;
                }
                scale_rows(T, gc0 + 32 * kt, hi);
                *(bf16x8*)(Ggp + (kt * 2 + ct) * 2048) = accfrag(T, 0); *(bf16x8*)(Ggp + (kt * 2 + ct) * 2048 + 16) = accfrag(T, 1);
                f32x16 D; zero16(D);
                D = MFMA32(kn0, lcol<false>(wl, 3, r32 + 32 * ct, hi, 0), D); D = MFMA32(kn1, lcol<false>(wl, 3, r32 + 32 * ct, hi, 1), D);
                D = MFMA32(nb0, Qf[ct][0], D); D = MFMA32(nb1, Qf[ct][1], D);
                scale_rows(D, gc0 + 32 * kt, hi);
                *(bf16x8*)(Tgp + (kt * 2 + ct) * 2048) = accfrag(D, 0); *(bf16x8*)(Tgp + (kt * 2 + ct) * 2048 + 16) = accfrag(D, 1);
            }
        }
    }
    const int sb = sb1;
    bf16x8 G2Tf[2][2][2];
    bf16x8 Qf[2][2];
    {
        bf16x8 Pa[2][2];
        scanA_pq(p, R, wl, sb1, bh * 128 + c64 * 2 + 1, lane, Pa, Qf);
#pragma unroll
        for (int kt = 0; kt < 2; ++kt) {
        __builtin_amdgcn_sched_barrier(0);
            const bf16x8 bt0 = lcol<true>(wl, 1, r32 + 32 * kt, hi, 0), bt1 = lcol<true>(wl, 1, r32 + 32 * kt, hi, 1);
            const float g = gc1[r32 + 32 * kt];
#pragma unroll
            for (int ct = 0; ct < 2; ++ct) {
        __builtin_amdgcn_sched_barrier(0);
                f32x16 T; zero16(T);
                T = MFMA32(Pa[ct][0], bt0, T); T = MFMA32(Pa[ct][1], bt1, T);
#pragma unroll
                for (int r = 0; r < 16; ++r) T[r] = g * (((kt == ct) && (crow(r, hi) == r32) ? 1.f : 0.f) - T[r]);
                G2Tf[ct][kt][0] = accfrag(T, 0); G2Tf[ct][kt][1] = accfrag(T, 1);
            }
        }
    }
#pragma unroll
    for (int ct = 0; ct < 2; ++ct) {
        __builtin_amdgcn_sched_barrier(0);
        bf16x8 G1c[2][2], D1c[2][2];
        asm volatile("s_waitcnt vmcnt(0)" ::: "memory");
#pragma unroll
        for (int c = 0; c < 2; ++c) { G1c[c][0] = *(const bf16x8*)(Ggp + (c * 2 + ct) * 2048); G1c[c][1] = *(const bf16x8*)(Ggp + (c * 2 + ct) * 2048 + 16);
                                      D1c[c][0] = *(const bf16x8*)(Tgp + (c * 2 + ct) * 2048); D1c[c][1] = *(const bf16x8*)(Tgp + (c * 2 + ct) * 2048 + 16); }
        const bf16x8 vn0 = lcol<false>(wl, 3, r32 + 32 * ct, hi, 0), vn1 = lcol<false>(wl, 3, r32 + 32 * ct, hi, 1);
#pragma unroll
        for (int kt = 0; kt < 2; ++kt) {
        __builtin_amdgcn_sched_barrier(0);
            const bf16x8 nb0 = negfrag(lcol<true>(wl, 1, r32 + 32 * kt, hi, 0)), nb1 = negfrag(lcol<true>(wl, 1, r32 + 32 * kt, hi, 1));
            const bf16x8 kn0 = lcol<false>(wl, 2, r32 + 32 * kt, hi, 0), kn1 = lcol<false>(wl, 2, r32 + 32 * kt, hi, 1);
            f32x16 D; zero16(D);
            D = MFMA32(kn0, vn0, D); D = MFMA32(kn1, vn1, D);
            D = MFMA32(nb0, Qf[ct][0], D); D = MFMA32(nb1, Qf[ct][1], D);
            scale_rows(D, gc1 + 32 * kt, hi);
#pragma unroll
            for (int c = 0; c < 2; ++c) { D = MFMA32(G2Tf[c][kt][0], D1c[c][0], D); D = MFMA32(G2Tf[c][kt][1], D1c[c][1], D); }
            *(bf16x8*)(Dgp + (kt * 2 + ct) * 2048) = accfrag(D, 0); *(bf16x8*)(Dgp + (kt * 2 + ct) * 2048 + 16) = accfrag(D, 1);
            f32x16 G; zero16(G);
#pragma unroll
            for (int c = 0; c < 2; ++c) { G = MFMA32(G2Tf[c][kt][0], G1c[c][0], G); G = MFMA32(G2Tf[c][kt][1], G1c[c][1], G); }
#pragma unroll
            for (int r = 0; r < 16; ++r) bstore16((short)f2bf(G[r]), rsG, ((r32 >> 4) * 64 + ((r32 >> 2) & 1) * 32 + 4 * hi) * 16 + (4 * ((r32 >> 3) & 1) + (r32 & 3)) * 2, so + ((kt * 4 + 2 * ct) * 64 + (r & 3) + 8 * (r >> 2)) * 16, 0);
        }
    }
}
__device__ __forceinline__ void scan_stageB(const Params& p, int task_, int lane) {
    const int task = __builtin_amdgcn_readfirstlane(task_);
    const int bh = task >> 1, vt = task & 1, r32 = lane & 31, hi = lane >> 5;
    f32x16 H[2]; zero16(H[0]); zero16(H[1]);
    const rsrc_t rsG = mk_rsrc(SCAN_TMP(p) + OFF_GCH, 16u << 20), rsD = mk_rsrc(SCAN_TMP(p) + OFF_DCH, 16u << 20), rsH = mk_rsrc(p.ws + OFF_HST, 16u << 20);
    const int vg = r32 * 128 + hi * 8, vl = lane * 32 + vt * 2048;
    constexpr int DEPTH = 3;
    bf16x8 Gf[DEPTH][2][4]; u32x4 Dd[DEPTH][2][2];
#define SB_LOAD(SLOT, C) { const int so_ = (bh * 64 + (C)) * 8192; \
        _Pragma("unroll") for (int kt = 0; kt < 2; ++kt) { _Pragma("unroll") for (int qq = 0; qq < 4; ++qq) Gf[SLOT][kt][qq] = as_bf16x8(__builtin_amdgcn_raw_buffer_load_b128(rsG, lane * 16 + (kt * 4 + qq) * 1024, so_, 0)); \
            Dd[SLOT][kt][0] = __builtin_amdgcn_raw_buffer_load_b128(rsD, vl + kt * 4096, so_, 0); Dd[SLOT][kt][1] = __builtin_amdgcn_raw_buffer_load_b128(rsD, vl + kt * 4096 + 16, so_, 0); } }
#define SB_STEP(SLOT, C) { const int so = (bh * 64 + (C)) * 8192; bf16x8 Hf[2][2]; \
        _Pragma("unroll") for (int kt = 0; kt < 2; ++kt) { Hf[kt][0] = accfrag(H[kt], 0); Hf[kt][1] = accfrag(H[kt], 1); \
            if (!SB_NOSTORE) { bstore128(*reinterpret_cast<const u32x4*>(&Hf[kt][0]), rsH, vl + kt * 4096, so, 0); \
            bstore128(*reinterpret_cast<const u32x4*>(&Hf[kt][1]), rsH, vl + kt * 4096 + 16, so, 0); } } \
        _Pragma("unroll") for (int kt = 0; kt < 2; ++kt) { f32x16 N; \
            _Pragma("unroll") for (int i = 0; i < 4; ++i) { N[2 * i] = lo_f(Dd[SLOT][kt][0][i]); N[2 * i + 1] = hi_f(Dd[SLOT][kt][0][i]); N[8 + 2 * i] = lo_f(Dd[SLOT][kt][1][i]); N[8 + 2 * i + 1] = hi_f(Dd[SLOT][kt][1][i]); } \
            _Pragma("unroll") for (int c2 = 0; c2 < 2; ++c2) _Pragma("unroll") for (int q = 0; q < 2; ++q) N = MFMA32(Gf[SLOT][kt][2 * c2 + q], Hf[c2][q], N); \
            H[kt] = N; } }
    SB_LOAD(0, 0) SB_LOAD(1, 1)
    for (int c = 0; c < 63; c += 3) {
        SB_LOAD(2, c + 2) SB_STEP(0, c)
        SB_LOAD(0, c + 3) SB_STEP(1, c + 1)
        if (c + 4 < 64) SB_LOAD(1, c + 4)
        SB_STEP(2, c + 2)
    }
    SB_STEP(0, 63)
#undef SB_LOAD
#undef SB_STEP
}
__device__ __forceinline__ void scan_stageC(const Params& p, int task_, int lane, size_t yoff, unsigned char* wl) {
    const int task = __builtin_amdgcn_readfirstlane(task_);
    const int bh = task >> 6, c64 = task & 63, b = bh >> 3, hd = bh & 7, r32 = lane & 31, hi = lane >> 5;
    const unsigned char* Hg = p.ws + OFF_HST + (size_t)task * 8192 + lane * 32;
    bf16x8 Hf[2][2][2];
#pragma unroll
    for (int kt = 0; kt < 2; ++kt)
#pragma unroll
        for (int vt = 0; vt < 2; ++vt) { Hf[kt][vt][0] = *(const bf16x8*)(Hg + (kt * 2 + vt) * 2048); Hf[kt][vt][1] = *(const bf16x8*)(Hg + (kt * 2 + vt) * 2048 + 16); }
    const ScanRs R{mk_rsrc(p.ws + OFF_ABAR, 16u << 20), mk_rsrc(p.ws + OFF_BTIL, 16u << 20), mk_rsrc(p.ws + OFF_KTIL, 16u << 20), mk_rsrc(p.ws + OFF_RBAR, 16u << 20), mk_rsrc(p.ws + OFF_SV, 16u << 20)};
    const rsrc_t rsM = mk_rsrc(SCAN_TMP(p) + OFF_MCH, 8u << 20);
    const int vrow = r32 * 1024 + hi * 16, vrowp = r32 * 1024 + hi * 8, vcn = r32 * 2 + hi * 8192, vcp = r32 * 2 + hi * 4096;
#pragma unroll 1
    for (int u = 0; u < 2; ++u) {
        const size_t rb = ((size_t)(b * 4096 + c64 * 64 + 32 * u)) * 512 + hd * 64;
        const int sb = (int)(rb * 2);
        const int sub = (b * 4096 + c64 * 64) / 32 + u, msub = bh * 128 + c64 * 2 + u;
        scan_stage_tiles(wl, R, sb, lane);
        f32x16 xak, xrb, xrk; zero16(xak); zero16(xrb); zero16(xrk);
#ifdef VTEST_OWNM
        f32x16 xab_; zero16(xab_);
#endif
#pragma unroll
        for (int q = 0; q < 4; ++q) {
            const bf16x8 fa = lrow_nat(wl, 0, r32, hi, q), fr = rowfrag_nat(R.rbar, sb, vrow, q), fb = lrow_nat(wl, 1, r32, hi, q), fk = lrow_nat(wl, 2, r32, hi, q);
            xak = MFMA32(fk, fa, xak); xrb = MFMA32(fb, fr, xrb); xrk = MFMA32(fk, fr, xrk);
#ifdef VTEST_OWNM
            xab_ = MFMA32(fb, fa, xab_);
#endif
        }
#pragma unroll
        for (int r = 0; r < 16; ++r) { const int sr = crow(r, hi); xak[r] = sr < r32 ? xak[r] : 0.f; xrb[r] = sr <= r32 ? xrb[r] : 0.f; xrk[r] = sr <= r32 ? xrk[r] : 0.f; }
#if defined(VTEST_OWNM)
#pragma unroll
        for (int r = 0; r < 16; ++r) xab_[r] = crow(r, hi) < r32 ? xab_[r] : 0.f;
        float m_[32];
        tri_inverse_rows(xab_, r32, m_);
        const bf16x8 mn0 = mfrag(m_, 0, hi, false), mn1 = mfrag(m_, 1, hi, false), mp0 = mfrag(m_, 0, hi, true), mp1 = mfrag(m_, 1, hi, true);
#elif defined(VTEST_MI)
        bf16x8 mn0, mn1, mp0, mp1;
#pragma unroll
        for (int e = 0; e < 8; ++e) { mn0[e] = (8 * hi + e == r32) ? 0x3F80 : 0; mn1[e] = (16 + 8 * hi + e == r32) ? 0x3F80 : 0;
            mp0[e] = (8 * (e >> 2) + 4 * hi + (e & 3) == r32) ? 0x3F80 : 0; mp1[e] = (16 + 8 * (e >> 2) + 4 * hi + (e & 3) == r32) ? 0x3F80 : 0; }
#else
        const bf16x8 mn0 = rowfrag_nat(rsM, msub * 2048, r32 * 64 + hi * 16, 0), mn1 = rowfrag_nat(rsM, msub * 2048, r32 * 64 + hi * 16, 1), mp0 = rowfrag_perm(rsM, msub * 2048, r32 * 64 + hi * 8, 0), mp1 = rowfrag_perm(rsM, msub * 2048, r32 * 64 + hi * 8, 1);
#endif
        bf16x8 PTf[2][2];
#pragma unroll
        for (int kt = 0; kt < 2; ++kt) { f32x16 T; zero16(T);
            T = MFMA32(lcol<false>(wl, 0, r32 + 32 * kt, hi, 0), mn0, T); T = MFMA32(lcol<false>(wl, 0, r32 + 32 * kt, hi, 1), mn1, T);
            PTf[kt][0] = accfrag(T, 0); PTf[kt][1] = accfrag(T, 1); }
        const bf16x8 ak0 = accfrag(xak, 0), ak1 = accfrag(xak, 1), rb0 = accfrag(xrb, 0), rb1 = accfrag(xrb, 1), rk0 = accfrag(xrk, 0), rk1 = accfrag(xrk, 1);
        bf16x8 Uf[2][2];
#pragma unroll
        for (int vt = 0; vt < 2; ++vt) {
        __builtin_amdgcn_sched_barrier(0);
            const bf16x8 vp0 = lcol<true>(wl, 3, r32 + 32 * vt, hi, 0), vp1 = lcol<true>(wl, 3, r32 + 32 * vt, hi, 1);
            f32x16 W; zero16(W);
            W = MFMA32(ak0, vp0, W); W = MFMA32(ak1, vp1, W);
            f32x16 U; zero16(U);
            U = MFMA32(mp0, accfrag(W, 0), U); U = MFMA32(mp1, accfrag(W, 1), U);
#pragma unroll
            for (int kt = 0; kt < 2; ++kt) { U = MFMA32(PTf[kt][0], Hf[kt][vt][0], U); U = MFMA32(PTf[kt][1], Hf[kt][vt][1], U); }
#pragma unroll
            for (int r = 0; r < 16; ++r) U[r] = -U[r];
            Uf[vt][0] = accfrag(U, 0); Uf[vt][1] = accfrag(U, 1);
            f32x16 Y; zero16(Y);
#pragma unroll
            for (int kt = 0; kt < 2; ++kt) { Y = MFMA32(rowfrag_perm(R.rbar, sb, vrowp, 2 * kt), Hf[kt][vt][0], Y); Y = MFMA32(rowfrag_perm(R.rbar, sb, vrowp, 2 * kt + 1), Hf[kt][vt][1], Y); }
#ifndef VTEST_NOU
            Y = MFMA32(rb0, Uf[vt][0], Y); Y = MFMA32(rb1, Uf[vt][1], Y);
#endif
            Y = MFMA32(rk0, vp0, Y); Y = MFMA32(rk1, vp1, Y);
            bf16_t* yo = (bf16_t*)(p.ws + yoff) + rb + 32 * vt + r32;
#pragma unroll
#ifdef VTEST_YU
            for (int r = 0; r < 16; ++r) Y[r] = U[r];
#pragma unroll
#endif
#ifdef SCAN_VERIFY
            for (int r = 0; r < 16; ++r) yo[(size_t)crow(r, hi) * 512] = f2bf(Y[r]);
#else
            for (int r = 0; r < 16; ++r) { (void)yo; *(unsigned short*)(wl + crow(r, hi) * 144 + (32 * vt + r32) * 2) = (unsigned short)f2bf(Y[r]); }
#endif
        }
#ifndef SCAN_VERIFY
        {
            __builtin_amdgcn_wave_barrier(); asm volatile("s_waitcnt lgkmcnt(0)" ::: "memory");
            const int ts = lane >> 4, cg = lane & 15, ch = hd * 64 + cg * 4;
            const f32x4 lw = *(const f32x4*)(p.in[23] + ch), lb = *(const f32x4*)(p.in[24] + ch);
            u32x2 gq[8]; float bq[8];
#pragma unroll
            for (int it = 0; it < 8; ++it) { const int tk = it * 4 + ts;
                gq[it] = *(const u32x2*)((const bf16_t*)(p.ws + OFF_SG) + rb + (size_t)tk * 512 + cg * 4);
                bq[it] = ((const float*)(p.ws + OFF_BONUS))[(size_t)(b * 4096 + c64 * 64 + 32 * u + tk) * 8 + hd]; }
#pragma unroll
            for (int it = 0; it < 8; ++it) {
                const int tk = it * 4 + ts; const size_t o = rb + (size_t)tk * 512 + cg * 4;
                const f32x4 y = bf4(*(const u32x2*)(wl + tk * 144 + cg * 8));
                const float mean = reduce16((y[0] + y[1]) + (y[2] + y[3])) * (1.f / 64.f);
                const f32x4 d = y - mean;
                const float var = reduce16((d[0] * d[0] + d[1] * d[1]) + (d[2] * d[2] + d[3] * d[3])) * (1.f / 64.f);
                const float rs = rsqrtf(var + 64e-5f);
                const f32x4 vv = bf4(*(const u32x2*)(wl + 3 * 4608 + tk * 144 + cg * 8));
                const float bonus = bq[it];
                const f32x4 yn = d * rs * lw + lb + vv * bonus;
                const f32x4 g = bf4(gq[it]);
                *(u32x2*)((bf16_t*)(p.ws + OFF_YG) + o) = pk4(yn * g);
            }
        }
#endif
        if (u == 0) {
            const float* gc = (const float*)(p.ws + OFF_GC) + (size_t)sub * 512 + hd * 64;
#pragma unroll
            for (int kt = 0; kt < 2; ++kt) {
        __builtin_amdgcn_sched_barrier(0);
                const bf16x8 bt0 = lcol<true>(wl, 1, r32 + 32 * kt, hi, 0), bt1 = lcol<true>(wl, 1, r32 + 32 * kt, hi, 1);
                const bf16x8 kn0 = lcol<false>(wl, 2, r32 + 32 * kt, hi, 0), kn1 = lcol<false>(wl, 2, r32 + 32 * kt, hi, 1);
#pragma unroll
                for (int vt = 0; vt < 2; ++vt) {
        __builtin_amdgcn_sched_barrier(0);
                    const u32x4 h0 = *reinterpret_cast<const u32x4*>(&Hf[kt][vt][0]), h1 = *reinterpret_cast<const u32x4*>(&Hf[kt][vt][1]);
                    f32x16 N;
#pragma unroll
                    for (int i = 0; i < 4; ++i) { N[2 * i] = lo_f(h0[i]); N[2 * i + 1] = hi_f(h0[i]); N[8 + 2 * i] = lo_f(h1[i]); N[8 + 2 * i + 1] = hi_f(h1[i]); }
                    N = MFMA32(bt0, Uf[vt][0], N); N = MFMA32(bt1, Uf[vt][1], N);
                    N = MFMA32(kn0, lcol<false>(wl, 3, r32 + 32 * vt, hi, 0), N); N = MFMA32(kn1, lcol<false>(wl, 3, r32 + 32 * vt, hi, 1), N);
                    scale_rows(N, gc + 32 * kt, hi);
                    Hf[kt][vt][0] = accfrag(N, 0); Hf[kt][vt][1] = accfrag(N, 1);
                }
            }
        }
    }
}


__device__ __forceinline__ void p4_rwkv_prep_chunked(const Params& p) {
    const int lane = otid() & 63, gw = blockIdx.x * 8 + (otid() >> 6), nw = gridDim.x * 8, ts = lane >> 4, cg = lane & 15;
    const bf16_t* P = (const bf16_t*)(p.ws + OFF_P);
    for (int task = gw; task < (T_TOK / 32) * 8; task += nw) {
        const int sub = task >> 3, hd = task & 7, ch = hd * 64 + cg * 4;
        f32x4 carry = {0.f, 0.f, 0.f, 0.f};
        for (int g = 0; g < 8; ++g) {
            const int t = sub * 32 + g * 4 + ts;
            const bf16_t* row = P + (size_t)t * NPA;
            const bool first = (t & 4095) == 0;
            const f32x4 r0 = bf4(*(const u32x2*)(row + C_R + ch)), k0 = bf4(*(const u32x2*)(row + C_K + ch)), v0 = bf4(*(const u32x2*)(row + C_V + ch));
            f32x4 rp = {0.f, 0.f, 0.f, 0.f}, kp = rp, vp = rp;
            if (!first) { rp = bf4(*(const u32x2*)(row + C_R + ch - NPA)); kp = bf4(*(const u32x2*)(row + C_K + ch - NPA)); vp = bf4(*(const u32x2*)(row + C_V + ch - NPA)); }
            const float* mu = p.in[7];
            const f32x4 r = r0 + (rp - r0) * *(const f32x4*)(mu + ch), k = k0 + (kp - k0) * *(const f32x4*)(mu + 512 + ch), v = v0 + (vp - v0) * *(const f32x4*)(mu + 1024 + ch);
            const size_t o = (size_t)t * 512 + ch;
            const f32x4 dec = *(const f32x4*)(p.in[16] + ch) + bf4(*(const u32x2*)((const bf16_t*)(p.ws + OFF_SE) + o));
            const f32x4 apre = *(const f32x4*)(p.in[18] + ch) + bf4(*(const u32x2*)((const bf16_t*)(p.ws + OFF_SB) + o));
            const f32x4 kkw = *(const f32x4*)(p.in[20] + ch), kaw = *(const f32x4*)(p.in[21] + ch), rkw = *(const f32x4*)(p.in[22] + ch);
            f32x4 e, a, kkr, kh;
            float n2 = 0.f, bn = 0.f;
#pragma unroll
            for (int i = 0; i < 4; ++i) {
                const float nd = -dec[i], sp = fmaxf(nd, 0.f) + __logf(1.f + __expf(-fabsf(nd)));
                e[i] = __expf(-sp - 0.5f);
                a[i] = sigmoidf_(apre[i]);
                kkr[i] = k[i] * kkw[i]; n2 += kkr[i] * kkr[i];
                kh[i] = k[i] * (1.f + (a[i] - 1.f) * kaw[i]);
                bn += r[i] * kh[i] * rkw[i];
            }
            n2 = reduce16(n2); bn = reduce16(bn);
            const f32x4 kk = kkr * __builtin_amdgcn_rsqf(fmaxf(n2, 1e-24f));
            f32x4 pe = e;
#pragma unroll
            for (int i = 0; i < 4; ++i) { const float u1 = __shfl_up(pe[i], 16); if (ts >= 1) pe[i] += u1; }
#pragma unroll
            for (int i = 0; i < 4; ++i) { const float u2 = __shfl_up(pe[i], 32); if (ts >= 2) pe[i] += u2; }
            const f32x4 cs = carry + pe, csm = cs - e;
#pragma unroll
            for (int i = 0; i < 4; ++i) carry[i] += __shfl(pe[i], 48 + cg);
            f32x4 gm, gi, gp;
#pragma unroll
            for (int i = 0; i < 4; ++i) { gm[i] = __expf(-cs[i]); gi[i] = __expf(cs[i]); gp[i] = __expf(-csm[i]); }
            *(u32x2*)((bf16_t*)(p.ws + OFF_ABAR) + o) = pk4(kk * gp); *(u32x2*)((bf16_t*)(p.ws + OFF_BTIL) + o) = pk4(kk * a * gi); *(u32x2*)((bf16_t*)(p.ws + OFF_KTIL) + o) = pk4(kh * gi);
            *(u32x2*)((bf16_t*)(p.ws + OFF_RBAR) + o) = pk4(r * gm); *(u32x2*)((bf16_t*)(p.ws + OFF_SV) + o) = pk4(v);
            if (cg == 0) ((float*)(p.ws + OFF_BONUS))[(size_t)t * 8 + hd] = bn;
            if (g == 7 && ts == 3) *(f32x4*)((float*)(p.ws + OFF_GC) + (size_t)sub * 512 + ch) = gm;
        }
    }
}
__device__ __forceinline__ void p4c_tile2(const Params& p, int sub, int hd0, int lane, const unsigned char* decp, const unsigned char* aprp) {
    const int ts = lane >> 4, cg = lane & 15;
    const bf16_t* P = (const bf16_t*)(p.ws + OFF_P);
    const float* mu = p.in[7];
    f32x4 mur[2], muk[2], muv[2], decb[2], aaab[2], kkw[2], kaw[2], rkw[2], carry[2];
#pragma unroll
    for (int h = 0; h < 2; ++h) { const int ch = (hd0 + h) * 64 + cg * 4;
        mur[h] = *(const f32x4*)(mu + ch); muk[h] = *(const f32x4*)(mu + 512 + ch); muv[h] = *(const f32x4*)(mu + 1024 + ch);
        decb[h] = *(const f32x4*)(p.in[16] + ch); aaab[h] = *(const f32x4*)(p.in[18] + ch);
        kkw[h] = *(const f32x4*)(p.in[20] + ch); kaw[h] = *(const f32x4*)(p.in[21] + ch); rkw[h] = *(const f32x4*)(p.in[22] + ch); carry[h] = (f32x4){0.f, 0.f, 0.f, 0.f}; }
    u32x2 in_[2][6], nx_[2][6];
    auto fetch = [&](int g, u32x2 (&d)[2][6]) {
        const int t = sub * 32 + g * 4 + ts; const bf16_t* row = P + (size_t)t * NPA; const int po = ((t & 4095) == 0) ? 0 : NPA;
#pragma unroll
        for (int h = 0; h < 2; ++h) { const int ch = (hd0 + h) * 64 + cg * 4;
            d[h][0] = *(const u32x2*)(row + C_R + ch); d[h][1] = *(const u32x2*)(row + C_K + ch); d[h][2] = *(const u32x2*)(row + C_V + ch);
            d[h][3] = *(const u32x2*)(row + C_R + ch - po); d[h][4] = *(const u32x2*)(row + C_K + ch - po); d[h][5] = *(const u32x2*)(row + C_V + ch - po); }
    };
    fetch(0, in_);
#pragma unroll 1
    for (int g = 0; g < 8; ++g) {
        const int t = sub * 32 + g * 4 + ts;
        const bool first = (t & 4095) == 0;
        fetch(g < 7 ? g + 1 : 7, nx_);
#pragma unroll
        for (int h = 0; h < 2; ++h) {
            const int hd = hd0 + h, ch = hd * 64 + cg * 4;
            const f32x4 r0 = bf4(in_[h][0]), k0 = bf4(in_[h][1]), v0 = bf4(in_[h][2]);
            f32x4 rp = bf4(in_[h][3]), kp = bf4(in_[h][4]), vp = bf4(in_[h][5]);
            if (first) { rp = (f32x4){0.f, 0.f, 0.f, 0.f}; kp = rp; vp = rp; }
            const f32x4 r = r0 + (rp - r0) * mur[h], k = k0 + (kp - k0) * muk[h], v = v0 + (vp - v0) * muv[h];
            const size_t o = (size_t)t * 512 + ch;
            const f32x4 dec = decb[h] + bf4(*(const u32x2*)(decp + (g * 4 + ts) * 272 + h * 128 + cg * 8));
            const f32x4 apre = aaab[h] + bf4(*(const u32x2*)(aprp + (g * 4 + ts) * 272 + h * 128 + cg * 8));
            f32x4 e, a, kkr, kh;
            float n2 = 0.f, bn = 0.f;
#pragma unroll
            for (int i = 0; i < 4; ++i) {
                const float nd = -dec[i], sp = fmaxf(nd, 0.f) + __logf(1.f + __expf(-fabsf(nd)));
                e[i] = __expf(-sp - 0.5f);
                a[i] = sigmoidf_(apre[i]);
                kkr[i] = k[i] * kkw[h][i]; n2 += kkr[i] * kkr[i];
                kh[i] = k[i] * (1.f + (a[i] - 1.f) * kaw[h][i]);
                bn += r[i] * kh[i] * rkw[h][i];
            }
            n2 = reduce16(n2); bn = reduce16(bn);
            const f32x4 kk = kkr * __builtin_amdgcn_rsqf(fmaxf(n2, 1e-24f));
            f32x4 pe = e;
#pragma unroll
            for (int i = 0; i < 4; ++i) { const float u1 = __shfl_up(pe[i], 16); if (ts >= 1) pe[i] += u1; }
#pragma unroll
            for (int i = 0; i < 4; ++i) { const float u2 = __shfl_up(pe[i], 32); if (ts >= 2) pe[i] += u2; }
            const f32x4 cs = carry[h] + pe, csm = cs - e;
#pragma unroll
            for (int i = 0; i < 4; ++i) carry[h][i] += __shfl(pe[i], 48 + cg);
            f32x4 gm, gi, gp;
#pragma unroll
            for (int i = 0; i < 4; ++i) { gm[i] = __expf(-cs[i]); gi[i] = __expf(cs[i]); gp[i] = __expf(-csm[i]); }
            *(u32x2*)((bf16_t*)(p.ws + OFF_ABAR) + o) = pk4(kk * gp); *(u32x2*)((bf16_t*)(p.ws + OFF_BTIL) + o) = pk4(kk * a * gi); *(u32x2*)((bf16_t*)(p.ws + OFF_KTIL) + o) = pk4(kh * gi);
            *(u32x2*)((bf16_t*)(p.ws + OFF_RBAR) + o) = pk4(r * gm); *(u32x2*)((bf16_t*)(p.ws + OFF_SV) + o) = pk4(v);
            if (cg == 0) ((float*)(p.ws + OFF_BONUS))[(size_t)t * 8 + hd] = bn;
            if (g == 7 && ts == 3) *(f32x4*)((float*)(p.ws + OFF_GC) + (size_t)sub * 512 + ch) = gm;
        }
#pragma unroll
        for (int h = 0; h < 2; ++h)
#pragma unroll
            for (int i = 0; i < 6; ++i) in_[h][i] = nx_[h][i];
    }
}
__device__ __forceinline__ void p5c_epilogue_chunked(const Params& p) {
    const int lane = otid() & 63, gw = blockIdx.x * 8 + (otid() >> 6), nw = gridDim.x * 8, ts = lane >> 4, cg = lane & 15;
    for (int task = gw; task < (T_TOK / 4) * 8; task += nw) {
        const int t = (task >> 3) * 4 + ts, hd = task & 7, ch = hd * 64 + cg * 4;
        const size_t o = (size_t)t * 512 + ch;
        const f32x4 y = bf4(*(const u32x2*)((const bf16_t*)(p.ws + OFF_YCH) + o));
        const float mean = reduce16((y[0] + y[1]) + (y[2] + y[3])) * (1.f / 64.f);
        const f32x4 d = y - mean;
        const float var = reduce16((d[0] * d[0] + d[1] * d[1]) + (d[2] * d[2] + d[3] * d[3])) * (1.f / 64.f);
        const float rs = rsqrtf(var + 64e-5f);
        const f32x4 vv = bf4(*(const u32x2*)((const bf16_t*)(p.ws + OFF_SV) + o));
        const float bonus = ((const float*)(p.ws + OFF_BONUS))[(size_t)t * 8 + hd];
        const f32x4 yn = d * rs * *(const f32x4*)(p.in[23] + ch) + *(const f32x4*)(p.in[24] + ch) + vv * bonus;
        const f32x4 g = bf4(*(const u32x2*)((const bf16_t*)(p.ws + OFF_SG) + o));
        *(u32x2*)((bf16_t*)(p.ws + OFF_YG) + o) = pk4(yn * g);
    }
}
__device__ __forceinline__ void p5_stageA(const Params& p, unsigned char* lds) { const int lane = otid() & 63, wid = otid() >> 6, gw = blockIdx.x * 8 + wid, nw = gridDim.x * 8; for (int task = gw; task < 2048; task += nw) scan_stageA(p, task, lane, lds + wid * 18432); }
__device__ __forceinline__ void p5_stageA_local(const Params& p, unsigned char* lds, const XcdBarrier& xb) {
    const int lane = otid() & 63, wid = otid() >> 6;
    if (gridDim.x == 256) {
        asm volatile("s_waitcnt vmcnt(0)" ::: "memory");
        __syncthreads();
        scan_stageA(p, (((int)blockIdx.x >> 6) * 8 + wid) * 64 + ((int)blockIdx.x & 63), lane, lds + wid * 18432);
    } else { xcd_barrier(xb); p5_stageA(p, lds); }
}
__device__ __forceinline__ void p5_stageC(const Params& p, unsigned char* lds) { const int lane = otid() & 63, wid = otid() >> 6, gw = blockIdx.x * 8 + wid, nw = gridDim.x * 8; for (int task = gw; task < 2048; task += nw) scan_stageC(p, task, lane, OFF_YCH, lds + wid * 18432); }
__device__ __forceinline__ void p5_stageB(const Params& p) { const int lane = otid() & 63, wid = otid() >> 6; if (wid < 2 && blockIdx.x < 32) scan_stageB(p, blockIdx.x * 2 + wid, lane); }

#ifdef VTEST_NAIVE
__device__ __forceinline__ void scan_naive0(const Params& p, int bh, int lane) {
    const int b = bh >> 3, hd = bh & 7;
    const bf16_t* ABAR = (const bf16_t*)(p.ws + OFF_ABAR); const bf16_t* BTIL = (const bf16_t*)(p.ws + OFF_BTIL); const bf16_t* KTIL = (const bf16_t*)(p.ws + OFF_KTIL);
    const bf16_t* RBAR = (const bf16_t*)(p.ws + OFF_RBAR); const bf16_t* SV = (const bf16_t*)(p.ws + OFF_SV);
    float H[64];
#pragma unroll
    for (int k = 0; k < 64; ++k) H[k] = 0.f;
    for (int t = 0; t < 32; ++t) {
        const size_t ro = ((size_t)(b * 4096 + t)) * 512 + hd * 64;
        const float vv = bf2f(SV[ro + lane]);
        float u = 0.f;
#pragma unroll
        for (int k = 0; k < 64; ++k) u -= bf2f(ABAR[ro + k]) * H[k];
        const float u_keep = u;
#ifdef VTEST_MI
        u = 0.f;
#endif
        float y = 0.f;
#ifdef VTEST_NOU
        u = 0.f;
#endif
#pragma unroll
        for (int k = 0; k < 64; ++k) { H[k] += bf2f(BTIL[ro + k]) * u + bf2f(KTIL[ro + k]) * vv; y += bf2f(RBAR[ro + k]) * H[k]; }
#ifdef VTEST_YU
        y = u_keep;
#endif
#if VTEST_NAIVE == 2
        YRAW_PTR(p)[ro + lane] = f2bf(y);
#else
        ((bf16_t*)(p.ws + OFF_YCH))[ro + lane] = f2bf(y);
#endif
    }
}
#endif
#ifdef SCAN_VERIFY
__device__ __forceinline__ void scan_compare(const Params& p) {
    float sd = 0.f, sr = 0.f;
    const bf16_t* A = (const bf16_t*)((const unsigned char*)p.out + 0); const bf16_t* B = (const bf16_t*)(p.ws + OFF_YCH);
    for (size_t i = (size_t)blockIdx.x * NTHREADS + otid(); i < (size_t)T_TOK * 512; i += (size_t)gridDim.x * NTHREADS) { const int spos = (int)((i >> 9) & 4095);
#ifdef VSEL_LO
        if (spos < VSEL_LO || spos >= VSEL_HI) continue;
#endif
        const float a = bf2f(A[i]), b = bf2f(B[i]); sd += (a - b) * (a - b); sr += a * a; }
    sd = wave_sum(sd); sr = wave_sum(sr);
    if ((otid() & 63) == 0) { atomicAdd((float*)(p.ws + OFF_CTR) + 8, sd); atomicAdd((float*)(p.ws + OFF_CTR) + 9, sr); }
    unsigned mask = 0;
    auto scan16 = [&](const bf16_t* X, size_t n, unsigned bit) { for (size_t i = (size_t)blockIdx.x * NTHREADS + otid(); i < n; i += (size_t)gridDim.x * NTHREADS) if ((X[i] & 0x7F80u) == 0x7F80u) mask |= bit; };
    scan16((const bf16_t*)(SCAN_TMP(p) + OFF_MCH), (size_t)4096 * 1024, 1u); scan16((const bf16_t*)(SCAN_TMP(p) + OFF_GCH), (size_t)2048 * 4096, 2u);
    scan16((const bf16_t*)(SCAN_TMP(p) + OFF_DCH), (size_t)2048 * 4096, 4u); scan16((const bf16_t*)(p.ws + OFF_HST), (size_t)2048 * 4096, 8u);
    scan16(B, (size_t)T_TOK * 512, 16u); scan16(A, (size_t)T_TOK * 512, 32u);
    scan16((const bf16_t*)(p.ws + OFF_ABAR), (size_t)T_TOK * 512, 64u); scan16((const bf16_t*)(p.ws + OFF_BTIL), (size_t)T_TOK * 512, 64u); scan16((const bf16_t*)(p.ws + OFF_KTIL), (size_t)T_TOK * 512, 64u); scan16((const bf16_t*)(p.ws + OFF_RBAR), (size_t)T_TOK * 512, 64u);
    if (mask) atomicOr((unsigned*)(p.ws + OFF_CTR) + 10, mask);
}
#endif

__device__ __forceinline__ void p5b_scan_epilogue(const Params& p) {
    const int lane = otid() & 63, gw = blockIdx.x * 8 + (otid() >> 6), nw = gridDim.x * 8, ts = lane >> 4, cg = lane & 15;
    for (int task = gw; task < (T_TOK / 4) * 8; task += nw) {
        const int t = (task >> 3) * 4 + ts, hd = task & 7, ch = hd * 64 + cg * 4;
        const size_t o = (size_t)t * 512 + ch;
        const f32x4 y = bf4(*(const u32x2*)((const bf16_t*)(p.ws + OFF_YRAW) + o));
        const float mean = reduce16((y[0] + y[1]) + (y[2] + y[3])) * (1.f / 64.f);
        const f32x4 d = y - mean;
        const float var = reduce16((d[0] * d[0] + d[1] * d[1]) + (d[2] * d[2] + d[3] * d[3])) * (1.f / 64.f);
        const float rs = rsqrtf(var + 64e-5f);
        const f32x4 rr = bf4(*(const u32x2*)((const bf16_t*)(p.ws + OFF_SR) + o)), kh = bf4(*(const u32x2*)((const bf16_t*)(p.ws + OFF_SKH) + o)), vv = bf4(*(const u32x2*)((const bf16_t*)(p.ws + OFF_SV) + o));
        const f32x4 rk = *(const f32x4*)(p.in[22] + ch), pr = rr * kh * rk;
        const float bonus = reduce16((pr[0] + pr[1]) + (pr[2] + pr[3]));
        const f32x4 yn = d * rs * *(const f32x4*)(p.in[23] + ch) + *(const f32x4*)(p.in[24] + ch) + vv * bonus;
        const f32x4 g = bf4(*(const u32x2*)((const bf16_t*)(p.ws + OFF_SG) + o));
        *(u32x2*)((bf16_t*)(p.ws + OFF_YG) + o) = pk4(yn * g);
    }
}
constexpr int AT_KLD = 208, AT_VLD = 144, AT_KBYTES = 64 * AT_KLD, AT_VBYTES = 64 * AT_VLD, AT_STAGE = AT_KBYTES + AT_VBYTES;
__device__ __forceinline__ void attn_item(const Params& p, int bh, int qb, unsigned char* lds) {
    const int b = bh >> 3, hd = bh & 7, tid = otid(), lane = tid & 63, wid = tid >> 6, r32 = lane & 31, hi = lane >> 5;
    const int qloc = wid * 32 + r32;
    const bf16_t* Q = (const bf16_t*)((const unsigned char*)p.out + DO_Q) + ((size_t)(b * 4096 + qb * 256 + qloc)) * 768 + hd * 96 + hi * 8;
    const bf16_t* Kg = (const bf16_t*)((const unsigned char*)p.out + DO_K) + ((size_t)(b * 4096)) * 768 + hd * 96;
    const bf16_t* Vg = (const bf16_t*)((const unsigned char*)p.out + DO_VT) + ((size_t)(b * 8 + hd) * 64) * 4096;
    bf16x8 qf[6];
#pragma unroll
    for (int s = 0; s < 6; ++s) qf[s] = *(const bf16x8*)(Q + s * 16);
    f32x16 o0, o1;
#pragma unroll
    for (int r = 0; r < 16; ++r) { o0[r] = 0.f; o1[r] = 0.f; }
    float l = 0.f;
    const int nkt = 4 * qb + 4, mylast = 4 * qb + (wid >> 1);
    u32x4 stA[3], stB[3];
    auto gload = [&](int ktK, int ktV, u32x4 (&st)[3]) {
#pragma unroll
        for (int i = 0; i < 3; ++i) { const int c = tid + NTHREADS * i;
            if (c < 768) { if (ktK < nkt) { const int row = c / 12, cc = c - row * 12; st[i] = *(const u32x4*)(Kg + (size_t)(ktK * 64 + row) * 768 + cc * 8); } }
            else if (c < 1280) { if (ktV < nkt) { const int c2 = c - 768, dv = c2 >> 3, kc = c2 & 7; st[i] = *(const u32x4*)(Vg + (size_t)dv * 4096 + ktV * 64 + kc * 8); } } }
    };
    auto swrite = [&](int ktK, int ktV, const u32x4 (&st)[3]) {
#pragma unroll
        for (int i = 0; i < 3; ++i) { const int c = tid + NTHREADS * i;
            if (c < 768) { if (ktK < nkt) { const int row = c / 12, cc = c - row * 12; *(u32x4*)(lds + (ktK & 1) * AT_STAGE + row * AT_KLD + cc * 16) = st[i]; } }
            else if (c < 1280) { if (ktV < nkt) { const int c2 = c - 768, dv = c2 >> 3, kc = c2 & 7; *(u32x4*)(lds + (ktV & 1) * AT_STAGE + AT_KBYTES + dv * AT_VLD + kc * 16) = st[i]; } } }
    };
    auto qk = [&](int kt, f32x16& a0, f32x16& a1) {
        const unsigned char* sk = lds + (kt & 1) * AT_STAGE + r32 * AT_KLD + hi * 16;
        bf16x8 kf[12];
#pragma unroll
        for (int s = 0; s < 6; ++s) { kf[2 * s] = *(const bf16x8*)(sk + s * 32); kf[2 * s + 1] = *(const bf16x8*)(sk + 32 * AT_KLD + s * 32); }
        __builtin_amdgcn_sched_barrier(0);
#pragma unroll
        for (int r = 0; r < 16; ++r) { a0[r] = 0.f; a1[r] = 0.f; }
#pragma unroll
        for (int s = 0; s < 6; ++s) { a0 = MFMA32(kf[2 * s], qf[s], a0); a1 = MFMA32(kf[2 * s + 1], qf[s], a1); }
    };
    auto body = [&](int kt, f32x16& c0, f32x16& c1, f32x16& x0, f32x16& x1, const u32x4 (&stW)[3], u32x4 (&stL)[3]) {
        gload(kt + 3, kt + 2, stL);
        if (kt + 1 <= mylast) qk(kt + 1, x0, x1);
        if (kt <= mylast) {
            const unsigned char* sv = lds + (kt & 1) * AT_STAGE + AT_KBYTES + r32 * AT_VLD + hi * 16;
            bf16x8 vf[8];
#pragma unroll
            for (int ks = 0; ks < 4; ++ks) { vf[2 * ks] = *(const bf16x8*)(sv + ks * 32); vf[2 * ks + 1] = *(const bf16x8*)(sv + 32 * AT_VLD + ks * 32); }
            __builtin_amdgcn_sched_barrier(0);
            if (kt == mylast) {
                const int kbase = (kt - 4 * qb) * 64;
#pragma unroll
                for (int r = 0; r < 16; ++r) { if (kbase + crow(r, hi) > qloc) c0[r] = -1e30f; if (kbase + 32 + crow(r, hi) > qloc) c1[r] = -1e30f; }
            }
            float ps = 0.f;
#pragma unroll
            for (int r = 0; r < 16; ++r) { c0[r] = __builtin_amdgcn_exp2f(c0[r]); c1[r] = __builtin_amdgcn_exp2f(c1[r]); ps += c0[r] + c1[r]; }
            l += ps;
            u32x4 pw[4];
#pragma unroll
            for (int q = 0; q < 2; ++q) {
                pw[q].x = pk2(c0[8 * q + 0], c0[8 * q + 1]); pw[q].y = pk2(c0[8 * q + 2], c0[8 * q + 3]); pw[q].z = pk2(c0[8 * q + 4], c0[8 * q + 5]); pw[q].w = pk2(c0[8 * q + 6], c0[8 * q + 7]);
                pw[2 + q].x = pk2(c1[8 * q + 0], c1[8 * q + 1]); pw[2 + q].y = pk2(c1[8 * q + 2], c1[8 * q + 3]); pw[2 + q].z = pk2(c1[8 * q + 4], c1[8 * q + 5]); pw[2 + q].w = pk2(c1[8 * q + 6], c1[8 * q + 7]);
            }
#pragma unroll
            for (int ks = 0; ks < 4; ++ks) { o0 = MFMA32(vf[2 * ks], as_bf16x8(pw[ks]), o0); o1 = MFMA32(vf[2 * ks + 1], as_bf16x8(pw[ks]), o1); }
        }
        swrite(kt + 2, kt + 1, stW);
        __syncthreads();
    };
    __syncthreads();
    gload(0, 0, stA); gload(1, nkt, stB);
    swrite(0, 0, stA); swrite(1, nkt, stB);
    gload(2, 1, stB);
    __syncthreads();
    f32x16 sa0, sa1, sb0, sb1;
    qk(0, sa0, sa1);
#pragma unroll 1
    for (int kt = 0; kt < nkt; kt += 2) { body(kt, sa0, sa1, sb0, sb1, stB, stA); body(kt + 1, sb0, sb1, sa0, sa1, stA, stB); }
    l = xhalf_sum(l);
    const float il = 1.f / l;
    bf16_t* O = (bf16_t*)(p.ws + OFF_OMLA) + ((size_t)(b * 4096 + qb * 256 + qloc)) * 512 + hd * 64 + 4 * hi;
#pragma unroll
    for (int rq = 0; rq < 4; ++rq) {
        u32x2 w0, w1;
        w0.x = pk2(o0[rq * 4 + 0] * il, o0[rq * 4 + 1] * il); w0.y = pk2(o0[rq * 4 + 2] * il, o0[rq * 4 + 3] * il);
        w1.x = pk2(o1[rq * 4 + 0] * il, o1[rq * 4 + 1] * il); w1.y = pk2(o1[rq * 4 + 2] * il, o1[rq * 4 + 3] * il);
        *(u32x2*)(O + 8 * rq) = w0; *(u32x2*)(O + 32 + 8 * rq) = w1;
    }
}
__device__ __forceinline__ void p5_attn_scan(const Params& p, unsigned char* lds) {
#ifdef CHUNKED
    p5_stageB(p);
#elif !defined(SKIP_SCAN)
    if (blockIdx.x < 128) scan_task(p, blockIdx.x, lds);
#endif
#ifdef SKIP_ATTN
    return;
#endif
    unsigned* ctr = (unsigned*)(p.ws + OFF_CTR);
    unsigned* slot = (unsigned*)(lds + 2 * AT_STAGE);
    for (;;) {
        __syncthreads();
        if (otid() == 0) *slot = atomicAdd(ctr, 1u);
        __syncthreads();
        const unsigned n = *slot;
        if (n >= 512u) break;
        attn_item(p, n & 31, 15 - (n >> 5), lds);
    }
}

__device__ __forceinline__ void p6_merge(const Params& p, PG8_LAS unsigned char* ldsl) {
    static_assert(OFF_YG == OFF_OMLA + (size_t)64 * 256 * 512 * 2 && OFF_WORWKV == OFF_WOMLA + (size_t)4 * 256 * 512 * 2, "chained second operand pair = unit (pm + 64, pn + 4)");
    pg8::ChainOrder S; S.S.init(T_TOK, 1024, gridDim.x, blockIdx.x);
    const pg8::Gemm g{(const bf16_t*)(p.ws + OFF_OMLA), (const bf16_t*)(p.ws + OFF_WOMLA), T_TOK, 1024, 512};
    const pg8::EpiMergeChain E{(bf16_t*)(p.ws + OFF_MERGED), p.ws + OFF_G8};
    pg8::gemm_phase(ldsl, g, S, E);
}
__device__ __forceinline__ void p7_mix(const Params& p, PG8_LAS unsigned char* ldsl) {
    pg8::StaticOrder S; S.init(T_TOK, 1024, gridDim.x, blockIdx.x);
    const pg8::Gemm g{(const bf16_t*)(p.ws + OFF_MERGED), (const bf16_t*)(p.ws + OFF_WOUT), T_TOK, 1024, 1024};
    const pg8::EpiMix E{p.in[0], (bf16_t*)(p.ws + OFF_X1), (const float*)(p.ws + OFF_MOD)};
    pg8::gemm_phase(ldsl, g, S, E);
}
constexpr size_t OFF_E8D = OFF_S + 32 * MiB, OFF_E8U = OFF_E8D + 16 * MiB, OFF_ESC = OFF_E8U + 16 * MiB;
__device__ __forceinline__ unsigned fp4_code(float y) {
    const float a = fabsf(y);
    const unsigned c = (unsigned)(a > 0.25f) + (unsigned)(a > 0.75f) + (unsigned)(a > 1.25f) + (unsigned)(a > 1.75f) + (unsigned)(a > 2.5f) + (unsigned)(a > 3.5f) + (unsigned)(a > 5.f);
    return c | ((__float_as_uint(y) >> 28) & 8u);
}
__device__ __forceinline__ void p8_cvt_experts(const Params& p) {
    const int lane = otid() & 63, gw = blockIdx.x * 8 + (otid() >> 6), nw = gridDim.x * 8;
    f32x4 v[4], vn[4];
    {   const int which = gw >> 14, e = gw & 16383; const float* src = p.in[which ? 32 : 31] + (size_t)e * 1024 + lane * 16;
#pragma unroll
        for (int i = 0; i < 4; ++i) vn[i] = *(const f32x4*)(src + 4 * i); }
#pragma unroll 1
    for (int row = gw; row < 2 * 16384; row += nw) {
        const int which = row >> 14, e = row & 16383;
#pragma unroll
        for (int i = 0; i < 4; ++i) v[i] = vn[i];
        {   const int rn = (row + nw < 2 * 16384) ? row + nw : row; const int wn = rn >> 14, en = rn & 16383;
            const float* src = p.in[wn ? 32 : 31] + (size_t)en * 1024 + lane * 16;
#pragma unroll
            for (int i = 0; i < 4; ++i) vn[i] = *(const f32x4*)(src + 4 * i); }
        float am = 0.f;
#pragma unroll
        for (int i = 0; i < 4; ++i) am = fmaxf(am, fmaxf(fmaxf(fabsf(v[i][0]), fabsf(v[i][1])), fmaxf(fabsf(v[i][2]), fabsf(v[i][3]))));
#pragma unroll
        for (int o = 32; o; o >>= 1) am = fmaxf(am, __shfl_xor(am, o));
        am = fmaxf(am, 1e-30f);
        const float q = 6.f / am;
        u32x2 w = {0u, 0u};
#pragma unroll
        for (int i = 0; i < 4; ++i) {
            const unsigned nb = fp4_code(v[i][0] * q) | (fp4_code(v[i][1] * q) << 4) | (fp4_code(v[i][2] * q) << 8) | (fp4_code(v[i][3] * q) << 12);
            if (i < 2) w.x |= nb << (16 * i); else w.y |= nb << (16 * (i - 2));
        }
        *(u32x2*)(p.ws + (which ? OFF_E8U : OFF_E8D) + (size_t)e * 512 + lane * 8) = w;
        if (lane == 0) ((float*)(p.ws + OFF_ESC))[row] = am * (1.f / 6.f);
    }
}
__device__ __forceinline__ void p9_query(const Params& p, PG8_LAS unsigned char* ldsl) {
    pg8::StaticOrder S; S.init(T_TOK, 2048, gridDim.x, blockIdx.x);
    const pg8::Gemm g{(const bf16_t*)(p.ws + OFF_H), (const bf16_t*)(p.ws + OFF_WQRY), T_TOK, 2048, 1024};
    const pg8::EpiStoreBf16 E{(bf16_t*)((unsigned char*)p.out + DO_Q2), 2048};
    pg8::gemm_phase(ldsl, g, S, E);
}
__device__ constexpr int CAND_A[50] = {0,0,0,0,0,0,0,0,0,0,0,0,0,0,0,0, 1,1,1,1,1,1,1,1, 2,2,2,2,2, 3,3,3,3, 4,4,4, 5,5, 6,6, 7,7, 8, 9, 10, 11, 12, 13, 14, 15};
__device__ constexpr int CAND_B[50] = {0,1,2,3,4,5,6,7,8,9,10,11,12,13,14,15, 0,1,2,3,4,5,6,7, 0,1,2,3,4, 0,1,2,3, 0,1,2, 0,1, 0,1, 0,1, 0, 0, 0, 0, 0, 0, 0, 0};
__device__ __forceinline__ float knock(float v, float m, float neg) { float o; asm volatile("v_cmp_eq_f32 vcc, %1, %2\n\tv_cndmask_b32 %0, %1, %3, vcc" : "=v"(o) : "v"(v), "v"(m), "v"(neg) : "vcc"); return o; }
__device__ __forceinline__ void knock_sel(float& v, int& e, float m, float neg, int ce) { asm volatile("v_cmp_eq_f32 vcc, %0, %2\n\tv_cndmask_b32 %0, %0, %3, vcc\n\tv_cndmask_b32 %1, %1, %4, vcc" : "+v"(v), "+v"(e) : "v"(m), "v"(neg), "v"(ce) : "vcc"); }
__device__ __forceinline__ void ce_desc(float& a, float& b) { const float mx = __builtin_fmaxf(a, b), mn = __builtin_fminf(a, b); a = mx; b = mn; }
template <int OFF> __device__ __forceinline__ void sort16_desc(float (&v)[64]) {
#pragma unroll
    for (int k = 2; k <= 16; k <<= 1)
#pragma unroll
        for (int j = k >> 1; j > 0; j >>= 1)
#pragma unroll
            for (int i = 0; i < 16; ++i) { const int l = i ^ j; if (l > i) { if ((i & k) == 0) ce_desc(v[OFF + i], v[OFF + l]); else ce_desc(v[OFF + l], v[OFF + i]); } }
}
template <int A, int B> __device__ __forceinline__ void merge16_desc(float (&v)[64]) {
#pragma unroll
    for (int i = 0; i < 16; ++i) v[A + i] = __builtin_fmaxf(v[A + i], v[B + 15 - i]);
#pragma unroll
    for (int j = 8; j > 0; j >>= 1)
#pragma unroll
        for (int i = 0; i < 16; ++i) { const int l = i ^ j; if (l > i) ce_desc(v[A + i], v[A + l]); }
}
__device__ __forceinline__ void top16_of_64(float (&v)[64]) {
    sort16_desc<0>(v); sort16_desc<16>(v); sort16_desc<32>(v); sort16_desc<48>(v);
    merge16_desc<0, 16>(v); merge16_desc<32, 48>(v); merge16_desc<0, 32>(v);
}
template <int J>
__device__ __forceinline__ void p10_half(const Params& p, int t, int head, int r32, int hi, int lane, float* wl, const unsigned char* ksh, const bf16x8 (&bqv)[8]) {
    const unsigned char* krow = ksh + J * 34816 + r32 * 272 + hi * 16;
    f32x16 acc[4];
#pragma unroll
    for (int f = 0; f < 4; ++f)
#pragma unroll
        for (int r = 0; r < 16; ++r) acc[f][r] = 0.f;
#pragma unroll
    for (int s = 0; s < 8; ++s) {
        const bf16x8 bq = bqv[s];
#pragma unroll
        for (int f = 0; f < 4; ++f) { const bf16x8 ak = *(const bf16x8*)(krow + f * 32 * 272 + s * 32); acc[f] = MFMA32(ak, bq, acc[f]); }
    }
    float v[64];
#pragma unroll
    for (int f = 0; f < 4; ++f)
#pragma unroll
        for (int r = 0; r < 16; ++r) v[f * 16 + r] = __uint_as_float((__float_as_uint(acc[f][r]) & ~0x7Fu) | (unsigned)(f * 32 + (r & 3) + 8 * (r >> 2) + 4 * hi));
    top16_of_64(v);
#pragma unroll
    for (int i = 0; i < 16; ++i) v[16 + i] = __shfl_xor(v[i], 32);
    merge16_desc<0, 16>(v);
    float* res = wl + J * 1024;
#pragma unroll
    for (int i = 0; i < 16; ++i) res[i * 64 + lane] = v[i];
}
__device__ __forceinline__ void p10_task(const Params& p, int task, int lane, float* wl, const unsigned char* ksh) {
    const int head = task & 7, tile = task >> 3, r32 = lane & 31, hi = lane >> 5, t = tile * 32 + r32;
    const float NEG = -3.0e38f;
    bf16x8 bq0[8], bq1[8];
    {   const bf16_t* qrow = (const bf16_t*)((const unsigned char*)p.out + DO_Q2) + (size_t)t * 2048 + head * 256 + hi * 8;
#pragma unroll
        for (int s = 0; s < 8; ++s) { bq0[s] = *(const bf16x8*)(qrow + s * 16); bq1[s] = *(const bf16x8*)(qrow + 128 + s * 16); } }
    p10_half<0>(p, t, head, r32, hi, lane, wl, ksh, bq0);
    p10_half<1>(p, t, head, r32, hi, lane, wl, ksh, bq1);
    __builtin_amdgcn_wave_barrier(); asm volatile("s_waitcnt lgkmcnt(0)" ::: "memory");
    float tv0[16], tv1[16];
#pragma unroll
    for (int it = 0; it < 16; ++it) { tv0[it] = __uint_as_float(__float_as_uint(wl[it * 64 + lane]) & ~0x7Fu); tv1[it] = __uint_as_float(__float_as_uint(wl[1024 + it * 64 + lane]) & ~0x7Fu); }
    float cs[64];
#pragma unroll
    for (int c = 0; c < 64; ++c) cs[c] = c < 50 ? __uint_as_float((__float_as_uint(tv0[CAND_A[c < 50 ? c : 0]] + tv1[CAND_B[c < 50 ? c : 0]]) & ~0xFFu) | (unsigned)(CAND_A[c < 50 ? c : 0] * 16 + CAND_B[c < 50 ? c : 0])) : NEG;
    top16_of_64(cs);
    float gv[16]; int ge[16];
#pragma unroll
    for (int it = 0; it < 16; ++it) {
        const unsigned w = __float_as_uint(cs[it]); const int a = (w >> 4) & 15, b = w & 15;
        gv[it] = __uint_as_float(w & ~0xFFu);
        ge[it] = (int)(__float_as_uint(wl[a * 64 + lane]) & 0x7Fu) * 128 + (int)(__float_as_uint(wl[1024 + b * 64 + lane]) & 0x7Fu);
    }
    float sum = 0.f; const float gmax = gv[0];
#pragma unroll
    for (int it = 0; it < 16; ++it) { gv[it] = __expf(gv[it] - gmax); sum += gv[it]; }
    const float inv = 1.f / sum;
    if (hi == 0) {
        int* io = (int*)(p.ws + OFF_IDX) + (size_t)t * 128 + head * 16; float* go = (float*)(p.ws + OFF_GATES) + (size_t)t * 128 + head * 16;
#pragma unroll
        for (int q = 0; q < 4; ++q) {
            *(int4*)(io + 4 * q) = make_int4(ge[4 * q], ge[4 * q + 1], ge[4 * q + 2], ge[4 * q + 3]);
            *(f32x4*)(go + 4 * q) = (f32x4){gv[4 * q] * inv, gv[4 * q + 1] * inv, gv[4 * q + 2] * inv, gv[4 * q + 3] * inv};
        }
    }
    __builtin_amdgcn_wave_barrier(); asm volatile("s_waitcnt lgkmcnt(0)" ::: "memory");
}
__device__ __forceinline__ void p10_route(const Params& p, unsigned char* lds) {
    const int lane = otid() & 63, wid = otid() >> 6, gw = blockIdx.x * 8 + wid, nw = gridDim.x * 8;
    float* wl = (float*)lds + wid * 2048;
    unsigned char* ksh = lds + 65536;
    __syncthreads();
    for (int c = otid(); c < 2 * 128 * 16; c += NTHREADS) { const int tb = c >> 11, row = (c >> 4) & 127, ch = c & 15;
        *(u32x4*)(ksh + tb * 34816 + row * 272 + ch * 16) = *(const u32x4*)((const bf16_t*)(p.ws + (tb ? OFF_SK2 : OFF_SK1)) + row * 128 + ch * 8); }
    __syncthreads();
    for (int task = gw; task < 512 * 8; task += nw) p10_task(p, task, lane, wl, ksh);
}
__device__ __forceinline__ void p9_query_route(const Params& p, unsigned char* lds, PG8_LAS unsigned char* ldsl) {
    p9_query(p, ldsl);
    asm volatile("s_waitcnt vmcnt(0)" ::: "memory");
    const int lane = otid() & 63, wid = otid() >> 6;
    float* wl = (float*)lds + wid * 2048;
    unsigned char* ksh = lds + 65536;
    __syncthreads();
    for (int c = otid(); c < 2 * 128 * 16; c += NTHREADS) { const int tb = c >> 11, row = (c >> 4) & 127, ch = c & 15;
        *(u32x4*)(ksh + tb * 34816 + row * 272 + ch * 16) = *(const u32x4*)((const bf16_t*)(p.ws + (tb ? OFF_SK2 : OFF_SK1)) + row * 128 + ch * 8); }
    __syncthreads();
    pg8::StaticOrder S; S.init(T_TOK, 2048, gridDim.x, blockIdx.x);
#pragma unroll 1
    for (int r = 0; r < 2; ++r) {
        pg8::Unit u;
        if (!S.next(r, u)) break;
        int pm = u.pm, pn = u.pn; asm volatile("" : "+s"(pm), "+s"(pn));
        p10_task(p, (pm * 8 + wid) * 8 + pn, lane, wl, ksh);
    }
}
__device__ __forceinline__ float gelu_tanh(float x) { const float u = 0.7978845608028654f * (x + 0.044715f * x * x * x); return 0.5f * x * (1.f + tanhf_(u)); }
__device__ __forceinline__ float dot16_fp8(const f32x2 (&hv)[8], u32x4 d) {
    f32x2 s = {0.f, 0.f};
#pragma unroll
    for (int i = 0; i < 4; ++i) {
        const f32x2 a = __builtin_amdgcn_cvt_pk_f32_fp8((int)d[i], false), b = __builtin_amdgcn_cvt_pk_f32_fp8((int)d[i], true);
        s += hv[2 * i] * a; s += hv[2 * i + 1] * b;
    }
    return s.x + s.y;
}
__device__ __forceinline__ void axpy16_fp8(f32x2 (&acc)[8], float a, u32x4 u) {
    const f32x2 a2 = {a, a};
#pragma unroll
    for (int i = 0; i < 4; ++i) {
        const f32x2 x = __builtin_amdgcn_cvt_pk_f32_fp8((int)u[i], false), y = __builtin_amdgcn_cvt_pk_f32_fp8((int)u[i], true);
        acc[2 * i] += a2 * x; acc[2 * i + 1] += a2 * y;
    }
}
__device__ __forceinline__ float gelu_fast(float x) {
    const float u2 = 1.5957691216057308f * (x + 0.044715f * x * x * x);
    return x * __builtin_amdgcn_rcpf(1.f + __expf(-u2));
}
typedef long i64_t;
typedef short s16x4_t __attribute__((ext_vector_type(4)));
typedef int i32x8_t __attribute__((ext_vector_type(8)));
#define MFMA128_F8F4(a, b, c) __builtin_amdgcn_mfma_scale_f32_16x16x128_f8f6f4((a), (b), (c), 0, 4, 0, 0, 0, 0)
constexpr int P11_TPW = 4;
#ifndef P11_NB1
#define P11_NB1 32
#define P11_NB2 16
#endif
#ifndef P11_EMASK
#define P11_EMASK 0x3FFFu
#endif
constexpr int P11_RING = 0, P11_H8 = 0, P11_H8P = 1040, P11_REC = 16384, P11_DOT = 18432, P11_WAVE = 19456;
static_assert(P11_WAVE * 8 <= LDS_MAIN, "P11 LDS");
__device__ __forceinline__ float clamp440(float x) { return fminf(fmaxf(x, -440.f), 440.f); }
__device__ __forceinline__ void p11_gather(const Params& p, unsigned char* lds, PG8_LAS unsigned char* ldsl) {
    const int lane = otid() & 63, wid = otid() >> 6, gw = blockIdx.x * 8 + wid, nw = gridDim.x * 8;
    const int n16 = lane & 15, g4 = lane >> 4;
    const unsigned char* ED = p.ws + OFF_E8D; const unsigned char* EUb = p.ws + OFF_E8U; const float* ESC = (const float*)(p.ws + OFF_ESC);
    unsigned char* wb = lds + wid * P11_WAVE;
    unsigned* recs = (unsigned*)(wb + P11_REC); bf16_t* dots = (bf16_t*)(wb + P11_DOT);
    PG8_LAS unsigned char* ringl = ldsl + __builtin_amdgcn_readfirstlane(wid * P11_WAVE + P11_RING);
    const unsigned char* ringg = wb + P11_RING;
    const unsigned long long lt = (1ull << lane) - 1ull;
#define P11_ISSUE(TAB, ea, OFFB, bufo) { _Pragma("unroll") for (int i_ = 0; i_ < 4; ++i_) \
        __builtin_amdgcn_global_load_lds((const unsigned*)((TAB) + (size_t)ea[i_] + (OFFB)), (PG8_LAS unsigned*)(ringl + (bufo) + i_ * 1024), 16, 0, 0); }
#define P11_NEXTBUF(bufo) { bufo = (bufo + 4096) & 16383; }
    __syncthreads();
    for (int t0 = gw * P11_TPW; t0 < T_TOK; t0 += nw * P11_TPW) {
        {
            unsigned ev[8], rk[8];
#pragma unroll
            for (int k = 0; k < 4; ++k) { const int* ip = (const int*)(p.ws + OFF_IDX) + (size_t)(t0 + k) * 128; ev[2 * k] = (unsigned)ip[lane]; ev[2 * k + 1] = (unsigned)ip[64 + lane]; }
#pragma unroll
            for (int j = 0; j < 8; ++j) rk[j] = 0;
            unsigned base = 0;
#pragma unroll 1
            for (unsigned bk = 0; bk < 16; ++bk) {
#pragma unroll
                for (int j = 0; j < 8; ++j) {
                    const bool hit = (ev[j] >> 10) == bk;
                    const unsigned long long m = __ballot(hit);
                    if (hit) rk[j] = base + __builtin_popcountll(m & lt);
                    base += __builtin_popcountll(m);
                }
            }
#pragma unroll
            for (int j = 0; j < 8; ++j) recs[rk[j]] = ev[j] | ((unsigned)(j >> 1) << 14) | ((unsigned)((j & 1) * 64 + lane) << 16);
        }
#pragma unroll
        for (int k = 0; k < 4; ++k) {
            const bf16_t* hrow = (const bf16_t*)(p.ws + OFF_H) + (size_t)(t0 + k) * 1024 + lane * 16;
            const u32x4 h0 = *(const u32x4*)(hrow), h1 = *(const u32x4*)(hrow + 8);
            u32x4 whi, wlo;
#pragma unroll
            for (int i = 0; i < 4; ++i) {
                const unsigned wa = i < 2 ? h0[2 * i] : h1[2 * i - 4], wb2 = i < 2 ? h0[2 * i + 1] : h1[2 * i - 3];
                const float x0 = clamp440(lo_f(wa) * 8.f), x1 = clamp440(hi_f(wa) * 8.f), x2 = clamp440(lo_f(wb2) * 8.f), x3 = clamp440(hi_f(wb2) * 8.f);
                int t = 0; t = __builtin_amdgcn_cvt_pk_fp8_f32(x0, x1, t, false); t = __builtin_amdgcn_cvt_pk_fp8_f32(x2, x3, t, true);
                const f32x2 d01 = __builtin_amdgcn_cvt_pk_f32_fp8(t, false), d23 = __builtin_amdgcn_cvt_pk_f32_fp8(t, true);
                int u = 0; u = __builtin_amdgcn_cvt_pk_fp8_f32((x0 - d01.x) * 16.f, (x1 - d01.y) * 16.f, u, false); u = __builtin_amdgcn_cvt_pk_fp8_f32((x2 - d23.x) * 16.f, (x3 - d23.y) * 16.f, u, true);
                whi[i] = (unsigned)t; wlo[i] = (unsigned)u;
            }
            *(u32x4*)(wb + P11_H8 + (2 * k) * P11_H8P + lane * 16) = whi; *(u32x4*)(wb + P11_H8 + (2 * k + 1) * P11_H8P + lane * 16) = wlo;
        }
        __builtin_amdgcn_wave_barrier(); asm volatile("s_waitcnt lgkmcnt(0)" ::: "memory");
        u32x4 hf[16];
#pragma unroll
        for (int c = 0; c < 16; ++c) hf[c] = *(const u32x4*)(wb + P11_H8 + (lane & 7) * P11_H8P + c * 64 + g4 * 16);
        {
            const unsigned rotn = (((unsigned)n16 << 1) | ((unsigned)n16 >> 3)) & 15u;
            const unsigned rd0 = (unsigned)n16 * 256u + ((((unsigned)g4) ^ rotn) << 4);
            const unsigned xg = ((unsigned)lane & 15u) ^ (2u * (unsigned)g4);
            const unsigned goff0 = (xg ^ 0u) << 4, goff1 = (xg ^ 8u) << 4, goff2 = (xg ^ 1u) << 4, goff3 = (xg ^ 9u) << 4;
#define P11_EA1(dst, bb) { dst[0] = ((recs[(bb) * 16 + 0 + g4] & P11_EMASK) << 9) + goff0; dst[1] = ((recs[(bb) * 16 + 4 + g4] & P11_EMASK) << 9) + goff1; \
                           dst[2] = ((recs[(bb) * 16 + 8 + g4] & P11_EMASK) << 9) + goff2; dst[3] = ((recs[(bb) * 16 + 12 + g4] & P11_EMASK) << 9) + goff3; }
#define P11_RD1(F) { _Pragma("unroll") for (int c4 = 0; c4 < 4; ++c4) F[c4] = *(const u32x4*)(ringg + bufo + (rd0 ^ (unsigned)(c4 << 6))); }
#define P11_T1(Q, eaI, QI, FC, FN) { asm volatile("s_waitcnt lgkmcnt(0)" : "+v"(FC[0]), "+v"(FC[1]), "+v"(FC[2]), "+v"(FC[3]) :: "memory"); \
                P11_ISSUE(ED, eaI, 256 * (QI), bufo); P11_NEXTBUF(bufo); \
                asm volatile("s_waitcnt vmcnt(12)" ::: "memory"); P11_RD1(FN); \
                _Pragma("unroll") for (int c4 = 0; c4 < 4; ++c4) { const int S_ = 4 * (Q) + c4; \
                    const i32x8_t A_ = {(int)hf[2 * S_][0], (int)hf[2 * S_][1], (int)hf[2 * S_][2], (int)hf[2 * S_][3], (int)hf[2 * S_ + 1][0], (int)hf[2 * S_ + 1][1], (int)hf[2 * S_ + 1][2], (int)hf[2 * S_ + 1][3]}; \
                    const i32x8_t B_ = {(int)FC[c4][0], (int)FC[c4][1], (int)FC[c4][2], (int)FC[c4][3], 0, 0, 0, 0}; \
                    if (c4 & 1) a1 = MFMA128_F8F4(A_, B_, a1); else a0 = MFMA128_F8F4(A_, B_, a0); } \
                asm volatile("s_nop 7" : "+v"(a0), "+v"(a1) : "v"(FC[0]), "v"(FC[1]), "v"(FC[2]), "v"(FC[3])); }
            unsigned ea0[4], ea1[4], ea2[4];
            P11_EA1(ea0, 0); P11_EA1(ea1, 1);
            int bufo = 0;
            asm volatile("s_waitcnt lgkmcnt(0)" ::: "memory");
            P11_ISSUE(ED, ea0, 0, 0); P11_ISSUE(ED, ea0, 256, 4096); P11_ISSUE(ED, ea1, 0, 8192); P11_ISSUE(ED, ea1, 256, 12288);
            u32x4 fA[4], fB[4];
            asm volatile("s_waitcnt vmcnt(12)" ::: "memory"); P11_RD1(fA);
#pragma unroll 1
            for (int b = 0; b < P11_NB1; ++b) {
                const unsigned rec = recs[b * 16 + n16];
                const int b2 = b < 30 ? b + 2 : 31;
                P11_EA1(ea2, b2);
                f32x4 a0 = {0.f, 0.f, 0.f, 0.f}, a1 = {0.f, 0.f, 0.f, 0.f};
                asm volatile("" : "+v"(a0), "+v"(a1));
                P11_T1(0, ea2, 0, fA, fB) P11_T1(1, ea2, 1, fB, fA)
                const f32x4 cs = a0 + a1;
                const unsigned tl = (rec >> 14) & 3u;
                const float val = (tl & 1u) ? (cs[2] + cs[3] * 0.0625f) : (cs[0] + cs[1] * 0.0625f);
                if ((unsigned)g4 == (tl >> 1)) dots[b * 16 + n16] = f2bf(val * 0.125f);
            }
            asm volatile("s_waitcnt vmcnt(0)" ::: "memory");
        }
        __builtin_amdgcn_wave_barrier(); asm volatile("s_waitcnt lgkmcnt(0)" ::: "memory");
        float inv_s;
        {
            float av[8]; unsigned rc[8]; float am = 0.f;
#pragma unroll
            for (int i = 0; i < 8; ++i) {
                const unsigned rec = recs[i * 64 + lane]; const float d = bf2f(dots[i * 64 + lane]);
                const unsigned e = rec & 0x3FFFu, tl = (rec >> 14) & 3u, slot = (rec >> 16) & 127u;
                const float gt = ((const float*)(p.ws + OFF_GATES))[(size_t)(t0 + tl) * 128 + slot];
                av[i] = gelu_fast(d * ESC[e]) * gt * ESC[16384 + e]; rc[i] = rec & 0xFFFFu; am = fmaxf(am, fabsf(av[i]));
            }
#pragma unroll
            for (int o = 32; o; o >>= 1) am = fmaxf(am, __shfl_xor(am, o));
            const float sc = __uint_as_float(__float_as_uint(240.f / fmaxf(am, 1e-30f)) & 0x7f800000u);
            inv_s = 1.f / sc;
#pragma unroll
            for (int i = 0; i < 8; ++i) {
                const int th = __builtin_amdgcn_cvt_pk_fp8_f32(av[i] * sc, 0.f, 0, false);
                recs[i * 64 + lane] = rc[i] | (((unsigned)th & 0xFFu) << 16);
            }
        }
        __builtin_amdgcn_wave_barrier(); asm volatile("s_waitcnt lgkmcnt(0)" ::: "memory");
        {
            const unsigned pc = (unsigned)lane & 7u, q8 = (unsigned)lane >> 3;
            const unsigned goff0 = (pc ^ (q8 & 2u)) << 4, goff1 = (pc ^ (q8 & 2u) ^ 4u) << 4;
            const unsigned r4 = (unsigned)n16 >> 2, c4l = (unsigned)n16 & 3u;
            const unsigned fsw = (r4 & 2u) | (((unsigned)g4 & 1u) << 2);
            const unsigned tr0 = (8u * (unsigned)g4 + r4) * 128u + 8u * (c4l & 1u) + (((c4l >> 1) ^ fsw) << 4);
            const unsigned tlm = (unsigned)n16 >> 2, dsm = (unsigned)n16 & 3u;
            const unsigned trb = (unsigned)(size_t)ringl;
            const unsigned selA = 0x0c0c0c0cu ^ (0x0eu << (8u * dsm));
            f32x4 acc[16];
#pragma unroll
            for (int i = 0; i < 16; ++i) acc[i] = (f32x4){0.f, 0.f, 0.f, 0.f};
#define P11_EA2(dst, bb) { dst[0] = ((recs[(bb) * 32 + 0 + q8] & P11_EMASK) << 9) + goff0; dst[1] = ((recs[(bb) * 32 + 8 + q8] & P11_EMASK) << 9) + goff1; \
                           dst[2] = ((recs[(bb) * 32 + 16 + q8] & P11_EMASK) << 9) + goff0; dst[3] = ((recs[(bb) * 32 + 24 + q8] & P11_EMASK) << 9) + goff1; }
#define P11_RD2(F) { _Pragma("unroll") for (int nt = 0; nt < 4; ++nt) { const unsigned ta_ = trb + (unsigned)bufo + (tr0 ^ (unsigned)(nt << 5)); \
                    asm volatile("ds_read_b64_tr_b16 %0, %1" : "=v"(F[nt][0]) : "v"(ta_) : "memory"); \
                    asm volatile("ds_read_b64_tr_b16 %0, %1 offset:512" : "=v"(F[nt][1]) : "v"(ta_) : "memory"); } }
#define P11_T2(Q, eaI, QI, FC, FN) { \
                asm volatile("s_waitcnt lgkmcnt(0)" : "+v"(FC[0][0]), "+v"(FC[0][1]), "+v"(FC[1][0]), "+v"(FC[1][1]), "+v"(FC[2][0]), "+v"(FC[2][1]), "+v"(FC[3][0]), "+v"(FC[3][1]) :: "memory"); \
                P11_ISSUE(EUb, eaI, 128 * (QI), bufo); P11_NEXTBUF(bufo); \
                asm volatile("s_waitcnt vmcnt(12)" ::: "memory"); P11_RD2(FN); \
                _Pragma("unroll") for (int nt = 0; nt < 4; ++nt) { \
                    const i32x8_t B_ = {(int)(unsigned)FC[nt][0], (int)(unsigned)((unsigned long long)FC[nt][0] >> 32), (int)(unsigned)FC[nt][1], (int)(unsigned)((unsigned long long)FC[nt][1] >> 32), 0, 0, 0, 0}; \
                    acc[4 * (Q) + nt] = MFMA128_F8F4(Aop, B_, acc[4 * (Q) + nt]); } \
                asm volatile("s_nop 7" : "+v"(acc[4 * (Q)]), "+v"(acc[4 * (Q) + 1]), "+v"(acc[4 * (Q) + 2]), "+v"(acc[4 * (Q) + 3]) \
                             : "v"(FC[0][0]), "v"(FC[0][1]), "v"(FC[1][0]), "v"(FC[1][1]), "v"(FC[2][0]), "v"(FC[2][1]), "v"(FC[3][0]), "v"(FC[3][1]), "v"(Aop)); }
            unsigned eaC[4], eaN[4];
            P11_EA2(eaC, 0);
            int bufo = 0;
            asm volatile("s_waitcnt lgkmcnt(0)" ::: "memory");
            P11_ISSUE(EUb, eaC, 0, 0); P11_ISSUE(EUb, eaC, 128, 4096); P11_ISSUE(EUb, eaC, 256, 8192); P11_ISSUE(EUb, eaC, 384, 12288);
            i64_t gA[4][2], gB[4][2];
            asm volatile("s_waitcnt vmcnt(12)" ::: "memory"); P11_RD2(gA);
#pragma unroll 1
            for (int b = 0; b < P11_NB2; ++b) {
                const u32x4 Ra = *(const u32x4*)(recs + b * 32 + 4 * g4), Rb = *(const u32x4*)(recs + b * 32 + 16 + 4 * g4);
                const int bn = b < 15 ? b + 1 : 15;
                P11_EA2(eaN, bn);
                i32x8_t Aop;
#pragma unroll
                for (int w = 0; w < 8; ++w) { const unsigned R = w < 4 ? Ra[w] : Rb[w - 4]; Aop[w] = (((R >> 14) & 3u) == tlm) ? (int)__builtin_amdgcn_perm(0u, R, selA) : 0; }
                P11_T2(0, eaN, 0, gA, gB) P11_T2(1, eaN, 1, gB, gA) P11_T2(2, eaN, 2, gA, gB) P11_T2(3, eaN, 3, gB, gA)
            }
            asm volatile("s_waitcnt vmcnt(0) lgkmcnt(0)" : "+v"(gA[0][0]), "+v"(gA[0][1]), "+v"(gA[1][0]), "+v"(gA[1][1]), "+v"(gA[2][0]), "+v"(gA[2][1]), "+v"(gA[3][0]), "+v"(gA[3][1]) :: "memory");
            const int t = t0 + g4, bb = t >> 12;
            const float* gt2 = (const float*)(p.ws + OFF_MOD) + bb * 6144 + 5120 + 4 * n16;
            const bf16_t* x1 = (const bf16_t*)(p.ws + OFF_X1) + (size_t)t * 1024 + 4 * n16; float* o = p.out + (size_t)t * 1024 + 4 * n16;
            const float k0 = inv_s * DBG_FFN;
#pragma unroll
            for (int h = 0; h < 2; ++h) {
                u32x2 xr[8]; f32x4 gv[8];
#pragma unroll
                for (int i = 0; i < 8; ++i) { xr[i] = *(const u32x2*)(x1 + 64 * (8 * h + i)); gv[i] = *(const f32x4*)(gt2 + 64 * (8 * h + i)); }
#pragma unroll
                for (int i = 0; i < 8; ++i) *(f32x4*)(o + 64 * (8 * h + i)) = bf4(xr[i]) + gv[i] * (acc[8 * h + i] * k0);
            }
        }
    }
}

__global__ void __launch_bounds__(NTHREADS) mega(Params p) {
    __shared__ __attribute__((aligned(16))) unsigned char lds[LDS_MAIN + 16];
    PG8_LAS unsigned char* ldsl = (PG8_LAS unsigned char*)&lds[0];
    cg::grid_group grid = cg::this_grid();
    if (threadIdx.x == 0) *(uint4*)(&lds[LDS_MAIN]) = make_uint4(0u, 0u, 0u, 0u);
    __syncthreads();
    const XcdBarrier xb = xcd_barrier_post((unsigned*)(p.ws + OFF_BAR), (volatile LAS unsigned*)(&lds[LDS_MAIN]));
#ifdef PROBE
    int phase_no_ = 0;
#define TSTAMP() { if (blockIdx.x == 0 && threadIdx.x == 0) ((unsigned long long*)(p.ws + OFF_CTR + 2048))[phase_no_] = __builtin_amdgcn_s_memrealtime(); ++phase_no_; }
    TSTAMP()
#define PHASE(BODY) { BODY; xcd_barrier(xb); TSTAMP() }
#else
#define PHASE(BODY) { BODY; xcd_barrier(xb); }
#endif
    p0_prep(p, lds); xcd_barrier(xb);
    if (p.pad0 != 0) grid.sync();
#ifdef PROBE
    TSTAMP()
#endif
    PHASE((modnorm_phase<true>(p, p.in[0], p.in[5], 0, (bf16_t*)((unsigned char*)p.out + DO_H), lds), p1_finalize_mod(p)))
    PHASE(p2_proj(p, ldsl, lds))
#if defined(CHUNKED) && !defined(SCAN_VERIFY)
    PHASE((p3_small(p, lds), p5_stageA_local(p, lds, xb)))
#else
    PHASE(p3_small(p, lds))
#endif
#if defined(SCAN_VERIFY)
    PHASE(p4_rwkv_prep(p))
    PHASE(if (blockIdx.x < 128) scan_task(p, blockIdx.x, lds))
    PHASE(p3_small(p, lds, true))
    PHASE(p4_rwkv_prep_chunked(p))
    PHASE(p5_stageA(p, lds))
    PHASE(p5_stageB(p))
    PHASE(p5_stageC(p, lds))
#ifdef VTEST_NAIVE
    PHASE({ const int gw_ = blockIdx.x * 8 + (otid() >> 6); if (gw_ < 32) scan_naive0(p, gw_, otid() & 63); })
#endif
    PHASE(scan_compare(p))
    { const float* cc = (const float*)(p.ws + OFF_CTR); const float rel = sqrtf(cc[8] / fmaxf(cc[9], 1e-30f));
      for (int i = blockIdx.x * NTHREADS + threadIdx.x; i < T_TOK * DM; i += gridDim.x * NTHREADS) p.out[i] = p.in[0][i] + (i == 0 ? ((rel == rel) ? 100.f * (log10f(fminf(fmaxf(rel, 1e-6f), 1e12f)) + 6.f) : 5000.f + 100.f * (float)(((const unsigned*)cc)[10] & 31u)) : 0.f); }
    return;
#elif defined(CHUNKED)
    PHASE(p5_attn_scan(p, lds))
    PHASE(p5_stageC(p, lds))
#else
    PHASE(p4_rwkv_prep(p))
    PHASE(p5_attn_scan(p, lds))
    PHASE(p5b_scan_epilogue(p))
#endif
    PHASE(p6_merge(p, ldsl))
    PHASE(p7_mix(p, ldsl))
    PHASE((modnorm_phase<false>(p, (const float*)(p.ws + OFF_X1), p.in[27], 3072, (bf16_t*)(p.ws + OFF_H), lds), p8_cvt_experts(p)))
#ifdef EMPTY_PHASES
    PHASE({}) PHASE({}) PHASE({}) PHASE({}) PHASE({}) PHASE({}) PHASE({}) PHASE({}) PHASE({}) PHASE({})
#endif
    PHASE(p9_query_route(p, lds, ldsl))
    p11_gather(p, lds, ldsl);
#ifdef PROBE
    grid.sync(); TSTAMP()
    if (blockIdx.x == 0 && threadIdx.x == 0) { const unsigned long long* tsp = (const unsigned long long*)(p.ws + OFF_CTR + 2048); p.out[0] += (float)(tsp[PROBE + 1] - tsp[PROBE]) * 0.0001f; }
#endif
}

extern "C" void kernel_launch(void* const* d_in, const int* in_sizes, int n_in,
                              void* d_out, int out_size, void* d_ws, size_t ws_size,
                              hipStream_t stream) {
    static int grid_blocks = 0;
    if (!grid_blocks) {
        int dev = 0, cus = 0, per_cu = 0;
        (void)hipGetDevice(&dev);
        (void)hipDeviceGetAttribute(&cus, hipDeviceAttributeMultiprocessorCount, dev);
        (void)hipOccupancyMaxActiveBlocksPerMultiprocessor(&per_cu, mega, NTHREADS, 0);
        if (per_cu > 1) per_cu = 1;
        grid_blocks = cus * per_cu;
    }
    Params p{};
    for (int i = 0; i < 33; ++i) p.in[i] = (const float*)d_in[i];
    p.out = (float*)d_out; p.ws = (unsigned char*)d_ws; p.pad0 = 0; p.pad1 = 0;
    (void)hipMemsetAsync((unsigned char*)d_ws + OFF_BAR, 0, 16384, stream);
    void* args[] = {&p};
    hipError_t e = hipLaunchCooperativeKernel((void*)mega, dim3(grid_blocks), dim3(NTHREADS), args, 0, stream);
    if (e != hipSuccess) fprintf(stderr, "cooperative launch failed: %s (grid %d)\n", hipGetErrorString(e), grid_blocks);
}
```

```cpp
#include <hip/hip_runtime.h>
#include <hip/hip_cooperative_groups.h>
#include <cstdio>
#include <cstdint>
namespace cg = cooperative_groups;

typedef unsigned short bf16_t;
typedef short bf16x8 __attribute__((ext_vector_type(8)));
typedef float f32x16 __attribute__((ext_vector_type(16)));
typedef float f32x4 __attribute__((ext_vector_type(4)));
typedef unsigned u32x4 __attribute__((ext_vector_type(4)));
typedef unsigned u32x2 __attribute__((ext_vector_type(2)));
typedef float f32x2 __attribute__((ext_vector_type(2)));

#define NTHREADS 512
#ifndef SB_NOSTORE
#define SB_NOSTORE 0
#endif
#define CHUNKED 1
#ifndef DBG_FFN
#define DBG_FFN 1.f
#endif
#define MFMA32(a, b, c) __builtin_amdgcn_mfma_f32_32x32x16_bf16((a), (b), (c), 0, 0, 0)

constexpr int T_TOK = 16384, SEQ = 4096, NB = 4, DM = 1024;
constexpr int NPA = 2304;
constexpr int C_QA = 0, C_KVA = 256, C_KR = 384, C_RW = 416;
constexpr int C_R = C_RW, C_K = C_RW + 512, C_V = C_RW + 1024, C_WD = C_RW + 1536, C_AD = C_RW + 1600, C_GD = C_RW + 1664;
constexpr size_t MiB = 1u << 20;
constexpr size_t OFF_WINA = 0, OFF_WG = OFF_WINA + (size_t)NPA * 1024 * 2, OFF_WUQ = OFF_WG + 2048 * 1024 * 2, OFF_WUKV = OFF_WUQ + 768 * 256 * 2,
                 OFF_WDEC = OFF_WUKV + 1024 * 128 * 2, OFF_WAAA = OFF_WDEC + 512 * 64 * 2, OFF_WGATE = OFF_WAAA + 512 * 64 * 2,
                 OFF_WOMLA = OFF_WGATE + 512 * 128 * 2, OFF_WORWKV = OFF_WOMLA + 1024 * 512 * 2, OFF_WOUT = OFF_WORWKV + 1024 * 512 * 2,
                 OFF_WQRY = OFF_WOUT + 1024 * 1024 * 2, OFF_SK1 = OFF_WQRY + 2048 * 1024 * 2, OFF_SK2 = OFF_SK1 + 128 * 128 * 2,
                 OFF_MODP = OFF_SK2 + 128 * 128 * 2, OFF_MOD = OFF_MODP + 16 * 4 * 6144 * 4, OFF_ROPE = OFF_MOD + 4 * 6144 * 4,
                 OFF_CTR = OFF_ROPE + (size_t)T_TOK * 32 * 4, OFF_BAR = OFF_CTR + 4096, OFF_GC = OFF_BAR + 16384, OFF_BONUS = OFF_GC + (size_t)(T_TOK / 32) * 512 * 4, OFF_END_W = OFF_BONUS + (size_t)T_TOK * 8 * 4;
static_assert(OFF_END_W <= 24 * MiB, "weights region");
constexpr size_t OFF_H = 24 * MiB;
constexpr size_t OFF_G8 = OFF_H;
constexpr size_t OFF_P = 56 * MiB;
constexpr size_t OFF_OMLA = OFF_P, OFF_YG = OFF_P + 16 * MiB, OFF_X1 = OFF_P;
constexpr size_t OFF_S = 128 * MiB;
constexpr size_t OFF_SR = OFF_S, OFF_SE = OFF_S + 16 * MiB, OFF_SKH = OFF_S + 32 * MiB, OFF_SV = OFF_S + 48 * MiB, OFF_SKK = OFF_S + 64 * MiB,
                 OFF_SB = OFF_S + 80 * MiB, OFF_SG = OFF_S + 96 * MiB;
constexpr size_t OFF_MERGED = OFF_S, OFF_EDOWN = OFF_S + 32 * MiB, OFF_EUP = OFF_S + 64 * MiB;
constexpr size_t OFF_IDX = 240 * MiB, OFF_GATES = 248 * MiB;
constexpr size_t DO_Q = 0, DO_K = 24 * MiB, DO_VT = 48 * MiB, DO_Q2 = 0, DO_H = 0;

struct Params {
    const float* in[33];
    float* out;
    unsigned char* ws;
    int pad0, pad1;
};

__device__ __forceinline__ int otid() { int t = threadIdx.x; asm volatile("" : "+v"(t)); return t; }
__device__ __forceinline__ float bf2f(bf16_t h) { return __uint_as_float((unsigned)h << 16); }
typedef __bf16 bf16v2_t __attribute__((ext_vector_type(2)));
__device__ __forceinline__ unsigned pk2(float lo, float hi) { const f32x2 v = {lo, hi}; bf16v2_t r = __builtin_convertvector(v, bf16v2_t); return *reinterpret_cast<unsigned*>(&r); }
__device__ __forceinline__ bf16_t f2bf(float f) { return (bf16_t)(pk2(f, 0.f) & 0xffffu); }
__device__ __forceinline__ float lo_f(unsigned w) { return __uint_as_float(w << 16); }
__device__ __forceinline__ float hi_f(unsigned w) { return __uint_as_float(w & 0xffff0000u); }
__device__ __forceinline__ f32x4 bf4(u32x2 w) { return (f32x4){lo_f(w.x), hi_f(w.x), lo_f(w.y), hi_f(w.y)}; }
__device__ __forceinline__ u32x2 pk4(f32x4 v) { u32x2 w; w.x = pk2(v[0], v[1]); w.y = pk2(v[2], v[3]); return w; }
__device__ __forceinline__ float wave_sum(float v) { for (int o = 32; o; o >>= 1) v += __shfl_xor(v, o); return v; }
__device__ __forceinline__ float xhalf_sum(float v) { return v + __shfl_xor(v, 32); }
__device__ __forceinline__ float xhalf_max(float v) { return fmaxf(v, __shfl_xor(v, 32)); }
__device__ __forceinline__ float sigmoidf_(float x) { return __builtin_amdgcn_rcpf(1.f + __expf(-x)); }
__device__ __forceinline__ float tanhf_(float x) { float e = __expf(-2.f * fabsf(x)); float t = (1.f - e) * __builtin_amdgcn_rcpf(1.f + e); return x < 0.f ? -t : t; }
__device__ __forceinline__ int crow(int reg, int hi) { return (reg & 3) + 8 * (reg >> 2) + 4 * hi; }
__device__ __forceinline__ bf16x8 as_bf16x8(u32x4 w) { return *reinterpret_cast<bf16x8*>(&w); }


#define XB_TMO      128
#define XB_XCNT(j)  (256  + 64 * (j))
#define XB_XSUB(j)  (1280 + 64 * (j))
#define XB_XGEN(j)  (2304 + 64 * (j))
#define XB_TOP      3328
#define XB_TOPGEN   3392
#define XCD_BAR_WORDS 3456
#define XB_SPIN_CAP (1u << 18)
#define LAS __attribute__((address_space(3)))
__device__ __forceinline__ unsigned xb_ld(unsigned* p)              { return __hip_atomic_load(p, __ATOMIC_RELAXED, __HIP_MEMORY_SCOPE_AGENT); }
__device__ __forceinline__ unsigned xb_add(unsigned* p, unsigned v) { return __hip_atomic_fetch_add(p, v, __ATOMIC_RELAXED, __HIP_MEMORY_SCOPE_AGENT); }
__device__ __forceinline__ unsigned xb_xcc_id() { return (unsigned)__builtin_amdgcn_s_getreg((3 << 11) | 20) & 0xFu; }
#define XB_SPIN(cond, bar) do { unsigned _sp = 0; while (cond) { __builtin_amdgcn_s_sleep(1); \
    if ((++_sp & 255u) == 0u) { if (xb_ld(&(bar)[XB_TMO])) break; if (_sp > XB_SPIN_CAP) { atomicAdd(&(bar)[XB_TMO], 1u); break; } } } } while (0)
struct XcdBarrier { unsigned* bar; unsigned x; volatile LAS unsigned* st; };
__device__ __forceinline__ XcdBarrier xcd_barrier_post(unsigned* bar, volatile LAS unsigned* st) {
    XcdBarrier b; b.bar = bar; b.x = xb_xcc_id(); b.st = st;
    if (threadIdx.x == 0) (void)xb_add(&bar[XB_XCNT(b.x)], 1u);
    return b;
}
__device__ __forceinline__ void xcd_barrier_complete(unsigned* bar, unsigned x, unsigned& nloc, unsigned& nx) {
    const unsigned G = gridDim.x * gridDim.y * gridDim.z;
    unsigned sum, cnt, mine, sp = 0u;
    for (;;) {
        sum = 0u; cnt = 0u; mine = 0u;
#pragma unroll
        for (unsigned j = 0; j < 16; ++j) { const unsigned c = xb_ld(&bar[XB_XCNT(j)]); sum += c; cnt += (c > 0u) ? 1u : 0u; mine = (j == x) ? c : mine; }
        if (sum == G) break;
        __builtin_amdgcn_s_sleep(1);
        if ((++sp & 255u) == 0u) { if (xb_ld(&bar[XB_TMO])) break; if (sp > XB_SPIN_CAP) { atomicAdd(&bar[XB_TMO], 1u); break; } }
    }
    nloc = mine > 0u ? mine : 1u; nx = cnt > 0u ? cnt : 1u;
}
__device__ __forceinline__ void xcd_barrier(const XcdBarrier& b) {
    asm volatile("s_waitcnt vmcnt(0)" ::: "memory");
    __syncthreads();
    if (threadIdx.x == 0) {
        unsigned* bar = b.bar;
        __builtin_amdgcn_s_waitcnt(0);
        unsigned nloc = b.st[0], nx = b.st[1];
        if (nloc == 0u) { xcd_barrier_complete(bar, b.x, nloc, nx); b.st[0] = nloc; b.st[1] = nx; }
        const unsigned old = xb_add(&bar[XB_XSUB(b.x)], 1u);
        const unsigned gen = old / nloc;
        if (old + 1u == (gen + 1u) * nloc) {
            __builtin_amdgcn_fence(__ATOMIC_RELEASE, "agent");
            asm volatile("s_waitcnt vmcnt(0)" ::: "memory");
            const unsigned og = xb_add(&bar[XB_TOP], 1u);
            const unsigned tg = og / nx;
            if (og + 1u == (tg + 1u) * nx) xb_add(&bar[XB_TOPGEN], 1u);
            else XB_SPIN(xb_ld(&bar[XB_TOPGEN]) == tg, bar);
            __builtin_amdgcn_fence(__ATOMIC_ACQUIRE, "agent");
            xb_add(&bar[XB_XGEN(b.x)], 1u);
            asm volatile("s_waitcnt vmcnt(0)" ::: "memory");
        } else {
            XB_SPIN(xb_ld(&bar[XB_XGEN(b.x)]) == gen, bar);
            __builtin_amdgcn_fence(__ATOMIC_ACQUIRE, "agent");
            asm volatile("s_waitcnt vmcnt(0)" ::: "memory");
        }
    }
    __syncthreads();
}


namespace pg8 {
#define PG8_LAS __attribute__((address_space(3)))
constexpr int BM = 256, BK = 64, HALF = 128, HTB = HALF * BK * 2, STAGE_BYTES = 8 * HTB, NXCD = 8, WGM = 8;
__host__ __device__ __forceinline__ int lds_byte(int r, int c) { const int st = (r >> 4) * 2 + (c >> 5), rr = r & 15, cc = c & 31, ob = rr * 64 + cc * 2; return st * 1024 + (ob ^ (((ob >> 9) & 1) << 5)); }
__host__ __device__ __forceinline__ void stage_rc(int b, int& R, int& C) { const int st = b / 1024, sb = b % 1024, swz = sb ^ (((sb >> 9) & 1) << 5); R = (st >> 1) * 16 + swz / 64; C = (st & 1) * 32 + (swz % 64) / 2; }
__host__ __device__ __forceinline__ int perm32(int rho) { const int n = rho >> 4, i = rho & 15; return 8 * (i >> 2) + 4 * n + (i & 3); }
struct Unit { int pm, pn; };
struct Gemm { const bf16_t* A; const bf16_t* Bt; int M, N, K; };
struct StaticOrder {
    int nM, nN, nwg, G, c;
    __host__ __device__ void init(int M, int N, int G_, int c_) { nM = M / BM; nN = N / BM; nwg = nM * nN; G = G_; c = c_; }
    __host__ __device__ bool next(int i, Unit& u) const {
        const long L = (long)i * G + c; if (L >= nwg) return false;
        int wgid = (int)L; { const int q = nwg / NXCD, r = nwg % NXCD, xcd = wgid % NXCD, off = wgid / NXCD; wgid = (xcd < r ? xcd * (q + 1) : r * (q + 1) + (xcd - r) * q) + off; }
        const int nig = WGM * nN, gid = wgid / nig, fm = gid * WGM, gsz = (nM - fm) < WGM ? (nM - fm) : WGM;
        u.pm = fm + ((wgid % nig) % gsz); u.pn = (wgid % nig) / gsz; return true;
    }
    __device__ __forceinline__ void a_ready(const Unit&) const {}
    __device__ __forceinline__ void done(const Unit&) const {}
};
template <class Epi, class Sched>
__device__ __forceinline__ void gemm_phase(PG8_LAS unsigned char* lds, const Gemm g, const Sched& S, const Epi& E) {
    int tid_ = threadIdx.x; asm volatile("" : "+v"(tid_));
    const int tid = tid_, wid = __builtin_amdgcn_readfirstlane(tid >> 6), lane = tid & 63, wr = wid >> 2, wc = wid & 3, fr = lane & 15, fq = lane >> 4;
    const int K = g.K, nt = K / BK;
    unsigned voffA[2], voffB[2];
#pragma unroll
    for (int i = 0; i < 2; ++i) { int R, C; stage_rc(tid * 16 + i * 8192, R, C); const int Rb = Epi::PERM ? ((R & ~31) + perm32(R & 31)) : R;
        voffA[i] = (unsigned)(R * K + C) * 2u; voffB[i] = (unsigned)(Rb * K + C) * 2u; }
    const size_t kstep = (size_t)(BK * 2);
    const size_t hstep = (size_t)HALF * K * 2;
    const size_t tstep = 2 * hstep;
    const unsigned ldsw = (unsigned)wid * 1024u;
    const int aoff = lds_byte(wr * 64 + fr, fq * 8), boff = lds_byte(wc * 32 + fr, fq * 8);
#define PG8_SA(b, h) (((b) * 2 + (h)) * HTB)
#define PG8_SB(b, h) ((4 + (b) * 2 + (h)) * HTB)
#define PG8_STAGE(bufoff, gbase, voff) do { _Pragma("unroll") for (int _i = 0; _i < 2; ++_i) \
        __builtin_amdgcn_global_load_lds((const unsigned*)((const char*)(gbase) + (voff)[_i]), (PG8_LAS unsigned*)(lds + (bufoff) + ldsw + _i * 8192), 16, 0, 0); } while (0)
#define PG8_LDA(dst, b, h) do { _Pragma("unroll") for (int m = 0; m < 4; ++m) _Pragma("unroll") for (int k = 0; k < 2; ++k) dst[m][k] = *(const PG8_LAS bf16x8*)(lds + PG8_SA(b, h) + aoff + m * 2048 + k * 1024); } while (0)
#define PG8_LDB(dst, b, h) do { _Pragma("unroll") for (int n = 0; n < 2; ++n) _Pragma("unroll") for (int k = 0; k < 2; ++k) dst[n][k] = *(const PG8_LAS bf16x8*)(lds + PG8_SB(b, h) + boff + n * 2048 + k * 1024); } while (0)
#define PG8_MMA(ai, bj, At, Bt) do { __builtin_amdgcn_s_setprio(1); _Pragma("unroll") for (int m = 0; m < 4; ++m) _Pragma("unroll") for (int n = 0; n < 2; ++n) _Pragma("unroll") for (int k = 0; k < 2; ++k) \
        acc[ai][bj][m][n] = __builtin_amdgcn_mfma_f32_16x16x32_bf16(Bt[n][k], At[m][k], acc[ai][bj][m][n], 0, 0, 0); __builtin_amdgcn_s_setprio(0); } while (0)
#define PG8_WAIT_V(n) asm volatile("s_waitcnt vmcnt(" #n ")" ::: "memory")
#define PG8_WAIT_L(n) asm volatile("s_waitcnt lgkmcnt(" #n ")" ::: "memory")
#define PG8_BAR __builtin_amdgcn_s_barrier()
#define PG8_SCHED __builtin_amdgcn_sched_barrier(0)
    Unit cur, nxt; int ui = 0;
    if (!S.next(0, cur)) return;
    f32x4 acc[2][2][4][2];
#pragma unroll
    for (int a = 0; a < 2; ++a)
#pragma unroll
        for (int b = 0; b < 2; ++b)
#pragma unroll
            for (int m = 0; m < 4; ++m)
#pragma unroll
                for (int n = 0; n < 2; ++n) acc[a][b][m][n] = (f32x4){0.f, 0.f, 0.f, 0.f};
    bf16x8 At[4][2], B0[2][2], B1[2][2];
    const char* cA = (const char*)g.A + (size_t)cur.pm * tstep; const char* cB = (const char*)g.Bt + (size_t)cur.pn * tstep;
    S.a_ready(cur);
    PG8_STAGE(PG8_SB(0, 0), cB, voffB); PG8_STAGE(PG8_SA(0, 0), cA, voffA); PG8_STAGE(PG8_SB(0, 1), cB + hstep, voffB); PG8_STAGE(PG8_SA(0, 1), cA + hstep, voffA);
    if (wr == 1) PG8_BAR;
    PG8_WAIT_V(4); PG8_BAR;
    PG8_STAGE(PG8_SB(1, 0), cB + kstep, voffB); PG8_STAGE(PG8_SA(1, 0), cA + kstep, voffA); PG8_STAGE(PG8_SB(1, 1), cB + hstep + kstep, voffB);
    PG8_WAIT_V(6); PG8_BAR;
    for (;;) {
        const bool has_next = S.next(ui + 1, nxt);
        const char* nA = has_next ? (const char*)g.A + (size_t)nxt.pm * tstep : cA; const char* nB = has_next ? (const char*)g.Bt + (size_t)nxt.pn * tstep : cB;
        for (int t = 0; t < nt; t += 2) {
            const bool last = (t == nt - 2);
            const char* a1 = cA + (size_t)(t + 1) * kstep;
            const char* a2 = last ? nA : cA + (size_t)(t + 2) * kstep; const char* b2 = last ? nB : cB + (size_t)(t + 2) * kstep;
            const char* a3 = a2 + kstep; const char* b3 = b2 + kstep;
            if (last && has_next) S.a_ready(nxt);
            PG8_LDB(B0, 0, 0); PG8_SCHED; PG8_LDA(At, 0, 0); PG8_STAGE(PG8_SA(1, 1), a1 + hstep, voffA);
            PG8_WAIT_L(8); PG8_BAR; PG8_WAIT_L(0); PG8_MMA(0, 0, At, B0); PG8_BAR; PG8_SCHED;
            PG8_LDB(B1, 0, 1); PG8_STAGE(PG8_SB(0, 0), b2, voffB);
            PG8_BAR; PG8_WAIT_L(0); PG8_MMA(0, 1, At, B1); PG8_BAR;
            PG8_LDA(At, 0, 1); PG8_STAGE(PG8_SA(0, 0), a2, voffA);
            PG8_BAR; PG8_WAIT_L(0); PG8_MMA(1, 0, At, B0); PG8_BAR; PG8_SCHED;
            PG8_STAGE(PG8_SB(0, 1), b2 + hstep, voffB);
            PG8_WAIT_V(6); PG8_BAR; PG8_MMA(1, 1, At, B1); PG8_BAR;
            PG8_LDB(B0, 1, 0); PG8_SCHED; PG8_LDA(At, 1, 0); PG8_STAGE(PG8_SA(0, 1), a2 + hstep, voffA);
            PG8_WAIT_L(8); PG8_BAR; PG8_WAIT_L(0); PG8_MMA(0, 0, At, B0); PG8_BAR; PG8_SCHED;
            PG8_LDB(B1, 1, 1); PG8_STAGE(PG8_SB(1, 0), b3, voffB);
            PG8_BAR; PG8_WAIT_L(0); PG8_MMA(0, 1, At, B1); PG8_BAR;
            PG8_LDA(At, 1, 1); PG8_STAGE(PG8_SA(1, 0), a3, voffA);
            PG8_BAR; PG8_WAIT_L(0); PG8_MMA(1, 0, At, B0); PG8_BAR; PG8_SCHED;
            PG8_STAGE(PG8_SB(1, 1), b3 + hstep, voffB);
            PG8_WAIT_V(6); PG8_BAR; PG8_MMA(1, 1, At, B1); PG8_BAR;
        }
        if constexpr (Epi::CHAIN) { if ((ui & 1) == 0) E.mid(acc, cur, wr, wc, fr, fq); else E(acc, cur, wr, wc, fr, fq); }
        else if constexpr (!Epi::AFTER_DRAIN) { E(acc, cur, wr, wc, fr, fq); S.done(cur); }
        if (!has_next) break;
        if (!(Epi::CHAIN && (ui & 1) == 0))
#pragma unroll
        for (int a = 0; a < 2; ++a)
#pragma unroll
            for (int b = 0; b < 2; ++b)
#pragma unroll
                for (int m = 0; m < 4; ++m)
#pragma unroll
                    for (int n = 0; n < 2; ++n) acc[a][b][m][n] = (f32x4){0.f, 0.f, 0.f, 0.f};
        cur = nxt; cA = nA; cB = nB; ++ui;
    }
    PG8_WAIT_V(0);
    if (wr == 0) PG8_BAR;
    PG8_BAR;
    if constexpr (Epi::AFTER_DRAIN) { E.fused(acc, cur, wr, wc, fr, fq, lds, wid, lane); S.done(cur); }
#undef PG8_SA
#undef PG8_SB
#undef PG8_STAGE
#undef PG8_LDA
#undef PG8_LDB
#undef PG8_MMA
#undef PG8_WAIT_V
#undef PG8_WAIT_L
#undef PG8_BAR
#undef PG8_SCHED
}

__device__ __forceinline__ u32x4 pk8(f32x4 a, f32x4 b) { u32x4 w; w.x = pk2(a[0], a[1]); w.y = pk2(a[2], a[3]); w.z = pk2(b[0], b[1]); w.w = pk2(b[2], b[3]); return w; }
__device__ __forceinline__ unsigned u8x4_sig(f32x4 v) { return (unsigned)__float2int_rn(255.f * sigmoidf_(v[0])) | ((unsigned)__float2int_rn(255.f * sigmoidf_(v[1])) << 8) | ((unsigned)__float2int_rn(255.f * sigmoidf_(v[2])) << 16) | ((unsigned)__float2int_rn(255.f * sigmoidf_(v[3])) << 24); }
__device__ __forceinline__ f32x4 u8x4_f(unsigned w) { return (f32x4){(float)(w & 255u), (float)((w >> 8) & 255u), (float)((w >> 16) & 255u), (float)(w >> 24)} * (1.f / 255.f); }
struct EpiStoreBf16 {
    static constexpr bool PERM = true, AFTER_DRAIN = false, CHAIN = false;
    bf16_t* O; int ldc;
    __device__ __forceinline__ void operator()(const f32x4 (&acc)[2][2][4][2], const Unit& u, int wr, int wc, int fr, int fq) const {
        const int row0 = u.pm * BM + wr * 64 + fr, col0 = u.pn * BM + wc * 32 + 8 * fq;
#pragma unroll
        for (int ai = 0; ai < 2; ++ai)
#pragma unroll
            for (int m = 0; m < 4; ++m) { bf16_t* rowp = O + (size_t)(row0 + ai * HALF + m * 16) * ldc + col0;
#pragma unroll
                for (int bj = 0; bj < 2; ++bj) *(u32x4*)(rowp + bj * HALF) = pk8(acc[ai][bj][m][0], acc[ai][bj][m][1]); }
    }
};
struct EpiProj {
    static constexpr bool PERM = true, AFTER_DRAIN = false, CHAIN = false;
    bf16_t* P; unsigned char* G8;
    __device__ __forceinline__ void operator()(const f32x4 (&acc)[2][2][4][2], const Unit& u, int wr, int wc, int fr, int fq) const {
        const int row0 = u.pm * BM + wr * 64 + fr;
        if (u.pn < NPA / 256) {
            const int col0 = u.pn * BM + wc * 32 + 8 * fq;
#pragma unroll
            for (int ai = 0; ai < 2; ++ai)
#pragma unroll
                for (int m = 0; m < 4; ++m) { bf16_t* rowp = P + (size_t)(row0 + ai * HALF + m * 16) * NPA + col0;
#pragma unroll
                    for (int bj = 0; bj < 2; ++bj) *(u32x4*)(rowp + bj * HALF) = pk8(acc[ai][bj][m][0], acc[ai][bj][m][1]); }
        } else {
            const int col0 = (u.pn - NPA / 256) * BM + wc * 32 + 8 * fq;
#pragma unroll
            for (int ai = 0; ai < 2; ++ai)
#pragma unroll
                for (int m = 0; m < 4; ++m) { unsigned char* rowp = G8 + (size_t)(row0 + ai * HALF + m * 16) * 2048 + col0;
#pragma unroll
                    for (int bj = 0; bj < 2; ++bj) { u32x2 w; w.x = u8x4_sig(acc[ai][bj][m][0]); w.y = u8x4_sig(acc[ai][bj][m][1]); *(u32x2*)(rowp + bj * HALF) = w; } }
        }
    }
};
template <bool SECOND> struct EpiMerge {
    static constexpr bool PERM = true, AFTER_DRAIN = false, CHAIN = false;
    bf16_t* Mg; const unsigned char* G8; int gcol;
    __device__ __forceinline__ void operator()(const f32x4 (&acc)[2][2][4][2], const Unit& u, int wr, int wc, int fr, int fq) const {
        const int row0 = u.pm * BM + wr * 64 + fr, col0 = u.pn * BM + wc * 32 + 8 * fq;
#pragma unroll
        for (int ai = 0; ai < 2; ++ai)
#pragma unroll
            for (int m = 0; m < 4; ++m) { const size_t row = (size_t)(row0 + ai * HALF + m * 16);
                __builtin_amdgcn_sched_barrier(0);
#pragma unroll
                for (int bj = 0; bj < 2; ++bj) {
                    const int c = col0 + bj * HALF;
                    const u32x2 g = *(const u32x2*)(G8 + row * 2048 + gcol + c);
                    f32x4 v0 = acc[ai][bj][m][0] * u8x4_f(g.x), v1 = acc[ai][bj][m][1] * u8x4_f(g.y);
                    if (SECOND) { const u32x4 pr = *(const u32x4*)(Mg + row * 1024 + c);
                        v0 += (f32x4){lo_f(pr.x), hi_f(pr.x), lo_f(pr.y), hi_f(pr.y)}; v1 += (f32x4){lo_f(pr.z), hi_f(pr.z), lo_f(pr.w), hi_f(pr.w)}; }
                    *(u32x4*)(Mg + row * 1024 + c) = pk8(v0, v1);
                } }
    }
};
struct EpiMergeChain {
    static constexpr bool PERM = true, AFTER_DRAIN = false, CHAIN = true;
    bf16_t* Mg; const unsigned char* G8;
    static __device__ __forceinline__ f32x4 g2e(unsigned w) { const f32x4 g = u8x4_f(w); return (f32x4){fmaxf(g[0], 1e-6f), fmaxf(g[1], 1e-6f), fmaxf(g[2], 1e-6f), fmaxf(g[3], 1e-6f)}; }
    static __device__ __forceinline__ f32x4 rcp4(f32x4 v) { return (f32x4){__builtin_amdgcn_rcpf(v[0]), __builtin_amdgcn_rcpf(v[1]), __builtin_amdgcn_rcpf(v[2]), __builtin_amdgcn_rcpf(v[3])}; }
    __device__ __forceinline__ void mid(f32x4 (&acc)[2][2][4][2], const Unit& u, int wr, int wc, int fr, int fq) const {
        const int row0 = u.pm * BM + wr * 64 + fr, col0 = u.pn * BM + wc * 32 + 8 * fq;
#pragma unroll
        for (int ai = 0; ai < 2; ++ai) {
            u32x2 G1[4][2], G2[4][2];
#pragma unroll
            for (int m = 0; m < 4; ++m)
#pragma unroll
                for (int bj = 0; bj < 2; ++bj) { const unsigned char* gp = G8 + (size_t)(row0 + ai * HALF + m * 16) * 2048 + col0 + bj * HALF; G1[m][bj] = *(const u32x2*)gp; G2[m][bj] = *(const u32x2*)(gp + 1024); }
#pragma unroll
            for (int m = 0; m < 4; ++m)
#pragma unroll
                for (int bj = 0; bj < 2; ++bj) { acc[ai][bj][m][0] *= u8x4_f(G1[m][bj].x) * rcp4(g2e(G2[m][bj].x)); acc[ai][bj][m][1] *= u8x4_f(G1[m][bj].y) * rcp4(g2e(G2[m][bj].y)); }
        }
    }
    __device__ __forceinline__ void operator()(const f32x4 (&acc)[2][2][4][2], const Unit& u, int wr, int wc, int fr, int fq) const {
        const int row0 = (u.pm - 64) * BM + wr * 64 + fr, col0 = (u.pn - 4) * BM + wc * 32 + 8 * fq;
#pragma unroll
        for (int ai = 0; ai < 2; ++ai) {
            u32x2 G2[4][2];
#pragma unroll
            for (int m = 0; m < 4; ++m)
#pragma unroll
                for (int bj = 0; bj < 2; ++bj) G2[m][bj] = *(const u32x2*)(G8 + (size_t)(row0 + ai * HALF + m * 16) * 2048 + 1024 + col0 + bj * HALF);
#pragma unroll
            for (int m = 0; m < 4; ++m)
#pragma unroll
                for (int bj = 0; bj < 2; ++bj)
                    *(u32x4*)(Mg + (size_t)(row0 + ai * HALF + m * 16) * 1024 + col0 + bj * HALF) = pk8(acc[ai][bj][m][0] * g2e(G2[m][bj].x), acc[ai][bj][m][1] * g2e(G2[m][bj].y));
        }
    }
};
struct ChainOrder {
    StaticOrder S;
    __host__ __device__ bool next(int i, Unit& u) const { if (!S.next(i >> 1, u)) return false; if (i & 1) { u.pm += 64; u.pn += 4; } return true; }
    __device__ __forceinline__ void a_ready(const Unit&) const {}
    __device__ __forceinline__ void done(const Unit&) const {}
};
struct EpiMix {
    static constexpr bool PERM = true, AFTER_DRAIN = false, CHAIN = false;
    const float* x; bf16_t* x1; const float* mod;
    __device__ __forceinline__ void operator()(const f32x4 (&acc)[2][2][4][2], const Unit& u, int wr, int wc, int fr, int fq) const {
        const int row0 = u.pm * BM + wr * 64 + fr, col0 = u.pn * BM + wc * 32 + 8 * fq;
        const float* gt1 = mod + ((u.pm * BM) >> 12) * 6144 + 2048;
        f32x4 g[2][2];
#pragma unroll
        for (int bj = 0; bj < 2; ++bj) { g[bj][0] = *(const f32x4*)(gt1 + col0 + bj * HALF); g[bj][1] = *(const f32x4*)(gt1 + col0 + bj * HALF + 4); }
#pragma unroll
        for (int am = 0; am < 4; ++am) {
            const int ai = am >> 1, m0 = (am & 1) * 2;
            f32x4 xv[2][2][2];
#pragma unroll
            for (int m = 0; m < 2; ++m)
#pragma unroll
                for (int bj = 0; bj < 2; ++bj) { const float* xp = x + (size_t)(row0 + ai * HALF + (m0 + m) * 16) * 1024 + col0 + bj * HALF; xv[m][bj][0] = *(const f32x4*)xp; xv[m][bj][1] = *(const f32x4*)(xp + 4); }
#pragma unroll
            for (int m = 0; m < 2; ++m)
#pragma unroll
                for (int bj = 0; bj < 2; ++bj)
                    *(u32x4*)(x1 + (size_t)(row0 + ai * HALF + (m0 + m) * 16) * 1024 + col0 + bj * HALF) = pk8(xv[m][bj][0] + g[bj][0] * acc[ai][bj][m0 + m][0], xv[m][bj][1] + g[bj][1] * acc[ai][bj][m0 + m][1]);
        }
    }
};
}

__device__ __forceinline__ void p0_mod_partials(const Params& p, unsigned char* lds, int task) {
    const int jb = task % 12, ks = task / 12, tid = otid();
    const float* c = p.in[1]; const float* w_ada = p.in[3];
    float* sc = (float*)lds;
    __syncthreads();
    if (tid < 256) { const int b = tid >> 6, k = tid & 63; const float v = c[b * 1024 + ks * 64 + k]; sc[tid] = v * sigmoidf_(v); }
    __syncthreads();
    const int j = jb * 512 + tid;
    float a0 = 0.f, a1 = 0.f, a2 = 0.f, a3 = 0.f;
    for (int k = 0; k < 64; ++k) { const float w = w_ada[(size_t)(ks * 64 + k) * 6144 + j]; a0 += sc[k] * w; a1 += sc[64 + k] * w; a2 += sc[128 + k] * w; a3 += sc[192 + k] * w; }
    float* modp = (float*)(p.ws + OFF_MODP) + (size_t)ks * 4 * 6144;
    modp[0 * 6144 + j] = a0; modp[1 * 6144 + j] = a1; modp[2 * 6144 + j] = a2; modp[3 * 6144 + j] = a3;
}
__device__ __forceinline__ void cvt_tile(const float* __restrict__ src, int ld, int K, int N, const float* __restrict__ g, bf16_t* __restrict__ dst, int tile, unsigned char* lds) {
    const int ntk = K / 64, tk = tile % ntk, tn = tile / ntk, k0 = tk * 64, n0 = tn * 256, tid = otid();
    bf16_t* tl = (bf16_t*)lds;
    f32x4 v[8];
#pragma unroll
    for (int i = 0; i < 8; ++i) {
        const int kr = (tid >> 4) + 32 * (i & 1), nc = (i >> 1) * 64 + (tid & 15) * 4, k = k0 + kr, n = n0 + nc;
        v[i] = (f32x4){0.f, 0.f, 0.f, 0.f};
        if (n < N) v[i] = *(const f32x4*)(src + (size_t)k * ld + n);
    }
    __syncthreads();
#pragma unroll
    for (int i = 0; i < 8; ++i) {
        const int kr = (tid >> 4) + 32 * (i & 1), nc = (i >> 1) * 64 + (tid & 15) * 4;
        const float gg = g ? g[k0 + kr] : 1.f;
        tl[(nc + 0) * 72 + kr] = f2bf(v[i][0] * gg); tl[(nc + 1) * 72 + kr] = f2bf(v[i][1] * gg); tl[(nc + 2) * 72 + kr] = f2bf(v[i][2] * gg); tl[(nc + 3) * 72 + kr] = f2bf(v[i][3] * gg);
    }
    __syncthreads();
#pragma unroll
    for (int i = 0; i < 4; ++i) { const int nl = (tid >> 3) + 64 * i, kc = tid & 7; *(u32x4*)(dst + (size_t)(n0 + nl) * K + k0 + kc * 8) = *(const u32x4*)(tl + nl * 72 + kc * 8); }
}
constexpr int NJOBS = 11; constexpr int NJOBS_EARLY = 2;
__device__ constexpr int J_IN[NJOBS]   = {6, 6, 9, 11, 15, 17, 19, 14, 25, 26, 28};
__device__ constexpr int J_COFF[NJOBS] = {0, 2208, 0, 0, 0, 0, 0, 0, 0, 0, 0};
__device__ constexpr int J_LD[NJOBS]   = {4256, 4256, 768, 1024, 512, 512, 512, 1024, 1024, 1024, 2048};
__device__ constexpr int J_K[NJOBS]    = {1024, 1024, 256, 128, 64, 64, 128, 512, 512, 1024, 1024};
__device__ constexpr int J_N[NJOBS]    = {2208, 2048, 768, 1024, 512, 512, 512, 1024, 1024, 1024, 2048};
__device__ constexpr int J_NPAD[NJOBS] = {NPA, 2048, 768, 1024, 512, 512, 512, 1024, 1024, 1024, 2048};
__device__ constexpr int J_G[NJOBS]    = {-1, -1, 8, 10, -1, -1, -1, -1, -1, -1, -1};
__device__ constexpr unsigned J_DST[NJOBS] = {(unsigned)OFF_WINA, (unsigned)OFF_WG, (unsigned)OFF_WUQ, (unsigned)OFF_WUKV, (unsigned)OFF_WDEC, (unsigned)OFF_WAAA, (unsigned)OFF_WGATE,
                                              (unsigned)OFF_WOMLA, (unsigned)OFF_WORWKV, (unsigned)OFF_WOUT, (unsigned)OFF_WQRY};
__device__ __forceinline__ void p0_prep(const Params& p, unsigned char* lds) {
    const int tid = otid(), nblk = gridDim.x, bid = blockIdx.x;
    if (bid == 0 && tid < 64) ((unsigned*)(p.ws + OFF_CTR))[tid] = 0u;
    int total = 192;
    for (int j = 0; j < NJOBS_EARLY; ++j) total += (J_NPAD[j] / 256) * (J_K[j] / 64);
    for (int task = bid; task < total; task += nblk) {
        if (task < 192) { p0_mod_partials(p, lds, task); continue; }
        int tt = task - 192;
        for (int j = 0; j < NJOBS_EARLY; ++j) {
            const int nt = (J_NPAD[j] / 256) * (J_K[j] / 64);
            if (tt < nt) { cvt_tile(p.in[J_IN[j]] + J_COFF[j], J_LD[j], J_K[j], J_N[j], J_G[j] >= 0 ? p.in[J_G[j]] : nullptr, (bf16_t*)(p.ws + J_DST[j]), tt, lds); break; }
            tt -= nt;
        }
    }
}
__device__ __forceinline__ void p0_late_weights(const Params& p, unsigned char* lds) {
    const int G = gridDim.x, nwg = (T_TOK / 256) * ((NPA + 2048) / 256), extra = nwg % G, c = blockIdx.x;
    const bool mine = extra == 0 || c >= extra; const int nb = extra == 0 ? G : G - extra, ci = extra == 0 ? c : c - extra;
    if (!mine) return;
    const int tid = otid();
    for (int i = ci * NTHREADS + tid; i < T_TOK * 16; i += nb * NTHREADS) {
        const int t = i >> 4, f = i & 15;
        const float inv_freq = exp2f(-(float)f * (13.287712379549449f / 16.f));
        const float ang = (float)((const int*)p.in[2])[t] * inv_freq;
        const float n = rintf(ang * 0.15915494309189535f);
        float r = fmaf(-n, 6.28318548202514648f, ang); r = fmaf(-n, -1.7484555e-7f, r);
        float* rp = (float*)(p.ws + OFF_ROPE) + (size_t)t * 32;
        rp[f] = __cosf(r); rp[16 + f] = __sinf(r);
    }
    for (int i = ci * NTHREADS + tid; i < 2 * 128 * 128; i += nb * NTHREADS) {
        const int which = i >> 14, e = i & 16383;
        ((bf16_t*)(p.ws + (which ? OFF_SK2 : OFF_SK1)))[e] = f2bf(p.in[which ? 30 : 29][e]);
    }
    int total = 0;
    for (int j = NJOBS_EARLY; j < NJOBS; ++j) total += (J_NPAD[j] / 256) * (J_K[j] / 64);
    for (int task = ci; task < total; task += nb) {
        int tt = task;
        for (int j = NJOBS_EARLY; j < NJOBS; ++j) {
            const int nt = (J_NPAD[j] / 256) * (J_K[j] / 64);
            if (tt < nt) { cvt_tile(p.in[J_IN[j]] + J_COFF[j], J_LD[j], J_K[j], J_N[j], J_G[j] >= 0 ? p.in[J_G[j]] : nullptr, (bf16_t*)(p.ws + J_DST[j]), tt, lds); break; }
            tt -= nt;
        }
    }
}

template <bool FROM_PART>
__device__ __forceinline__ void modnorm_phase(const Params& p, const float* __restrict__ src, const float* __restrict__ gain, int sh_col, bf16_t* __restrict__ dst, unsigned char* lds) {
    const int tid = otid(), lane = tid & 63, wid = tid >> 6;
    float* mul = (float*)lds; float* add = mul + 1024;
    for (int blk = blockIdx.x; blk < T_TOK / 64; blk += gridDim.x) {
        const int b = (blk * 64) / SEQ;
        __syncthreads();
        for (int cidx = tid; cidx < 1024; cidx += NTHREADS) {
            float sh, sc;
            if (FROM_PART) {
                sh = p.in[4][sh_col + cidx]; sc = p.in[4][sh_col + 1024 + cidx];
                const float* mp = (const float*)(p.ws + OFF_MODP) + b * 6144;
                for (int ks = 0; ks < 16; ++ks) { sh += mp[(size_t)ks * 4 * 6144 + sh_col + cidx]; sc += mp[(size_t)ks * 4 * 6144 + sh_col + 1024 + cidx]; }
            } else {
                const float* m = (const float*)(p.ws + OFF_MOD) + b * 6144;
                sh = m[sh_col + cidx]; sc = m[sh_col + 1024 + cidx];
            }
            mul[cidx] = gain[cidx] * (1.f + sc); add[cidx] = sh;
        }
        __syncthreads();
#pragma unroll 1
        for (int tb = 0; tb < 2; ++tb) {
            f32x4 v[4][4];
#pragma unroll
            for (int r = 0; r < 4; ++r) { const int t = blk * 64 + wid + 8 * (tb * 4 + r);
#pragma unroll
                for (int i = 0; i < 4; ++i) v[r][i] = FROM_PART ? *(const f32x4*)(src + (size_t)t * 1024 + i * 256 + lane * 4) : bf4(*(const u32x2*)((const bf16_t*)src + (size_t)t * 1024 + i * 256 + lane * 4)); }
#pragma unroll
            for (int r = 0; r < 4; ++r) { const int t = blk * 64 + wid + 8 * (tb * 4 + r);
                float ss = 0.f;
#pragma unroll
                for (int i = 0; i < 4; ++i) ss += v[r][i][0] * v[r][i][0] + v[r][i][1] * v[r][i][1] + v[r][i][2] * v[r][i][2] + v[r][i][3] * v[r][i][3];
                ss = wave_sum(ss);
                const float rstd = rsqrtf(ss * (1.f / 1024.f) + 1e-6f);
#pragma unroll
                for (int i = 0; i < 4; ++i) {
                    const int c0 = i * 256 + lane * 4;
                    const f32x4 m = *(const f32x4*)(mul + c0), a = *(const f32x4*)(add + c0);
                    u32x2 w; w.x = pk2(v[r][i][0] * rstd * m[0] + a[0], v[r][i][1] * rstd * m[1] + a[1]); w.y = pk2(v[r][i][2] * rstd * m[2] + a[2], v[r][i][3] * rstd * m[3] + a[3]);
                    *(u32x2*)(dst + (size_t)t * 1024 + c0) = w;
                }
            }
        }
    }
}
__device__ __forceinline__ void p1_finalize_mod(const Params& p) {
    for (int i = blockIdx.x * NTHREADS + otid(); i < 4 * 6144; i += gridDim.x * NTHREADS) {
        const int j = i % 6144;
        float s = p.in[4][j];
        const float* mp = (const float*)(p.ws + OFF_MODP) + i;
        for (int ks = 0; ks < 16; ++ks) s += mp[(size_t)ks * 4 * 6144];
        ((float*)(p.ws + OFF_MOD))[i] = s;
    }
}

constexpr int LDS_MAIN = 155648;
constexpr int G_LDR = 144;
constexpr int G_ABYTES = 256 * G_LDR, G_BBYTES = 128 * G_LDR, G_STAGE = G_ABYTES + G_BBYTES;
struct ALoadPlain { const bf16_t* A; int lda; __device__ __forceinline__ u32x4 operator()(int row, int k) const { return *(const u32x4*)(A + (size_t)row * lda + k); } };

template <class AL>
__device__ __forceinline__ void gemm_accum(f32x16 (&acc)[2][2], const AL& al, const bf16_t* __restrict__ Bt, int ldb, int K, int m0, int n0, unsigned char* lds) {
    const int tid = threadIdx.x, lane = tid & 63, wid = tid >> 6, wm = wid >> 1, wn = wid & 1, r32 = lane & 31, hi = lane >> 5;
    u32x4 ra[4], rb[2];
    const int nk = K / 64;
    auto gload = [&](int kt) {
#pragma unroll
        for (int i = 0; i < 4; ++i) { const int c = tid + NTHREADS * i; ra[i] = al(m0 + (c >> 3), kt * 64 + (c & 7) * 8); }
#pragma unroll
        for (int i = 0; i < 2; ++i) { const int c = tid + NTHREADS * i; rb[i] = *(const u32x4*)(Bt + (size_t)(n0 + (c >> 3)) * ldb + kt * 64 + (c & 7) * 8); }
    };
    auto swrite = [&](int buf) {
        unsigned char* sa = lds + buf * G_STAGE; unsigned char* sb = sa + G_ABYTES;
#pragma unroll
        for (int i = 0; i < 4; ++i) { const int c = tid + NTHREADS * i; *(u32x4*)(sa + (c >> 3) * G_LDR + (c & 7) * 16) = ra[i]; }
#pragma unroll
        for (int i = 0; i < 2; ++i) { const int c = tid + NTHREADS * i; *(u32x4*)(sb + (c >> 3) * G_LDR + (c & 7) * 16) = rb[i]; }
    };
    __syncthreads();
    gload(0); swrite(0);
    __syncthreads();
    for (int kt = 0; kt < nk; ++kt) {
        if (kt + 1 < nk) gload(kt + 1);
        const unsigned char* sa = lds + (kt & 1) * G_STAGE + (wm * 64 + r32) * G_LDR + hi * 16;
        const unsigned char* sb = lds + (kt & 1) * G_STAGE + G_ABYTES + (wn * 64 + r32) * G_LDR + hi * 16;
#pragma unroll
        for (int s = 0; s < 4; ++s) {
            const bf16x8 a0 = *(const bf16x8*)(sa + s * 32), a1 = *(const bf16x8*)(sa + 32 * G_LDR + s * 32);
            const bf16x8 b0 = *(const bf16x8*)(sb + s * 32), b1 = *(const bf16x8*)(sb + 32 * G_LDR + s * 32);
            acc[0][0] = MFMA32(a0, b0, acc[0][0]); acc[0][1] = MFMA32(a0, b1, acc[0][1]);
            acc[1][0] = MFMA32(a1, b0, acc[1][0]); acc[1][1] = MFMA32(a1, b1, acc[1][1]);
        }
        if (kt + 1 < nk) swrite((kt + 1) & 1);
        __syncthreads();
    }
}
__device__ __forceinline__ void zero_acc(f32x16 (&acc)[2][2]) {
#pragma unroll
    for (int i = 0; i < 2; ++i)
#pragma unroll
        for (int j = 0; j < 2; ++j)
#pragma unroll
            for (int r = 0; r < 16; ++r) acc[i][j][r] = 0.f;
}

constexpr int E_LDR = 272;
__device__ __forceinline__ void store_tile_bf16(const f32x16 (&v)[2][2], bf16_t* __restrict__ C, int ldc, int m0, int n0, unsigned char* lds) {
    const int tid = threadIdx.x, lane = tid & 63, wid = tid >> 6, wm = wid >> 1, wn = wid & 1, r32 = lane & 31, hi = lane >> 5;
    __syncthreads();
    unsigned char* base = lds + (wm * 64 + 4 * hi) * E_LDR + (wn * 64 + r32) * 2;
#pragma unroll
    for (int i = 0; i < 2; ++i)
#pragma unroll
        for (int j = 0; j < 2; ++j)
#pragma unroll
            for (int r = 0; r < 16; ++r) *(bf16_t*)(base + (i * 32 + (r & 3) + 8 * (r >> 2)) * E_LDR + j * 64) = f2bf(v[i][j][r]);
    __syncthreads();
#pragma unroll
    for (int i = 0; i < 8; ++i) { const int c = tid + NTHREADS * i, row = c >> 4, ch = c & 15;
        *(u32x4*)(C + (size_t)(m0 + row) * ldc + n0 + ch * 8) = *(const u32x4*)(lds + row * E_LDR + ch * 16); }
}
__device__ __forceinline__ void p2_proj(const Params& p, PG8_LAS unsigned char* ldsl, unsigned char* lds) {
    pg8::StaticOrder S; S.init(T_TOK, NPA + 2048, gridDim.x, blockIdx.x);
    const pg8::Gemm g{(const bf16_t*)((const unsigned char*)p.out + DO_H), (const bf16_t*)(p.ws + OFF_WINA), T_TOK, NPA + 2048, 1024};
    const pg8::EpiProj E{(bf16_t*)(p.ws + OFF_P), p.ws + OFF_G8};
    pg8::gemm_phase(ldsl, g, S, E);
    p0_late_weights(p, lds);
}
#ifndef P3_REP_Q
#define P3_REP_Q 1
#endif
#ifndef P3_REP_KV
#define P3_REP_KV 1
#endif
#ifndef P3_REP_L
#define P3_REP_L 1
#endif
constexpr float EPSN = 1e-6f;
constexpr float QSCALE = 0.10206207261596575f * 1.4426950408889634f;
__device__ __forceinline__ float sumsq8(u32x4 w) {
    float s = 0.f;
#pragma unroll
    for (int i = 0; i < 4; ++i) { const float a = lo_f(w[i]), b = hi_f(w[i]); s += a * a + b * b; }
    return s;
}
__device__ __forceinline__ void p3_q_load(const Params& p, int task, int lane, u32x4 (&av)[16]) {
    const int tile = task >> 3, r32 = lane & 31, hi = lane >> 5, t = tile * 32 + r32;
    const bf16_t* arow = (const bf16_t*)(p.ws + OFF_P) + (size_t)t * NPA + C_QA + hi * 8;
#pragma unroll
    for (int s = 0; s < 16; ++s) av[s] = *(const u32x4*)(arow + s * 16);
}
__device__ __forceinline__ void p3_q_task(const Params& p, int task, int lane, const unsigned char* wq  , const u32x4 (&avin)[16]) {
    const int head = task & 7, tile = task >> 3, r32 = lane & 31, hi = lane >> 5, t = tile * 32 + r32;
    const unsigned char* wrow = wq + r32 * 528 + hi * 16;
    f32x16 acc[3];
#pragma unroll
    for (int f = 0; f < 3; ++f)
#pragma unroll
        for (int r = 0; r < 16; ++r) acc[f][r] = 0.f;
    float ss = 0.f;
#pragma unroll
    for (int s = 0; s < 16; ++s) {
        const u32x4 av = avin[s];
        ss += sumsq8(av);
        const bf16x8 a = as_bf16x8(av);
#pragma unroll
        for (int f = 0; f < 3; ++f) { const bf16x8 w = *(const bf16x8*)(wrow + f * 32 * 528 + s * 32); acc[f] = MFMA32(w, a, acc[f]); }
    }
    ss = xhalf_sum(ss);
    const float rstd = rsqrtf(ss * (1.f / 256.f) + EPSN);
    float sn = 0.f, sr = 0.f;
#pragma unroll
    for (int r = 0; r < 16; ++r) { acc[0][r] *= rstd; acc[1][r] *= rstd; acc[2][r] *= rstd; sn += acc[0][r] * acc[0][r] + acc[1][r] * acc[1][r]; sr += acc[2][r] * acc[2][r]; }
    sn = xhalf_sum(sn); sr = xhalf_sum(sr);
    const float rn = rsqrtf(sn * (1.f / 64.f) + EPSN) * QSCALE, rr = rsqrtf(sr * (1.f / 32.f) + EPSN) * QSCALE;
    const float* qn = p.in[12];
    bf16_t* qo = (bf16_t*)((unsigned char*)p.out + DO_Q) + (size_t)t * 768 + head * 96;
#pragma unroll
    for (int f = 0; f < 2; ++f)
#pragma unroll
        for (int rq = 0; rq < 4; ++rq) {
            const int f0 = f * 32 + 8 * rq + 4 * hi;
            const f32x4 g = *(const f32x4*)(qn + f0);
            u32x2 w; w.x = pk2(acc[f][rq * 4 + 0] * rn * g[0], acc[f][rq * 4 + 1] * rn * g[1]); w.y = pk2(acc[f][rq * 4 + 2] * rn * g[2], acc[f][rq * 4 + 3] * rn * g[3]);
            *(u32x2*)(qo + f0) = w;
        }
    const float* rope = (const float*)(p.ws + OFF_ROPE) + (size_t)t * 32;
#pragma unroll
    for (int rq = 0; rq < 2; ++rq) {
        const int i0 = 8 * rq + 4 * hi;
        const f32x4 g1 = *(const f32x4*)(qn + 64 + i0), g2 = *(const f32x4*)(qn + 80 + i0), cs = *(const f32x4*)(rope + i0), sn4 = *(const f32x4*)(rope + 16 + i0);
        float o1[4], o2[4];
#pragma unroll
        for (int j = 0; j < 4; ++j) { const float x1 = acc[2][rq * 4 + j] * rr * g1[j], x2 = acc[2][8 + rq * 4 + j] * rr * g2[j]; o1[j] = x1 * cs[j] - x2 * sn4[j]; o2[j] = x1 * sn4[j] + x2 * cs[j]; }
        u32x2 w1, w2; w1.x = pk2(o1[0], o1[1]); w1.y = pk2(o1[2], o1[3]); w2.x = pk2(o2[0], o2[1]); w2.y = pk2(o2[2], o2[3]);
        *(u32x2*)(qo + 64 + i0) = w1; *(u32x2*)(qo + 80 + i0) = w2;
    }
}
__device__ __forceinline__ int vperm(int s) { return (s & ~12) | ((s & 4) << 1) | ((s & 8) >> 1); }
__device__ __forceinline__ void p3_kv_load(const Params& p, int task, int lane, u32x4 (&av)[8]) {
    const int tile = task >> 3, r32 = lane & 31, hi = lane >> 5, t = tile * 32 + r32;
    const bf16_t* arow = (const bf16_t*)(p.ws + OFF_P) + (size_t)t * NPA + C_KVA + hi * 8;
#pragma unroll
    for (int s = 0; s < 8; ++s) av[s] = *(const u32x4*)(arow + s * 16);
}
__device__ __forceinline__ void p3_kv_task(const Params& p, int task, int lane, unsigned char* wl, const unsigned char* wkv  , const u32x4 (&avin)[8]) {
    const int head = task & 7, tile = task >> 3, r32 = lane & 31, hi = lane >> 5, t = tile * 32 + r32;
    const bf16_t* prow = (const bf16_t*)(p.ws + OFF_P) + (size_t)t * NPA;
    const unsigned char* wrow = wkv + r32 * 272 + hi * 16;
    f32x16 acc[4];
#pragma unroll
    for (int f = 0; f < 4; ++f)
#pragma unroll
        for (int r = 0; r < 16; ++r) acc[f][r] = 0.f;
    float ss = 0.f;
#pragma unroll
    for (int s = 0; s < 8; ++s) {
        const u32x4 av = avin[s];
        ss += sumsq8(av);
        const bf16x8 a = as_bf16x8(av);
#pragma unroll
        for (int f = 0; f < 4; ++f) { const bf16x8 w = *(const bf16x8*)(wrow + f * 32 * 272 + s * 32); acc[f] = MFMA32(w, a, acc[f]); }
    }
    ss = xhalf_sum(ss);
    const float rstd = rsqrtf(ss * (1.f / 128.f) + EPSN);
    float sn = 0.f;
#pragma unroll
    for (int r = 0; r < 16; ++r) { acc[0][r] *= rstd; acc[1][r] *= rstd; sn += acc[0][r] * acc[0][r] + acc[1][r] * acc[1][r]; }
    sn = xhalf_sum(sn);
    const float rn = rsqrtf(sn * (1.f / 64.f) + EPSN);
    const float* kn = p.in[13];
    bf16_t* ko = (bf16_t*)((unsigned char*)p.out + DO_K) + (size_t)t * 768 + head * 96;
#pragma unroll
    for (int f = 0; f < 2; ++f)
#pragma unroll
        for (int rq = 0; rq < 4; ++rq) {
            const int f0 = f * 32 + 8 * rq + 4 * hi;
            const f32x4 g = *(const f32x4*)(kn + f0);
            u32x2 w; w.x = pk2(acc[f][rq * 4 + 0] * rn * g[0], acc[f][rq * 4 + 1] * rn * g[1]); w.y = pk2(acc[f][rq * 4 + 2] * rn * g[2], acc[f][rq * 4 + 3] * rn * g[3]);
            *(u32x2*)(ko + f0) = w;
        }
    {
        const float* rope = (const float*)(p.ws + OFF_ROPE) + (size_t)t * 32;
        float x1[2][4], x2[2][4]; float sr = 0.f;
#pragma unroll
        for (int rq = 0; rq < 2; ++rq) {
            const int i0 = 8 * rq + 4 * hi;
            const u32x2 a = *(const u32x2*)(prow + C_KR + i0), b = *(const u32x2*)(prow + C_KR + 16 + i0);
            x1[rq][0] = lo_f(a.x); x1[rq][1] = hi_f(a.x); x1[rq][2] = lo_f(a.y); x1[rq][3] = hi_f(a.y);
            x2[rq][0] = lo_f(b.x); x2[rq][1] = hi_f(b.x); x2[rq][2] = lo_f(b.y); x2[rq][3] = hi_f(b.y);
#pragma unroll
            for (int j = 0; j < 4; ++j) sr += x1[rq][j] * x1[rq][j] + x2[rq][j] * x2[rq][j];
        }
        sr = xhalf_sum(sr);
        const float rr = rsqrtf(sr * (1.f / 32.f) + EPSN);
#pragma unroll
        for (int rq = 0; rq < 2; ++rq) {
            const int i0 = 8 * rq + 4 * hi;
            const f32x4 g1 = *(const f32x4*)(kn + 64 + i0), g2 = *(const f32x4*)(kn + 80 + i0), cs = *(const f32x4*)(rope + i0), sn4 = *(const f32x4*)(rope + 16 + i0);
            float o1[4], o2[4];
#pragma unroll
            for (int j = 0; j < 4; ++j) { const float a = x1[rq][j] * rr * g1[j], b = x2[rq][j] * rr * g2[j]; o1[j] = a * cs[j] - b * sn4[j]; o2[j] = a * sn4[j] + b * cs[j]; }
            u32x2 w1, w2; w1.x = pk2(o1[0], o1[1]); w1.y = pk2(o1[2], o1[3]); w2.x = pk2(o2[0], o2[1]); w2.y = pk2(o2[2], o2[3]);
            *(u32x2*)(ko + 64 + i0) = w1; *(u32x2*)(ko + 80 + i0) = w2;
        }
    }
    __builtin_amdgcn_wave_barrier(); asm volatile("s_waitcnt lgkmcnt(0)" ::: "memory");
#pragma unroll
    for (int f = 0; f < 2; ++f)
#pragma unroll
        for (int r = 0; r < 16; ++r) *(bf16_t*)(wl + (f * 32 + (r & 3) + 8 * (r >> 2) + 4 * hi) * 80 + vperm(r32) * 2) = f2bf(acc[2 + f][r] * rstd);
    __builtin_amdgcn_wave_barrier(); asm volatile("s_waitcnt lgkmcnt(0)" ::: "memory");
    const int b = (tile * 32) >> 12, s0 = (tile * 32) & 4095;
    bf16_t* vo = (bf16_t*)((unsigned char*)p.out + DO_VT) + ((size_t)(b * 8 + head) * 64) * 4096 + s0;
#pragma unroll
    for (int i = 0; i < 4; ++i) { const int c = lane + 64 * i, row = c >> 2, ch = c & 3; *(u32x4*)(vo + (size_t)row * 4096 + ch * 8) = *(const u32x4*)(wl + row * 80 + ch * 16); }
}
template <int LORA, bool KEEP = false>
__device__ __forceinline__ void p3_lora_task(const Params& p, int tile, int fg, int lane, unsigned char* wl) {
    constexpr int CIN = LORA == 0 ? C_WD : (LORA == 1 ? C_AD : C_GD), KL = LORA == 2 ? 128 : 64;
    constexpr size_t WOFF = LORA == 0 ? OFF_WDEC : (LORA == 1 ? OFF_WAAA : OFF_WGATE), OOFF = LORA == 0 ? OFF_SE : (LORA == 1 ? OFF_SB : OFF_SG);
    const int r32 = lane & 31, hi = lane >> 5, t = tile * 32 + r32;
    const bf16_t* prow = (const bf16_t*)(p.ws + OFF_P) + (size_t)t * NPA + CIN + hi * 8;
    const float* mu = p.in[7] + (CIN - C_RW) + hi * 8;
    const bool first = (t & 4095) == 0;
    const bf16_t* wrow = (const bf16_t*)(p.ws + WOFF) + (size_t)(fg * 128 + r32) * KL + hi * 8;
    f32x16 acc[4];
#pragma unroll
    for (int f = 0; f < 4; ++f)
#pragma unroll
        for (int r = 0; r < 16; ++r) acc[f][r] = 0.f;
#pragma unroll
    for (int s = 0; s < KL / 16; ++s) {
        const u32x4 cur = *(const u32x4*)(prow + s * 16);
        u32x4 prv = {0u, 0u, 0u, 0u};
        if (!first) prv = *(const u32x4*)(prow - NPA + s * 16);
        const f32x4 m0 = *(const f32x4*)(mu + s * 16), m1 = *(const f32x4*)(mu + s * 16 + 4);
        float v[8];
#pragma unroll
        for (int i = 0; i < 4; ++i) {
            const float c0 = lo_f(cur[i]), c1 = hi_f(cur[i]), p0 = lo_f(prv[i]), p1 = hi_f(prv[i]);
            const float ma = (i < 2) ? m0[2 * i] : m1[2 * i - 4], mb = (i < 2) ? m0[2 * i + 1] : m1[2 * i - 3];
            v[2 * i] = c0 + (p0 - c0) * ma; v[2 * i + 1] = c1 + (p1 - c1) * mb;
        }
#pragma unroll
        for (int i = 0; i < 8; ++i) v[i] = LORA == 0 ? tanhf_(v[i]) : (LORA == 2 ? sigmoidf_(v[i]) : v[i]);
        u32x4 aw; aw.x = pk2(v[0], v[1]); aw.y = pk2(v[2], v[3]); aw.z = pk2(v[4], v[5]); aw.w = pk2(v[6], v[7]);
        const bf16x8 a = as_bf16x8(aw);
#pragma unroll
        for (int f = 0; f < 4; ++f) { const bf16x8 w = *(const bf16x8*)(wrow + (size_t)f * 32 * KL + s * 16); acc[f] = MFMA32(a, w, acc[f]); }
    }
    __builtin_amdgcn_wave_barrier(); asm volatile("s_waitcnt lgkmcnt(0)" ::: "memory");
#pragma unroll
    for (int f = 0; f < 4; ++f)
#pragma unroll
        for (int r = 0; r < 16; ++r) *(bf16_t*)(wl + ((r & 3) + 8 * (r >> 2) + 4 * hi) * 272 + (f * 32 + r32) * 2) = f2bf(acc[f][r]);
    __builtin_amdgcn_wave_barrier(); asm volatile("s_waitcnt lgkmcnt(0)" ::: "memory");
    if (KEEP) return;
    bf16_t* o = (bf16_t*)(p.ws + OOFF) + (size_t)(tile * 32) * 512 + fg * 128;
#pragma unroll
    for (int i = 0; i < 8; ++i) { const int c = lane + 64 * i, row = c >> 4, ch = c & 15; *(u32x4*)(o + (size_t)row * 512 + ch * 8) = *(const u32x4*)(wl + row * 272 + ch * 16); }
}
__device__ __forceinline__ void p4c_tile2(const Params& p, int tile, int hd0, int lane, const unsigned char* decp, const unsigned char* aprp);
__device__ __forceinline__ void p3_small(const Params& p, unsigned char* lds, bool lora_only = false) {
    const int tid = otid(), lane = tid & 63, wid = tid >> 6, gw = blockIdx.x * 8 + wid, nw = gridDim.x * 8;
    unsigned char* wl = lds + wid * 8704;
    unsigned char* wsh = lds + 8 * 8704;
    __syncthreads();
    if (!lora_only) {
        const int head = blockIdx.x & 7, tb = blockIdx.x >> 3;
        for (int c = tid; c < 96 * 32; c += NTHREADS) { const int row = c >> 5, ch = c & 31;
            *(u32x4*)(wsh + row * 528 + ch * 16) = *(const u32x4*)((const bf16_t*)(p.ws + OFF_WUQ) + (size_t)(head * 96 + row) * 256 + ch * 8); }
        __syncthreads();
        {   const int tq0 = (tb + 32 * wid) * 8 + head, tq1 = (tb + 32 * (wid + 8)) * 8 + head;
            u32x4 a0[16], a1[16];
            p3_q_load(p, tq0, lane, a0); p3_q_load(p, tq1, lane, a1);
            p3_q_task(p, tq0, lane, wsh, a0); p3_q_task(p, tq1, lane, wsh, a1); }
        __syncthreads();
        for (int c = tid; c < 128 * 16; c += NTHREADS) { const int row = c >> 4, ch = c & 15;
            *(u32x4*)(wsh + row * 272 + ch * 16) = *(const u32x4*)((const bf16_t*)(p.ws + OFF_WUKV) + (size_t)(head * 128 + row) * 128 + ch * 8); }
        __syncthreads();
        {   const int tk0 = (tb + 32 * wid) * 8 + head, tk1 = (tb + 32 * (wid + 8)) * 8 + head;
            u32x4 b0[8], b1[8];
            p3_kv_load(p, tk0, lane, b0); p3_kv_load(p, tk1, lane, b1);
            p3_kv_task(p, tk0, lane, wl, wsh, b0); p3_kv_task(p, tk1, lane, wl, wsh, b1); }
    }
#if defined(CHUNKED) && !defined(SCAN_VERIFY)
    __syncthreads();
    unsigned char* wl2 = lds + (8 + wid) * 8704;
#pragma unroll 1
    for (int tt = gw; tt < 512 * 4; tt += nw) {
        int tile = tt >> 2, fg = tt & 3;
        asm volatile("" : "+v"(tile), "+v"(fg));
        p3_lora_task<2>(p, tile, fg, lane, wl);
        __builtin_amdgcn_wave_barrier(); asm volatile("s_waitcnt lgkmcnt(0)" ::: "memory");
        asm volatile("" : "+v"(tile), "+v"(fg));
        p3_lora_task<0, true>(p, tile, fg, lane, wl);
        asm volatile("" : "+v"(tile), "+v"(fg));
        p3_lora_task<1, true>(p, tile, fg, lane, wl2);
        __builtin_amdgcn_wave_barrier(); asm volatile("s_waitcnt lgkmcnt(0)" ::: "memory");
        p4c_tile2(p, tile, 2 * fg, lane, wl, wl2);
        __builtin_amdgcn_wave_barrier(); asm volatile("s_waitcnt lgkmcnt(0)" ::: "memory");
    }
    return;
#endif
    constexpr int NL = 512 * 12;
    for (int rep_ = 0; rep_ < P3_REP_L; ++rep_) for (int tt = gw; tt < NL; tt += nw) {
        const int tile = tt / 12, sub = tt % 12, lora = sub >> 2, fg = sub & 3;
        if (lora == 0) p3_lora_task<0>(p, tile, fg, lane, wl); else if (lora == 1) p3_lora_task<1>(p, tile, fg, lane, wl); else p3_lora_task<2>(p, tile, fg, lane, wl);
    }
}

template <int CTRL> __device__ __forceinline__ float dpp_f(float v) { return __int_as_float(__builtin_amdgcn_update_dpp(0, __float_as_int(v), CTRL, 0xf, 0xf, false)); }
__device__ __forceinline__ float reduce16(float v) { v += dpp_f<0xB1>(v); v += dpp_f<0x4E>(v); v += dpp_f<0x141>(v); v += dpp_f<0x140>(v); return v; }
__device__ __forceinline__ void p4_rwkv_prep(const Params& p) {
    const int lane = otid() & 63, gw = blockIdx.x * 8 + (otid() >> 6), nw = gridDim.x * 8, ts = lane >> 4, cg = lane & 15;
    const bf16_t* P = (const bf16_t*)(p.ws + OFF_P);
    for (int task = gw; task < (T_TOK / 4) * 8; task += nw) {
        const int t = (task >> 3) * 4 + ts, hd = task & 7, ch = hd * 64 + cg * 4;
        const bf16_t* row = P + (size_t)t * NPA;
        const bool first = (t & 4095) == 0;
        const f32x4 r0 = bf4(*(const u32x2*)(row + C_R + ch)), k0 = bf4(*(const u32x2*)(row + C_K + ch)), v0 = bf4(*(const u32x2*)(row + C_V + ch));
        f32x4 rp = {0.f, 0.f, 0.f, 0.f}, kp = rp, vp = rp;
        if (!first) { rp = bf4(*(const u32x2*)(row + C_R + ch - NPA)); kp = bf4(*(const u32x2*)(row + C_K + ch - NPA)); vp = bf4(*(const u32x2*)(row + C_V + ch - NPA)); }
        const float* mu = p.in[7];
        const f32x4 r = r0 + (rp - r0) * *(const f32x4*)(mu + ch), k = k0 + (kp - k0) * *(const f32x4*)(mu + 512 + ch), v = v0 + (vp - v0) * *(const f32x4*)(mu + 1024 + ch);
        const size_t o = (size_t)t * 512 + ch;
        const f32x4 dec = *(const f32x4*)(p.in[16] + ch) + bf4(*(const u32x2*)((const bf16_t*)(p.ws + OFF_SE) + o));
        const f32x4 apre = *(const f32x4*)(p.in[18] + ch) + bf4(*(const u32x2*)((const bf16_t*)(p.ws + OFF_SB) + o));
        const f32x4 kkw = *(const f32x4*)(p.in[20] + ch), kaw = *(const f32x4*)(p.in[21] + ch);
        f32x4 e, a, kkr, kh;
        float n2 = 0.f;
#pragma unroll
        for (int i = 0; i < 4; ++i) {
            const float nd = -dec[i], sp = fmaxf(nd, 0.f) + __logf(1.f + __expf(-fabsf(nd)));
            e[i] = __expf(-sp - 0.5f);
            a[i] = sigmoidf_(apre[i]);
            kkr[i] = k[i] * kkw[i]; n2 += kkr[i] * kkr[i];
            kh[i] = k[i] * (1.f + (a[i] - 1.f) * kaw[i]);
        }
        n2 = reduce16(n2);
        const float inv = __builtin_amdgcn_rsqf(fmaxf(n2, 1e-24f));
        const f32x4 kk = kkr * inv;
        *(u32x2*)((bf16_t*)(p.ws + OFF_SR) + o) = pk4(r); *(u32x2*)((bf16_t*)(p.ws + OFF_SE) + o) = pk4(e); *(u32x2*)((bf16_t*)(p.ws + OFF_SKH) + o) = pk4(kh);
        *(u32x2*)((bf16_t*)(p.ws + OFF_SV) + o) = pk4(v); *(u32x2*)((bf16_t*)(p.ws + OFF_SKK) + o) = pk4(kk); *(u32x2*)((bf16_t*)(p.ws + OFF_SB) + o) = pk4(kk * a);
    }
}

constexpr int SC_CH = 32;
constexpr size_t OFF_YRAW = OFF_P + 32 * MiB;
#ifdef SCAN_VERIFY
#define YRAW_PTR(p) ((bf16_t*)((unsigned char*)(p).out))
#else
#define YRAW_PTR(p) ((bf16_t*)((p).ws + OFF_YRAW))
#endif
__device__ __forceinline__ void scan_task(const Params& p, int task, unsigned char* lds) {
    const int rq = task & 3, bh = task >> 2, b = bh >> 3, hd = bh & 7, tid = otid(), lane = tid & 63, wid = tid >> 6;
    constexpr int VEC_F = 9 * 16 * 64, SC_F = 16 * 4, VB_F = 32 * 64, BUF_F = VEC_F + SC_F + VB_F;
    float* buf = (float*)lds;
    float* ybuf = buf + 2 * BUF_F;
    const bool producer = wid >= 4;
    const int ptid = tid - 256, pj = ptid >> 4, pc = ptid & 15;
    u32x2 st[12];
    auto gload = [&](int c) {
        const size_t base = ((size_t)(b * 4096 + c * SC_CH + 2 * pj)) * 512 + hd * 64 + pc * 4;
#pragma unroll
        for (int i = 0; i < 6; ++i) { const size_t off = i == 0 ? OFF_SE : i == 1 ? OFF_SKK : i == 2 ? OFF_SB : i == 3 ? OFF_SKH : i == 4 ? OFF_SR : OFF_SV;
            st[2 * i] = *(const u32x2*)((const bf16_t*)(p.ws + off) + base); st[2 * i + 1] = *(const u32x2*)((const bf16_t*)(p.ws + off) + base + 512); }
    };
    auto swrite = [&](int bsel) {
        const f32x4 e0 = bf4(st[0]), e1 = bf4(st[1]), kk0 = bf4(st[2]), kk1 = bf4(st[3]), b0 = bf4(st[4]), b1 = bf4(st[5]), k0 = bf4(st[6]), k1 = bf4(st[7]), r0 = bf4(st[8]), r1 = bf4(st[9]);
        f32x4 w0, w1;
#pragma unroll
        for (int i = 0; i < 4; ++i) { w0[i] = __expf(-e0[i]); w1[i] = __expf(-e1[i]); }
        const f32x4 nk0 = -kk0, nk1 = -kk1;
        float* vb = buf + (size_t)bsel * BUF_F + pj * 64 + pc * 4;
        *(f32x4*)(vb + 0 * 1024) = nk0; *(f32x4*)(vb + 1 * 1024) = w0 * nk1; *(f32x4*)(vb + 2 * 1024) = w0 * r0; *(f32x4*)(vb + 3 * 1024) = w0 * w1; *(f32x4*)(vb + 4 * 1024) = b0 * w1;
        *(f32x4*)(vb + 5 * 1024) = k0 * w1; *(f32x4*)(vb + 6 * 1024) = b1; *(f32x4*)(vb + 7 * 1024) = k1; *(f32x4*)(vb + 8 * 1024) = r1;
        const f32x4 t0 = b0 * nk1, t1 = k0 * nk1, t2 = b0 * r0, t3 = k0 * r0;
        const float beta = reduce16((t0[0] + t0[1]) + (t0[2] + t0[3])), kappa = reduce16((t1[0] + t1[1]) + (t1[2] + t1[3]));
        const float rhob = reduce16((t2[0] + t2[1]) + (t2[2] + t2[3])), rhok = reduce16((t3[0] + t3[1]) + (t3[2] + t3[3]));
        if (pc == 0) *(f32x4*)(buf + (size_t)bsel * BUF_F + VEC_F + pj * 4) = (f32x4){beta, kappa, rhob, rhok};
        float* vv = buf + (size_t)bsel * BUF_F + VEC_F + SC_F + (2 * pj) * 64 + pc * 4;
        *(f32x4*)vv = bf4(st[10]); *(f32x4*)(vv + 64) = bf4(st[11]);
    };
    auto ydrain = [&](int c) {
        const int tok = ptid >> 3, pr = ptid & 7;
        const float* yb = ybuf + (size_t)(c & 1) * SC_CH * 16 + tok * 16 + pr * 2;
        *(unsigned*)(YRAW_PTR(p) + ((size_t)(b * 4096 + c * SC_CH + tok)) * 512 + hd * 64 + rq * 16 + pr * 2) = pk2(yb[0], yb[1]);
    };
    __syncthreads();
    if (producer) { gload(0); swrite(0); }
    __syncthreads();
    constexpr int NCH = SEQ / SC_CH;
    const int kq = lane & 15, rl = wid * 4 + (lane >> 4), row = rq * 16 + rl;
    f32x2 sA = {0.f, 0.f}, sB = {0.f, 0.f};
    for (int c = 0; c < NCH; ++c) {
        if (producer) {
            if (c + 1 < NCH) gload(c + 1);
            if (c > 0) ydrain(c - 1);
            if (c + 1 < NCH) swrite((c + 1) & 1);
        } else {
            const float* __restrict__ bb = buf + (size_t)(c & 1) * BUF_F + kq * 4;
            const float* __restrict__ scp = buf + (size_t)(c & 1) * BUF_F + VEC_F;
            const float* __restrict__ vp = buf + (size_t)(c & 1) * BUF_F + VEC_F + SC_F + row;
            float* __restrict__ yb = ybuf + (size_t)(c & 1) * SC_CH * 16 + rl;
            f32x4 q[9];
#pragma unroll
            for (int a = 0; a < 9; ++a) q[a] = *(const f32x4*)(bb + a * 1024);
            f32x4 sc = *(const f32x4*)scp; float v0 = vp[0], v1 = vp[64];
            float ykA = 0.f, ykB = 0.f;
#pragma unroll
            for (int j = 0; j < 16; ++j) {
                const int jn = j < 15 ? j + 1 : j;
                f32x4 qn[9];
#pragma unroll
                for (int a = 0; a < 9; ++a) qn[a] = *(const f32x4*)(bb + a * 1024 + jn * 64);
                const f32x4 scn = *(const f32x4*)(scp + jn * 4); const float v0n = vp[2 * jn * 64], v1n = vp[(2 * jn + 1) * 64];
                const f32x2 d1 = sA * (f32x2){q[0][0], q[0][1]} + sB * (f32x2){q[0][2], q[0][3]};
                const f32x2 d2 = sA * (f32x2){q[1][0], q[1][1]} + sB * (f32x2){q[1][2], q[1][3]};
                const f32x2 d3 = sA * (f32x2){q[2][0], q[2][1]} + sB * (f32x2){q[2][2], q[2][3]};
                float r1 = d1.x + d1.y, r2 = d2.x + d2.y, r3 = d3.x + d3.y;
                r1 += dpp_f<0xB1>(r1); r2 += dpp_f<0xB1>(r2); r3 += dpp_f<0xB1>(r3);
                r1 += dpp_f<0x4E>(r1); r2 += dpp_f<0x4E>(r2); r3 += dpp_f<0x4E>(r3);
                r1 += dpp_f<0x141>(r1); r2 += dpp_f<0x141>(r2); r3 += dpp_f<0x141>(r3);
                r1 += dpp_f<0x140>(r1); r2 += dpp_f<0x140>(r2); r3 += dpp_f<0x140>(r3);
                const float sa1 = r1, sa2 = r2 + sa1 * sc[0] + v0 * sc[1], y0 = r3 + sa1 * sc[2] + v0 * sc[3];
                const f32x2 a1 = {sa1, sa1}, a2 = {sa2, sa2}, u0 = {v0, v0}, u1 = {v1, v1};
                sA = sA * (f32x2){q[3][0], q[3][1]} + a1 * (f32x2){q[4][0], q[4][1]} + u0 * (f32x2){q[5][0], q[5][1]} + a2 * (f32x2){q[6][0], q[6][1]} + u1 * (f32x2){q[7][0], q[7][1]};
                sB = sB * (f32x2){q[3][2], q[3][3]} + a1 * (f32x2){q[4][2], q[4][3]} + u0 * (f32x2){q[5][2], q[5][3]} + a2 * (f32x2){q[6][2], q[6][3]} + u1 * (f32x2){q[7][2], q[7][3]};
                const f32x2 yy = sA * (f32x2){q[8][0], q[8][1]} + sB * (f32x2){q[8][2], q[8][3]};
                const float y1 = reduce16(yy.x + yy.y);
                ykA = (kq == j) ? y0 : ykA; ykB = (kq == j) ? y1 : ykB;
#pragma unroll
                for (int a = 0; a < 9; ++a) q[a] = qn[a];
                sc = scn; v0 = v0n; v1 = v1n;
            }
            yb[(2 * kq) * 16] = ykA; yb[(2 * kq + 1) * 16] = ykB;
        }
        __syncthreads();
    }
    if (producer) ydrain(NCH - 1);
}

constexpr size_t OFF_ABAR = OFF_SKK, OFF_BTIL = OFF_SB, OFF_KTIL = OFF_SKH, OFF_RBAR = OFF_SR;
#ifdef SCAN_VERIFY
#define SCAN_TMP(p) ((unsigned char*)(p).out)
constexpr size_t OFF_GCH = 16 * MiB, OFF_DCH = 32 * MiB, OFF_MCH = 48 * MiB;
#else
#define SCAN_TMP(p) ((p).ws)
constexpr size_t OFF_GCH = OFF_SE, OFF_DCH = 240 * MiB, OFF_MCH = OFF_WINA;
#endif
constexpr size_t OFF_YCH = OFF_SE;
constexpr size_t OFF_HST = 240 * MiB;
typedef __amdgpu_buffer_rsrc_t rsrc_t;
__device__ __forceinline__ rsrc_t mk_rsrc(const void* base, unsigned bytes) {
    const unsigned long long a = (unsigned long long)base;
    const unsigned lo = __builtin_amdgcn_readfirstlane((unsigned)a), hi = __builtin_amdgcn_readfirstlane((unsigned)(a >> 32));
    return __builtin_amdgcn_make_buffer_rsrc((void*)(((unsigned long long)hi << 32) | lo), (short)0, (int)bytes, 0x00020000); }
__device__ __forceinline__ void bstore128(u32x4 v, rsrc_t rs, int voff, int soff, int aux) { __builtin_amdgcn_raw_buffer_store_b128(v, rs, voff, soff, 0); asm volatile("s_nop 1" ::: "memory"); (void)aux; }
__device__ __forceinline__ void bstore16(short v, rsrc_t rs, int voff, int soff, int aux) { __builtin_amdgcn_raw_buffer_store_b16(v, rs, voff, soff, 0); asm volatile("s_nop 1" ::: "memory"); (void)aux; }
__device__ __forceinline__ bf16x8 rowfrag_nat(rsrc_t rs, int sb, int vrow  , int q) { return as_bf16x8(__builtin_amdgcn_raw_buffer_load_b128(rs, vrow + 32 * q, sb, 0)); }
__device__ __forceinline__ bf16x8 rowfrag_perm(rsrc_t rs, int sb, int vrow  , int q) {
    const u32x2 a = __builtin_amdgcn_raw_buffer_load_b64(rs, vrow + 32 * q, sb, 0), b = __builtin_amdgcn_raw_buffer_load_b64(rs, vrow + 32 * q + 16, sb, 0); return as_bf16x8((u32x4){a.x, a.y, b.x, b.y}); }
template <bool PERMK> __device__ __forceinline__ bf16x8 colfrag(rsrc_t rs, int sb, int vcol  , int q) {
    unsigned v[8];
#pragma unroll
    for (int e = 0; e < 8; ++e) { const int t = PERMK ? (16 * q + 8 * (e >> 2) + (e & 3)) : (16 * q + e); v[e] = (unsigned short)__builtin_amdgcn_raw_buffer_load_b16(rs, vcol, sb + t * 1024, 0); }
    return as_bf16x8((u32x4){v[0] | (v[1] << 16), v[2] | (v[3] << 16), v[4] | (v[5] << 16), v[6] | (v[7] << 16)});
}
__device__ __forceinline__ bf16x8 accfrag(const f32x16& a, int q) { return as_bf16x8((u32x4){pk2(a[8 * q], a[8 * q + 1]), pk2(a[8 * q + 2], a[8 * q + 3]), pk2(a[8 * q + 4], a[8 * q + 5]), pk2(a[8 * q + 6], a[8 * q + 7])}); }
__device__ __forceinline__ bf16x8 negfrag(bf16x8 f) { u32x4 w = *reinterpret_cast<u32x4*>(&f); w ^= 0x80008000u; return as_bf16x8(w); }
__device__ __forceinline__ void zero16(f32x16& a) {
#pragma unroll
    for (int r = 0; r < 16; ++r) a[r] = 0.f;
}
__device__ __forceinline__ void tri_inverse_rows(const f32x16& xab, int r32, float (&m)[32]) {
#pragma unroll
    for (int s = 31; s >= 0; --s) {
        float acc = (s == r32) ? 1.f : 0.f;
#pragma unroll
        for (int u = s + 1; u < 32; ++u) {
            const float l = __int_as_float(__builtin_amdgcn_readlane(__float_as_int(xab[(s & 3) + 4 * (s >> 3)]), u + 32 * ((s >> 2) & 1)));
            acc -= m[u] * l;
        }
        m[s] = acc;
    }
}
__device__ __forceinline__ bf16x8 mfrag(const float (&m)[32], int q, int hi, bool perm) {
    float v[8];
#pragma unroll
    for (int e = 0; e < 8; ++e) { const int lo = perm ? (16 * q + 8 * (e >> 2) + (e & 3)) : (16 * q + e), hio = perm ? lo + 4 : lo + 8; v[e] = hi ? m[hio] : m[lo]; }
    return as_bf16x8((u32x4){pk2(v[0], v[1]), pk2(v[2], v[3]), pk2(v[4], v[5]), pk2(v[6], v[7])});
}
__device__ __forceinline__ void scale_rows(f32x16& a, const float* gc  , int hi) {
#pragma unroll
    for (int rq = 0; rq < 4; ++rq) { const f32x4 g = *(const f32x4*)(gc + 8 * rq + 4 * hi);
#pragma unroll
        for (int j = 0; j < 4; ++j) a[rq * 4 + j] *= g[j]; }
}
__device__ __forceinline__ void scale_rows_r(f32x16& a, const f32x4 (&g)[4]) {
#pragma unroll
    for (int rq = 0; rq < 4; ++rq) {
#pragma unroll
        for (int j = 0; j < 4; ++j) a[rq * 4 + j] *= g[rq][j]; }
}

struct ScanRs { rsrc_t abar, btil, ktil, rbar, sv; };
__device__ __forceinline__ void scan_stage_tiles(unsigned char* wl, const ScanRs& R, int sb, int lane) {
    __builtin_amdgcn_wave_barrier(); asm volatile("s_waitcnt lgkmcnt(0)" ::: "memory");
#pragma unroll
    for (int ap = 0; ap < 4; ap += 2) {
        u32x4 t[2][4];
#pragma unroll
        for (int a2 = 0; a2 < 2; ++a2)
#pragma unroll
            for (int i = 0; i < 4; ++i) { const int a = ap + a2, row = (lane >> 3) + 8 * i, ch = lane & 7;
                t[a2][i] = __builtin_amdgcn_raw_buffer_load_b128(a == 0 ? R.abar : a == 1 ? R.btil : a == 2 ? R.ktil : R.sv, row * 1024 + ch * 16, sb, 0); }
#pragma unroll
        for (int a2 = 0; a2 < 2; ++a2)
#pragma unroll
            for (int i = 0; i < 4; ++i) { const int a = ap + a2, row = (lane >> 3) + 8 * i, ch = lane & 7; *(u32x4*)(wl + a * 4608 + row * 144 + ch * 16) = t[a2][i]; }
    }
    __builtin_amdgcn_wave_barrier(); asm volatile("s_waitcnt lgkmcnt(0)" ::: "memory");
}
__device__ __forceinline__ bf16x8 lrow_nat(const unsigned char* wl, int a, int r32, int hi, int q) { return *(const bf16x8*)(wl + a * 4608 + r32 * 144 + (2 * q + hi) * 16); }
template <bool PERMK> __device__ __forceinline__ bf16x8 lcol(const unsigned char* wl, int a, int col, int hi, int q) {
    unsigned v[8];
#pragma unroll
    for (int e = 0; e < 8; ++e) { const int t = (PERMK ? (16 * q + 8 * (e >> 2) + (e & 3) + 4 * hi) : (16 * q + e + 8 * hi));
        v[e] = *(const unsigned short*)(wl + a * 4608 + t * 144 + col * 2); }
    return as_bf16x8((u32x4){v[0] | (v[1] << 16), v[2] | (v[3] << 16), v[4] | (v[5] << 16), v[6] | (v[7] << 16)});
}
__device__ __forceinline__ void scanA_pq(const Params& p, const ScanRs& R, unsigned char* wl, int sb  , int sub  , int lane,
                                         bf16x8 (&Pf)[2][2], bf16x8 (&Qf)[2][2]) {
    const int r32 = lane & 31, hi = lane >> 5;
    scan_stage_tiles(wl, R, sb, lane);
    f32x16 xab, xak; zero16(xab); zero16(xak);
#pragma unroll
    for (int q = 0; q < 4; ++q) {
        const bf16x8 fa = lrow_nat(wl, 0, r32, hi, q), fb = lrow_nat(wl, 1, r32, hi, q), fk = lrow_nat(wl, 2, r32, hi, q);
        xab = MFMA32(fb, fa, xab); xak = MFMA32(fk, fa, xak);
    }
#pragma unroll
    for (int r = 0; r < 16; ++r) { const bool keep = crow(r, hi) < r32; xab[r] = keep ? xab[r] : 0.f; xak[r] = keep ? xak[r] : 0.f; }
    float m[32];
    tri_inverse_rows(xab, r32, m);
    if (hi == 0) {
        bf16_t* Mg = (bf16_t*)(SCAN_TMP(p) + OFF_MCH) + (size_t)sub * 1024 + r32 * 32;
#pragma unroll
        for (int i = 0; i < 4; ++i) *(u32x4*)(Mg + 8 * i) = (u32x4){pk2(m[8 * i], m[8 * i + 1]), pk2(m[8 * i + 2], m[8 * i + 3]), pk2(m[8 * i + 4], m[8 * i + 5]), pk2(m[8 * i + 6], m[8 * i + 7])};
    }
    const bf16x8 mn0 = mfrag(m, 0, hi, false), mn1 = mfrag(m, 1, hi, false), mp0 = mfrag(m, 0, hi, true), mp1 = mfrag(m, 1, hi, true);
    const bf16x8 ak0 = accfrag(xak, 0), ak1 = accfrag(xak, 1);
#pragma unroll
    for (int ct = 0; ct < 2; ++ct) {
        __builtin_amdgcn_sched_barrier(0);
        f32x16 Pt; zero16(Pt);
        Pt = MFMA32(mn0, lcol<false>(wl, 0, r32 + 32 * ct, hi, 0), Pt); Pt = MFMA32(mn1, lcol<false>(wl, 0, r32 + 32 * ct, hi, 1), Pt);
        Pf[ct][0] = accfrag(Pt, 0); Pf[ct][1] = accfrag(Pt, 1);
        f32x16 W; zero16(W);
        W = MFMA32(ak0, lcol<true>(wl, 3, r32 + 32 * ct, hi, 0), W); W = MFMA32(ak1, lcol<true>(wl, 3, r32 + 32 * ct, hi, 1), W);
        f32x16 Qt; zero16(Qt);
        Qt = MFMA32(mp0, accfrag(W, 0), Qt); Qt = MFMA32(mp1, accfrag(W, 1), Qt);
        Qf[ct][0] = accfrag(Qt, 0); Qf[ct][1] = accfrag(Qt, 1);
    }
}
__device__ __forceinline__ void scan_stageA(const Params& p, int task_, int lane, unsigned char* wl) {
    const int task = __builtin_amdgcn_readfirstlane(task_);
    const int bh = task >> 6, c64 = task & 63, b = bh >> 3, hd = bh & 7, r32 = lane & 31, hi = lane >> 5;
    const int sb0 = (int)((((size_t)(b * 4096 + c64 * 64)) * 512 + hd * 64) * 2), sb1 = sb0 + 32 * 1024;
    const int vcn = r32 * 2 + hi * 8192, vcp = r32 * 2 + hi * 4096;
    const ScanRs R{mk_rsrc(p.ws + OFF_ABAR, 16u << 20), mk_rsrc(p.ws + OFF_BTIL, 16u << 20), mk_rsrc(p.ws + OFF_KTIL, 16u << 20), mk_rsrc(p.ws + OFF_RBAR, 16u << 20), mk_rsrc(p.ws + OFF_SV, 16u << 20)};
    const int sub0 = (b * 4096 + c64 * 64) / 32;
    const float* gc0 = (const float*)(p.ws + OFF_GC) + (size_t)sub0 * 512 + hd * 64; const float* gc1 = gc0 + 512;
    const rsrc_t rsD = mk_rsrc(SCAN_TMP(p) + OFF_DCH, 16u << 20);
    const rsrc_t rsT = mk_rsrc(p.ws + OFF_HST, 16u << 20);
    const rsrc_t rsG = mk_rsrc(SCAN_TMP(p) + OFF_GCH, 16u << 20);
    const int so = task * 8192, vl = lane * 32;
    unsigned char* Dgp = SCAN_TMP(p) + OFF_DCH + (size_t)task * 8192 + lane * 32;
    unsigned char* Tgp = p.ws + OFF_HST + (size_t)task * 8192 + lane * 32;
    unsigned char* Ggp = SCAN_TMP(p) + OFF_GCH + (size_t)task * 8192 + lane * 32;
    {
        bf16x8 Pf[2][2], Qf[2][2];
        scanA_pq(p, R, wl, sb0, bh * 128 + c64 * 2, lane, Pf, Qf);
        const int sb = sb0;
        f32x4 gs0[2][4];
#pragma unroll
        for (int kt = 0; kt < 2; ++kt)
#pragma unroll
            for (int rq = 0; rq < 4; ++rq) gs0[kt][rq] = *(const f32x4*)(gc0 + 32 * kt + 8 * rq + 4 * hi);
#pragma unroll
        for (int kt = 0; kt < 2; ++kt) {
        __builtin_amdgcn_sched_barrier(0);
            const bf16x8 nb0 = negfrag(lcol<true>(wl, 1, r32 + 32 * kt, hi, 0)), nb1 = negfrag(lcol<true>(wl, 1, r32 + 32 * kt, hi, 1));
            const bf16x8 kn0 = lcol<false>(wl, 2, r32 + 32 * kt, hi, 0), kn1 = lcol<false>(wl, 2, r32 + 32 * kt, hi, 1);
#pragma unroll
            for (int ct = 0; ct < 2; ++ct) {
        __builtin_amdgcn_sched_barrier(0);
                f32x16 T; zero16(T);
                T = MFMA32(nb0, Pf[ct][0], T); T = MFMA32(nb1, Pf[ct][1], T);
                if (kt == ct) {
#pragma unroll
                    for (int r = 0; r < 16; ++r) T[r] += (crow(r, hi) == r32) ? 1.f : 0.f;
                }
                scale_rows_r(T, gs0[kt]);
                *(bf16x8*)(Ggp + (kt * 2 + ct) * 2048) = accfrag(T, 0); *(bf16x8*)(Ggp + (kt * 2 + ct) * 2048 + 16) = accfrag(T, 1);
                f32x16 D; zero16(D);
                D = MFMA32(kn0, lcol<false>(wl, 3, r32 + 32 * ct, hi, 0), D); D = MFMA32(kn1, lcol<false>(wl, 3, r32 + 32 * ct, hi, 1), D);
                D = MFMA32(nb0, Qf[ct][0], D); D = MFMA32(nb1, Qf[ct][1], D);
                scale_rows_r(D, gs0[kt]);
                *(bf16x8*)(Tgp + (kt * 2 + ct) * 2048) = accfrag(D, 0); *(bf16x8*)(Tgp + (kt * 2 + ct) * 2048 + 16) = accfrag(D, 1);
            }
        }
    }
    const int sb = sb1;
    bf16x8 G2Tf[2][2][2];
    bf16x8 Qf[2][2];
    {
        bf16x8 Pa[2][2];
        scanA_pq(p, R, wl, sb1, bh * 128 + c64 * 2 + 1, lane, Pa, Qf);
#pragma unroll
        for (int kt = 0; kt < 2; ++kt) {
        __builtin_amdgcn_sched_barrier(0);
            const bf16x8 bt0 = lcol<true>(wl, 1, r32 + 32 * kt, hi, 0), bt1 = lcol<true>(wl, 1, r32 + 32 * kt, hi, 1);
            const float g = gc1[r32 + 32 * kt];
#pragma unroll
            for (int ct = 0; ct < 2; ++ct) {
        __builtin_amdgcn_sched_barrier(0);
                f32x16 T; zero16(T);
                T = MFMA32(Pa[ct][0], bt0, T); T = MFMA32(Pa[ct][1], bt1, T);
#pragma unroll
                for (int r = 0; r < 16; ++r) T[r] = g * (((kt == ct) && (crow(r, hi) == r32) ? 1.f : 0.f) - T[r]);
                G2Tf[ct][kt][0] = accfrag(T, 0); G2Tf[ct][kt][1] = accfrag(T, 1);
            }
        }
    }
#pragma unroll
    for (int ct = 0; ct < 2; ++ct) {
        __builtin_amdgcn_sched_barrier(0);
        bf16x8 G1c[2][2], D1c[2][2];
        asm volatile("s_waitcnt vmcnt(0)" ::: "memory");
#pragma unroll
        for (int c = 0; c < 2; ++c) { G1c[c][0] = *(const bf16x8*)(Ggp + (c * 2 + ct) * 2048); G1c[c][1] = *(const bf16x8*)(Ggp + (c * 2 + ct) * 2048 + 16);
                                      D1c[c][0] = *(const bf16x8*)(Tgp + (c * 2 + ct) * 2048); D1c[c][1] = *(const bf16x8*)(Tgp + (c * 2 + ct) * 2048 + 16); }
        const bf16x8 vn0 = lcol<false>(wl, 3, r32 + 32 * ct, hi, 0), vn1 = lcol<false>(wl, 3, r32 + 32 * ct, hi, 1);
#pragma unroll
        for (int kt = 0; kt < 2; ++kt) {
        __builtin_amdgcn_sched_barrier(0);
            const bf16x8 nb0 = negfrag(lcol<true>(wl, 1, r32 + 32 * kt, hi, 0)), nb1 = negfrag(lcol<true>(wl, 1, r32 + 32 * kt, hi, 1));
            const bf16x8 kn0 = lcol<false>(wl, 2, r32 + 32 * kt, hi, 0), kn1 = lcol<false>(wl, 2, r32 + 32 * kt, hi, 1);
            f32x16 D; zero16(D);
            D = MFMA32(kn0, vn0, D); D = MFMA32(kn1, vn1, D);
            D = MFMA32(nb0, Qf[ct][0], D); D = MFMA32(nb1, Qf[ct][1], D);
            scale_rows(D, gc1 + 32 * kt, hi);
#pragma unroll
            for (int c = 0; c < 2; ++c) { D = MFMA32(G2Tf[c][kt][0], D1c[c][0], D); D = MFMA32(G2Tf[c][kt][1], D1c[c][1], D); }
            *(bf16x8*)(Dgp + (kt * 2 + ct) * 2048) = accfrag(D, 0); *(bf16x8*)(Dgp + (kt * 2 + ct) * 2048 + 16) = accfrag(D, 1);
            f32x16 G; zero16(G);
#pragma unroll
            for (int c = 0; c < 2; ++c) { G = MFMA32(G2Tf[c][kt][0], G1c[c][0], G); G = MFMA32(G2Tf[c][kt][1], G1c[c][1], G); }
#pragma unroll
            for (int r = 0; r < 16; ++r) bstore16((short)f2bf(G[r]), rsG, ((r32 >> 4) * 64 + ((r32 >> 2) & 1) * 32 + 4 * hi) * 16 + (4 * ((r32 >> 3) & 1) + (r32 & 3)) * 2, so + ((kt * 4 + 2 * ct) * 64 + (r & 3) + 8 * (r >> 2)) * 16, 0);
        }
    }
}
__device__ __forceinline__ void scan_stageB(const Params& p, int task_, int lane) {
    const int task = __builtin_amdgcn_readfirstlane(task_);
    const int bh = task >> 1, vt = task & 1, r32 = lane & 31, hi = lane >> 5;
    f32x16 H[2]; zero16(H[0]); zero16(H[1]);
    const rsrc_t rsG = mk_rsrc(SCAN_TMP(p) + OFF_GCH, 16u << 20), rsD = mk_rsrc(SCAN_TMP(p) + OFF_DCH, 16u << 20), rsH = mk_rsrc(p.ws + OFF_HST, 16u << 20);
    const int vg = r32 * 128 + hi * 8, vl = lane * 32 + vt * 2048;
    constexpr int DEPTH = 3;
    bf16x8 Gf[DEPTH][2][4]; u32x4 Dd[DEPTH][2][2];
#define SB_LOAD(SLOT, C) { const int so_ = (bh * 64 + (C)) * 8192; \
        _Pragma("unroll") for (int kt = 0; kt < 2; ++kt) { _Pragma("unroll") for (int qq = 0; qq < 4; ++qq) Gf[SLOT][kt][qq] = as_bf16x8(__builtin_amdgcn_raw_buffer_load_b128(rsG, lane * 16 + (kt * 4 + qq) * 1024, so_, 0)); \
            Dd[SLOT][kt][0] = __builtin_amdgcn_raw_buffer_load_b128(rsD, vl + kt * 4096, so_, 0); Dd[SLOT][kt][1] = __builtin_amdgcn_raw_buffer_load_b128(rsD, vl + kt * 4096 + 16, so_, 0); } }
#define SB_STEP(SLOT, C) { const int so = (bh * 64 + (C)) * 8192; bf16x8 Hf[2][2]; \
        _Pragma("unroll") for (int kt = 0; kt < 2; ++kt) { Hf[kt][0] = accfrag(H[kt], 0); Hf[kt][1] = accfrag(H[kt], 1); \
            if (!SB_NOSTORE) { bstore128(*reinterpret_cast<const u32x4*>(&Hf[kt][0]), rsH, vl + kt * 4096, so, 0); \
            bstore128(*reinterpret_cast<const u32x4*>(&Hf[kt][1]), rsH, vl + kt * 4096 + 16, so, 0); } } \
        _Pragma("unroll") for (int kt = 0; kt < 2; ++kt) { f32x16 N; \
            _Pragma("unroll") for (int i = 0; i < 4; ++i) { N[2 * i] = lo_f(Dd[SLOT][kt][0][i]); N[2 * i + 1] = hi_f(Dd[SLOT][kt][0][i]); N[8 + 2 * i] = lo_f(Dd[SLOT][kt][1][i]); N[8 + 2 * i + 1] = hi_f(Dd[SLOT][kt][1][i]); } \
            _Pragma("unroll") for (int c2 = 0; c2 < 2; ++c2) _Pragma("unroll") for (int q = 0; q < 2; ++q) N = MFMA32(Gf[SLOT][kt][2 * c2 + q], Hf[c2][q], N); \
            H[kt] = N; } }
    SB_LOAD(0, 0) SB_LOAD(1, 1)
    for (int c = 0; c < 63; c += 3) {
        SB_LOAD(2, c + 2) SB_STEP(0, c)
        SB_LOAD(0, c + 3) SB_STEP(1, c + 1)
        if (c + 4 < 64) SB_LOAD(1, c + 4)
        SB_STEP(2, c + 2)
    }
    SB_STEP(0, 63)
#undef SB_LOAD
#undef SB_STEP
}
__device__ __forceinline__ void scan_stageC(const Params& p, int task_, int lane, size_t yoff, unsigned char* wl) {
    const int task = __builtin_amdgcn_readfirstlane(task_);
    const int bh = task >> 6, c64 = task & 63, b = bh >> 3, hd = bh & 7, r32 = lane & 31, hi = lane >> 5;
    const unsigned char* Hg = p.ws + OFF_HST + (size_t)task * 8192 + lane * 32;
    bf16x8 Hf[2][2][2];
#pragma unroll
    for (int kt = 0; kt < 2; ++kt)
#pragma unroll
        for (int vt = 0; vt < 2; ++vt) { Hf[kt][vt][0] = *(const bf16x8*)(Hg + (kt * 2 + vt) * 2048); Hf[kt][vt][1] = *(const bf16x8*)(Hg + (kt * 2 + vt) * 2048 + 16); }
    const ScanRs R{mk_rsrc(p.ws + OFF_ABAR, 16u << 20), mk_rsrc(p.ws + OFF_BTIL, 16u << 20), mk_rsrc(p.ws + OFF_KTIL, 16u << 20), mk_rsrc(p.ws + OFF_RBAR, 16u << 20), mk_rsrc(p.ws + OFF_SV, 16u << 20)};
    const rsrc_t rsM = mk_rsrc(SCAN_TMP(p) + OFF_MCH, 8u << 20);
    const int vrow = r32 * 1024 + hi * 16, vrowp = r32 * 1024 + hi * 8, vcn = r32 * 2 + hi * 8192, vcp = r32 * 2 + hi * 4096;
#pragma unroll 1
    for (int u = 0; u < 2; ++u) {
        const size_t rb = ((size_t)(b * 4096 + c64 * 64 + 32 * u)) * 512 + hd * 64;
        const int sb = (int)(rb * 2);
        const int sub = (b * 4096 + c64 * 64) / 32 + u, msub = bh * 128 + c64 * 2 + u;
        scan_stage_tiles(wl, R, sb, lane);
        f32x16 xak, xrb, xrk; zero16(xak); zero16(xrb); zero16(xrk);
#ifdef VTEST_OWNM
        f32x16 xab_; zero16(xab_);
#endif
#pragma unroll
        for (int q = 0; q < 4; ++q) {
            const bf16x8 fa = lrow_nat(wl, 0, r32, hi, q), fr = rowfrag_nat(R.rbar, sb, vrow, q), fb = lrow_nat(wl, 1, r32, hi, q), fk = lrow_nat(wl, 2, r32, hi, q);
            xak = MFMA32(fk, fa, xak); xrb = MFMA32(fb, fr, xrb); xrk = MFMA32(fk, fr, xrk);
#ifdef VTEST_OWNM
            xab_ = MFMA32(fb, fa, xab_);
#endif
        }
#pragma unroll
        for (int r = 0; r < 16; ++r) { const int sr = crow(r, hi); xak[r] = sr < r32 ? xak[r] : 0.f; xrb[r] = sr <= r32 ? xrb[r] : 0.f; xrk[r] = sr <= r32 ? xrk[r] : 0.f; }
#if defined(VTEST_OWNM)
#pragma unroll
        for (int r = 0; r < 16; ++r) xab_[r] = crow(r, hi) < r32 ? xab_[r] : 0.f;
        float m_[32];
        tri_inverse_rows(xab_, r32, m_);
        const bf16x8 mn0 = mfrag(m_, 0, hi, false), mn1 = mfrag(m_, 1, hi, false), mp0 = mfrag(m_, 0, hi, true), mp1 = mfrag(m_, 1, hi, true);
#elif defined(VTEST_MI)
        bf16x8 mn0, mn1, mp0, mp1;
#pragma unroll
        for (int e = 0; e < 8; ++e) { mn0[e] = (8 * hi + e == r32) ? 0x3F80 : 0; mn1[e] = (16 + 8 * hi + e == r32) ? 0x3F80 : 0;
            mp0[e] = (8 * (e >> 2) + 4 * hi + (e & 3) == r32) ? 0x3F80 : 0; mp1[e] = (16 + 8 * (e >> 2) + 4 * hi + (e & 3) == r32) ? 0x3F80 : 0; }
#else
        const bf16x8 mn0 = rowfrag_nat(rsM, msub * 2048, r32 * 64 + hi * 16, 0), mn1 = rowfrag_nat(rsM, msub * 2048, r32 * 64 + hi * 16, 1), mp0 = rowfrag_perm(rsM, msub * 2048, r32 * 64 + hi * 8, 0), mp1 = rowfrag_perm(rsM, msub * 2048, r32 * 64 + hi * 8, 1);
#endif
        bf16x8 PTf[2][2];
#pragma unroll
        for (int kt = 0; kt < 2; ++kt) { f32x16 T; zero16(T);
            T = MFMA32(lcol<false>(wl, 0, r32 + 32 * kt, hi, 0), mn0, T); T = MFMA32(lcol<false>(wl, 0, r32 + 32 * kt, hi, 1), mn1, T);
            PTf[kt][0] = accfrag(T, 0); PTf[kt][1] = accfrag(T, 1); }
        const bf16x8 ak0 = accfrag(xak, 0), ak1 = accfrag(xak, 1), rb0 = accfrag(xrb, 0), rb1 = accfrag(xrb, 1), rk0 = accfrag(xrk, 0), rk1 = accfrag(xrk, 1);
        bf16x8 Uf[2][2];
#pragma unroll
        for (int vt = 0; vt < 2; ++vt) {
        __builtin_amdgcn_sched_barrier(0);
            const bf16x8 vp0 = lcol<true>(wl, 3, r32 + 32 * vt, hi, 0), vp1 = lcol<true>(wl, 3, r32 + 32 * vt, hi, 1);
            f32x16 W; zero16(W);
            W = MFMA32(ak0, vp0, W); W = MFMA32(ak1, vp1, W);
            f32x16 U; zero16(U);
            U = MFMA32(mp0, accfrag(W, 0), U); U = MFMA32(mp1, accfrag(W, 1), U);
#pragma unroll
            for (int kt = 0; kt < 2; ++kt) { U = MFMA32(PTf[kt][0], Hf[kt][vt][0], U); U = MFMA32(PTf[kt][1], Hf[kt][vt][1], U); }
#pragma unroll
            for (int r = 0; r < 16; ++r) U[r] = -U[r];
            Uf[vt][0] = accfrag(U, 0); Uf[vt][1] = accfrag(U, 1);
            f32x16 Y; zero16(Y);
#pragma unroll
            for (int kt = 0; kt < 2; ++kt) { Y = MFMA32(rowfrag_perm(R.rbar, sb, vrowp, 2 * kt), Hf[kt][vt][0], Y); Y = MFMA32(rowfrag_perm(R.rbar, sb, vrowp, 2 * kt + 1), Hf[kt][vt][1], Y); }
#ifndef VTEST_NOU
            Y = MFMA32(rb0, Uf[vt][0], Y); Y = MFMA32(rb1, Uf[vt][1], Y);
#endif
            Y = MFMA32(rk0, vp0, Y); Y = MFMA32(rk1, vp1, Y);
            bf16_t* yo = (bf16_t*)(p.ws + yoff) + rb + 32 * vt + r32;
#pragma unroll
#ifdef VTEST_YU
            for (int r = 0; r < 16; ++r) Y[r] = U[r];
#pragma unroll
#endif
#ifdef SCAN_VERIFY
            for (int r = 0; r < 16; ++r) yo[(size_t)crow(r, hi) * 512] = f2bf(Y[r]);
#else
            for (int r = 0; r < 16; ++r) { (void)yo; *(unsigned short*)(wl + crow(r, hi) * 144 + (32 * vt + r32) * 2) = (unsigned short)f2bf(Y[r]); }
#endif
        }
#ifndef SCAN_VERIFY
        {
            __builtin_amdgcn_wave_barrier(); asm volatile("s_waitcnt lgkmcnt(0)" ::: "memory");
            const int ts = lane >> 4, cg = lane & 15, ch = hd * 64 + cg * 4;
            const f32x4 lw = *(const f32x4*)(p.in[23] + ch), lb = *(const f32x4*)(p.in[24] + ch);
            u32x2 gq[8]; float bq[8];
#pragma unroll
            for (int it = 0; it < 8; ++it) { const int tk = it * 4 + ts;
                gq[it] = *(const u32x2*)((const bf16_t*)(p.ws + OFF_SG) + rb + (size_t)tk * 512 + cg * 4);
                bq[it] = ((const float*)(p.ws + OFF_BONUS))[(size_t)(b * 4096 + c64 * 64 + 32 * u + tk) * 8 + hd]; }
#pragma unroll
            for (int it = 0; it < 8; ++it) {
                const int tk = it * 4 + ts; const size_t o = rb + (size_t)tk * 512 + cg * 4;
                const f32x4 y = bf4(*(const u32x2*)(wl + tk * 144 + cg * 8));
                const float mean = reduce16((y[0] + y[1]) + (y[2] + y[3])) * (1.f / 64.f);
                const f32x4 d = y - mean;
                const float var = reduce16((d[0] * d[0] + d[1] * d[1]) + (d[2] * d[2] + d[3] * d[3])) * (1.f / 64.f);
                const float rs = rsqrtf(var + 64e-5f);
                const f32x4 vv = bf4(*(const u32x2*)(wl + 3 * 4608 + tk * 144 + cg * 8));
                const float bonus = bq[it];
                const f32x4 yn = d * rs * lw + lb + vv * bonus;
                const f32x4 g = bf4(gq[it]);
                *(u32x2*)((bf16_t*)(p.ws + OFF_YG) + o) = pk4(yn * g);
            }
        }
#endif
        if (u == 0) {
            const float* gc = (const float*)(p.ws + OFF_GC) + (size_t)sub * 512 + hd * 64;
#pragma unroll
            for (int kt = 0; kt < 2; ++kt) {
        __builtin_amdgcn_sched_barrier(0);
                const bf16x8 bt0 = lcol<true>(wl, 1, r32 + 32 * kt, hi, 0), bt1 = lcol<true>(wl, 1, r32 + 32 * kt, hi, 1);
                const bf16x8 kn0 = lcol<false>(wl, 2, r32 + 32 * kt, hi, 0), kn1 = lcol<false>(wl, 2, r32 + 32 * kt, hi, 1);
#pragma unroll
                for (int vt = 0; vt < 2; ++vt) {
        __builtin_amdgcn_sched_barrier(0);
                    const u32x4 h0 = *reinterpret_cast<const u32x4*>(&Hf[kt][vt][0]), h1 = *reinterpret_cast<const u32x4*>(&Hf[kt][vt][1]);
                    f32x16 N;
#pragma unroll
                    for (int i = 0; i < 4; ++i) { N[2 * i] = lo_f(h0[i]); N[2 * i + 1] = hi_f(h0[i]); N[8 + 2 * i] = lo_f(h1[i]); N[8 + 2 * i + 1] = hi_f(h1[i]); }
                    N = MFMA32(bt0, Uf[vt][0], N); N = MFMA32(bt1, Uf[vt][1], N);
                    N = MFMA32(kn0, lcol<false>(wl, 3, r32 + 32 * vt, hi, 0), N); N = MFMA32(kn1, lcol<false>(wl, 3, r32 + 32 * vt, hi, 1), N);
                    scale_rows(N, gc + 32 * kt, hi);
                    Hf[kt][vt][0] = accfrag(N, 0); Hf[kt][vt][1] = accfrag(N, 1);
                }
            }
        }
    }
}


__device__ __forceinline__ void p4_rwkv_prep_chunked(const Params& p) {
    const int lane = otid() & 63, gw = blockIdx.x * 8 + (otid() >> 6), nw = gridDim.x * 8, ts = lane >> 4, cg = lane & 15;
    const bf16_t* P = (const bf16_t*)(p.ws + OFF_P);
    for (int task = gw; task < (T_TOK / 32) * 8; task += nw) {
        const int sub = task >> 3, hd = task & 7, ch = hd * 64 + cg * 4;
        f32x4 carry = {0.f, 0.f, 0.f, 0.f};
        for (int g = 0; g < 8; ++g) {
            const int t = sub * 32 + g * 4 + ts;
            const bf16_t* row = P + (size_t)t * NPA;
            const bool first = (t & 4095) == 0;
            const f32x4 r0 = bf4(*(const u32x2*)(row + C_R + ch)), k0 = bf4(*(const u32x2*)(row + C_K + ch)), v0 = bf4(*(const u32x2*)(row + C_V + ch));
            f32x4 rp = {0.f, 0.f, 0.f, 0.f}, kp = rp, vp = rp;
            if (!first) { rp = bf4(*(const u32x2*)(row + C_R + ch - NPA)); kp = bf4(*(const u32x2*)(row + C_K + ch - NPA)); vp = bf4(*(const u32x2*)(row + C_V + ch - NPA)); }
            const float* mu = p.in[7];
            const f32x4 r = r0 + (rp - r0) * *(const f32x4*)(mu + ch), k = k0 + (kp - k0) * *(const f32x4*)(mu + 512 + ch), v = v0 + (vp - v0) * *(const f32x4*)(mu + 1024 + ch);
            const size_t o = (size_t)t * 512 + ch;
            const f32x4 dec = *(const f32x4*)(p.in[16] + ch) + bf4(*(const u32x2*)((const bf16_t*)(p.ws + OFF_SE) + o));
            const f32x4 apre = *(const f32x4*)(p.in[18] + ch) + bf4(*(const u32x2*)((const bf16_t*)(p.ws + OFF_SB) + o));
            const f32x4 kkw = *(const f32x4*)(p.in[20] + ch), kaw = *(const f32x4*)(p.in[21] + ch), rkw = *(const f32x4*)(p.in[22] + ch);
            f32x4 e, a, kkr, kh;
            float n2 = 0.f, bn = 0.f;
#pragma unroll
            for (int i = 0; i < 4; ++i) {
                const float nd = -dec[i], sp = fmaxf(nd, 0.f) + __logf(1.f + __expf(-fabsf(nd)));
                e[i] = __expf(-sp - 0.5f);
                a[i] = sigmoidf_(apre[i]);
                kkr[i] = k[i] * kkw[i]; n2 += kkr[i] * kkr[i];
                kh[i] = k[i] * (1.f + (a[i] - 1.f) * kaw[i]);
                bn += r[i] * kh[i] * rkw[i];
            }
            n2 = reduce16(n2); bn = reduce16(bn);
            const f32x4 kk = kkr * __builtin_amdgcn_rsqf(fmaxf(n2, 1e-24f));
            f32x4 pe = e;
#pragma unroll
            for (int i = 0; i < 4; ++i) { const float u1 = __shfl_up(pe[i], 16); if (ts >= 1) pe[i] += u1; }
#pragma unroll
            for (int i = 0; i < 4; ++i) { const float u2 = __shfl_up(pe[i], 32); if (ts >= 2) pe[i] += u2; }
            const f32x4 cs = carry + pe, csm = cs - e;
#pragma unroll
            for (int i = 0; i < 4; ++i) carry[i] += __shfl(pe[i], 48 + cg);
            f32x4 gm, gi, gp;
#pragma unroll
            for (int i = 0; i < 4; ++i) { gm[i] = __expf(-cs[i]); gi[i] = __expf(cs[i]); gp[i] = __expf(-csm[i]); }
            *(u32x2*)((bf16_t*)(p.ws + OFF_ABAR) + o) = pk4(kk * gp); *(u32x2*)((bf16_t*)(p.ws + OFF_BTIL) + o) = pk4(kk * a * gi); *(u32x2*)((bf16_t*)(p.ws + OFF_KTIL) + o) = pk4(kh * gi);
            *(u32x2*)((bf16_t*)(p.ws + OFF_RBAR) + o) = pk4(r * gm); *(u32x2*)((bf16_t*)(p.ws + OFF_SV) + o) = pk4(v);
            if (cg == 0) ((float*)(p.ws + OFF_BONUS))[(size_t)t * 8 + hd] = bn;
            if (g == 7 && ts == 3) *(f32x4*)((float*)(p.ws + OFF_GC) + (size_t)sub * 512 + ch) = gm;
        }
    }
}
__device__ __forceinline__ void p4c_tile2(const Params& p, int sub, int hd0, int lane, const unsigned char* decp, const unsigned char* aprp) {
    const int ts = lane >> 4, cg = lane & 15;
    const bf16_t* P = (const bf16_t*)(p.ws + OFF_P);
    const float* mu = p.in[7];
    f32x4 mur[2], muk[2], muv[2], decb[2], aaab[2], kkw[2], kaw[2], rkw[2], carry[2];
#pragma unroll
    for (int h = 0; h < 2; ++h) { const int ch = (hd0 + h) * 64 + cg * 4;
        mur[h] = *(const f32x4*)(mu + ch); muk[h] = *(const f32x4*)(mu + 512 + ch); muv[h] = *(const f32x4*)(mu + 1024 + ch);
        decb[h] = *(const f32x4*)(p.in[16] + ch); aaab[h] = *(const f32x4*)(p.in[18] + ch);
        kkw[h] = *(const f32x4*)(p.in[20] + ch); kaw[h] = *(const f32x4*)(p.in[21] + ch); rkw[h] = *(const f32x4*)(p.in[22] + ch); carry[h] = (f32x4){0.f, 0.f, 0.f, 0.f}; }
    u32x2 in_[2][6], nx_[2][6];
    auto fetch = [&](int g, u32x2 (&d)[2][6]) {
        const int t = sub * 32 + g * 4 + ts; const bf16_t* row = P + (size_t)t * NPA; const int po = ((t & 4095) == 0) ? 0 : NPA;
#pragma unroll
        for (int h = 0; h < 2; ++h) { const int ch = (hd0 + h) * 64 + cg * 4;
            d[h][0] = *(const u32x2*)(row + C_R + ch); d[h][1] = *(const u32x2*)(row + C_K + ch); d[h][2] = *(const u32x2*)(row + C_V + ch);
            d[h][3] = *(const u32x2*)(row + C_R + ch - po); d[h][4] = *(const u32x2*)(row + C_K + ch - po); d[h][5] = *(const u32x2*)(row + C_V + ch - po); }
    };
    fetch(0, in_);
#pragma unroll 1
    for (int g = 0; g < 8; ++g) {
        const int t = sub * 32 + g * 4 + ts;
        const bool first = (t & 4095) == 0;
        fetch(g < 7 ? g + 1 : 7, nx_);
#pragma unroll
        for (int h = 0; h < 2; ++h) {
            const int hd = hd0 + h, ch = hd * 64 + cg * 4;
            const f32x4 r0 = bf4(in_[h][0]), k0 = bf4(in_[h][1]), v0 = bf4(in_[h][2]);
            f32x4 rp = bf4(in_[h][3]), kp = bf4(in_[h][4]), vp = bf4(in_[h][5]);
            if (first) { rp = (f32x4){0.f, 0.f, 0.f, 0.f}; kp = rp; vp = rp; }
            const f32x4 r = r0 + (rp - r0) * mur[h], k = k0 + (kp - k0) * muk[h], v = v0 + (vp - v0) * muv[h];
            const size_t o = (size_t)t * 512 + ch;
            const f32x4 dec = decb[h] + bf4(*(const u32x2*)(decp + (g * 4 + ts) * 272 + h * 128 + cg * 8));
            const f32x4 apre = aaab[h] + bf4(*(const u32x2*)(aprp + (g * 4 + ts) * 272 + h * 128 + cg * 8));
            f32x4 e, a, kkr, kh;
            float n2 = 0.f, bn = 0.f;
#pragma unroll
            for (int i = 0; i < 4; ++i) {
                const float nd = -dec[i], sp = fmaxf(nd, 0.f) + __logf(1.f + __expf(-fabsf(nd)));
                e[i] = __expf(-sp - 0.5f);
                a[i] = sigmoidf_(apre[i]);
                kkr[i] = k[i] * kkw[h][i]; n2 += kkr[i] * kkr[i];
                kh[i] = k[i] * (1.f + (a[i] - 1.f) * kaw[h][i]);
                bn += r[i] * kh[i] * rkw[h][i];
            }
            n2 = reduce16(n2); bn = reduce16(bn);
            const f32x4 kk = kkr * __builtin_amdgcn_rsqf(fmaxf(n2, 1e-24f));
            f32x4 pe = e;
#pragma unroll
            for (int i = 0; i < 4; ++i) { const float u1 = __shfl_up(pe[i], 16); if (ts >= 1) pe[i] += u1; }
#pragma unroll
            for (int i = 0; i < 4; ++i) { const float u2 = __shfl_up(pe[i], 32); if (ts >= 2) pe[i] += u2; }
            const f32x4 cs = carry[h] + pe, csm = cs - e;
#pragma unroll
            for (int i = 0; i < 4; ++i) carry[h][i] += __shfl(pe[i], 48 + cg);
            f32x4 gm, gi, gp;
#pragma unroll
            for (int i = 0; i < 4; ++i) { gm[i] = __expf(-cs[i]); gi[i] = __expf(cs[i]); gp[i] = __expf(-csm[i]); }
            *(u32x2*)((bf16_t*)(p.ws + OFF_ABAR) + o) = pk4(kk * gp); *(u32x2*)((bf16_t*)(p.ws + OFF_BTIL) + o) = pk4(kk * a * gi); *(u32x2*)((bf16_t*)(p.ws + OFF_KTIL) + o) = pk4(kh * gi);
            *(u32x2*)((bf16_t*)(p.ws + OFF_RBAR) + o) = pk4(r * gm); *(u32x2*)((bf16_t*)(p.ws + OFF_SV) + o) = pk4(v);
            if (cg == 0) ((float*)(p.ws + OFF_BONUS))[(size_t)t * 8 + hd] = bn;
            if (g == 7 && ts == 3) *(f32x4*)((float*)(p.ws + OFF_GC) + (size_t)sub * 512 + ch) = gm;
        }
#pragma unroll
        for (int h = 0; h < 2; ++h)
#pragma unroll
            for (int i = 0; i < 6; ++i) in_[h][i] = nx_[h][i];
    }
}
__device__ __forceinline__ void p5c_epilogue_chunked(const Params& p) {
    const int lane = otid() & 63, gw = blockIdx.x * 8 + (otid() >> 6), nw = gridDim.x * 8, ts = lane >> 4, cg = lane & 15;
    for (int task = gw; task < (T_TOK / 4) * 8; task += nw) {
        const int t = (task >> 3) * 4 + ts, hd = task & 7, ch = hd * 64 + cg * 4;
        const size_t o = (size_t)t * 512 + ch;
        const f32x4 y = bf4(*(const u32x2*)((const bf16_t*)(p.ws + OFF_YCH) + o));
        const float mean = reduce16((y[0] + y[1]) + (y[2] + y[3])) * (1.f / 64.f);
        const f32x4 d = y - mean;
        const float var = reduce16((d[0] * d[0] + d[1] * d[1]) + (d[2] * d[2] + d[3] * d[3])) * (1.f / 64.f);
        const float rs = rsqrtf(var + 64e-5f);
        const f32x4 vv = bf4(*(const u32x2*)((const bf16_t*)(p.ws + OFF_SV) + o));
        const float bonus = ((const float*)(p.ws + OFF_BONUS))[(size_t)t * 8 + hd];
        const f32x4 yn = d * rs * *(const f32x4*)(p.in[23] + ch) + *(const f32x4*)(p.in[24] + ch) + vv * bonus;
        const f32x4 g = bf4(*(const u32x2*)((const bf16_t*)(p.ws + OFF_SG) + o));
        *(u32x2*)((bf16_t*)(p.ws + OFF_YG) + o) = pk4(yn * g);
    }
}
__device__ __forceinline__ void p5_stageA(const Params& p, unsigned char* lds) { const int lane = otid() & 63, wid = otid() >> 6, gw = blockIdx.x * 8 + wid, nw = gridDim.x * 8; for (int task = gw; task < 2048; task += nw) scan_stageA(p, task, lane, lds + wid * 18432); }
__device__ __forceinline__ void p5_stageA_local(const Params& p, unsigned char* lds, const XcdBarrier& xb) {
    const int lane = otid() & 63, wid = otid() >> 6;
    if (gridDim.x == 256) {
        asm volatile("s_waitcnt vmcnt(0)" ::: "memory");
        __syncthreads();
        scan_stageA(p, (((int)blockIdx.x >> 6) * 8 + wid) * 64 + ((int)blockIdx.x & 63), lane, lds + wid * 18432);
    } else { xcd_barrier(xb); p5_stageA(p, lds); }
}
__device__ __forceinline__ void p5_stageC(const Params& p, unsigned char* lds) { const int lane = otid() & 63, wid = otid() >> 6, gw = blockIdx.x * 8 + wid, nw = gridDim.x * 8; for (int task = gw; task < 2048; task += nw) scan_stageC(p, task, lane, OFF_YCH, lds + wid * 18432); }
__device__ __forceinline__ void p5_stageB(const Params& p) { const int lane = otid() & 63, wid = otid() >> 6; if (wid < 2 && blockIdx.x < 32) scan_stageB(p, blockIdx.x * 2 + wid, lane); }

#ifdef VTEST_NAIVE
__device__ __forceinline__ void scan_naive0(const Params& p, int bh, int lane) {
    const int b = bh >> 3, hd = bh & 7;
    const bf16_t* ABAR = (const bf16_t*)(p.ws + OFF_ABAR); const bf16_t* BTIL = (const bf16_t*)(p.ws + OFF_BTIL); const bf16_t* KTIL = (const bf16_t*)(p.ws + OFF_KTIL);
    const bf16_t* RBAR = (const bf16_t*)(p.ws + OFF_RBAR); const bf16_t* SV = (const bf16_t*)(p.ws + OFF_SV);
    float H[64];
#pragma unroll
    for (int k = 0; k < 64; ++k) H[k] = 0.f;
    for (int t = 0; t < 32; ++t) {
        const size_t ro = ((size_t)(b * 4096 + t)) * 512 + hd * 64;
        const float vv = bf2f(SV[ro + lane]);
        float u = 0.f;
#pragma unroll
        for (int k = 0; k < 64; ++k) u -= bf2f(ABAR[ro + k]) * H[k];
        const float u_keep = u;
#ifdef VTEST_MI
        u = 0.f;
#endif
        float y = 0.f;
#ifdef VTEST_NOU
        u = 0.f;
#endif
#pragma unroll
        for (int k = 0; k < 64; ++k) { H[k] += bf2f(BTIL[ro + k]) * u + bf2f(KTIL[ro + k]) * vv; y += bf2f(RBAR[ro + k]) * H[k]; }
#ifdef VTEST_YU
        y = u_keep;
#endif
#if VTEST_NAIVE == 2
        YRAW_PTR(p)[ro + lane] = f2bf(y);
#else
        ((bf16_t*)(p.ws + OFF_YCH))[ro + lane] = f2bf(y);
#endif
    }
}
#endif
#ifdef SCAN_VERIFY
__device__ __forceinline__ void scan_compare(const Params& p) {
    float sd = 0.f, sr = 0.f;
    const bf16_t* A = (const bf16_t*)((const unsigned char*)p.out + 0); const bf16_t* B = (const bf16_t*)(p.ws + OFF_YCH);
    for (size_t i = (size_t)blockIdx.x * NTHREADS + otid(); i < (size_t)T_TOK * 512; i += (size_t)gridDim.x * NTHREADS) { const int spos = (int)((i >> 9) & 4095);
#ifdef VSEL_LO
        if (spos < VSEL_LO || spos >= VSEL_HI) continue;
#endif
        const float a = bf2f(A[i]), b = bf2f(B[i]); sd += (a - b) * (a - b); sr += a * a; }
    sd = wave_sum(sd); sr = wave_sum(sr);
    if ((otid() & 63) == 0) { atomicAdd((float*)(p.ws + OFF_CTR) + 8, sd); atomicAdd((float*)(p.ws + OFF_CTR) + 9, sr); }
    unsigned mask = 0;
    auto scan16 = [&](const bf16_t* X, size_t n, unsigned bit) { for (size_t i = (size_t)blockIdx.x * NTHREADS + otid(); i < n; i += (size_t)gridDim.x * NTHREADS) if ((X[i] & 0x7F80u) == 0x7F80u) mask |= bit; };
    scan16((const bf16_t*)(SCAN_TMP(p) + OFF_MCH), (size_t)4096 * 1024, 1u); scan16((const bf16_t*)(SCAN_TMP(p) + OFF_GCH), (size_t)2048 * 4096, 2u);
    scan16((const bf16_t*)(SCAN_TMP(p) + OFF_DCH), (size_t)2048 * 4096, 4u); scan16((const bf16_t*)(p.ws + OFF_HST), (size_t)2048 * 4096, 8u);
    scan16(B, (size_t)T_TOK * 512, 16u); scan16(A, (size_t)T_TOK * 512, 32u);
    scan16((const bf16_t*)(p.ws + OFF_ABAR), (size_t)T_TOK * 512, 64u); scan16((const bf16_t*)(p.ws + OFF_BTIL), (size_t)T_TOK * 512, 64u); scan16((const bf16_t*)(p.ws + OFF_KTIL), (size_t)T_TOK * 512, 64u); scan16((const bf16_t*)(p.ws + OFF_RBAR), (size_t)T_TOK * 512, 64u);
    if (mask) atomicOr((unsigned*)(p.ws + OFF_CTR) + 10, mask);
}
#endif

__device__ __forceinline__ void p5b_scan_epilogue(const Params& p) {
    const int lane = otid() & 63, gw = blockIdx.x * 8 + (otid() >> 6), nw = gridDim.x * 8, ts = lane >> 4, cg = lane & 15;
    for (int task = gw; task < (T_TOK / 4) * 8; task += nw) {
        const int t = (task >> 3) * 4 + ts, hd = task & 7, ch = hd * 64 + cg * 4;
        const size_t o = (size_t)t * 512 + ch;
        const f32x4 y = bf4(*(const u32x2*)((const bf16_t*)(p.ws + OFF_YRAW) + o));
        const float mean = reduce16((y[0] + y[1]) + (y[2] + y[3])) * (1.f / 64.f);
        const f32x4 d = y - mean;
        const float var = reduce16((d[0] * d[0] + d[1] * d[1]) + (d[2] * d[2] + d[3] * d[3])) * (1.f / 64.f);
        const float rs = rsqrtf(var + 64e-5f);
        const f32x4 rr = bf4(*(const u32x2*)((const bf16_t*)(p.ws + OFF_SR) + o)), kh = bf4(*(const u32x2*)((const bf16_t*)(p.ws + OFF_SKH) + o)), vv = bf4(*(const u32x2*)((const bf16_t*)(p.ws + OFF_SV) + o));
        const f32x4 rk = *(const f32x4*)(p.in[22] + ch), pr = rr * kh * rk;
        const float bonus = reduce16((pr[0] + pr[1]) + (pr[2] + pr[3]));
        const f32x4 yn = d * rs * *(const f32x4*)(p.in[23] + ch) + *(const f32x4*)(p.in[24] + ch) + vv * bonus;
        const f32x4 g = bf4(*(const u32x2*)((const bf16_t*)(p.ws + OFF_SG) + o));
        *(u32x2*)((bf16_t*)(p.ws + OFF_YG) + o) = pk4(yn * g);
    }
}
constexpr int AT_KLD = 208, AT_VLD = 144, AT_KBYTES = 64 * AT_KLD, AT_VBYTES = 64 * AT_VLD, AT_STAGE = AT_KBYTES + AT_VBYTES;
__device__ __forceinline__ void attn_item(const Params& p, int bh, int qb, unsigned char* lds) {
    const int b = bh >> 3, hd = bh & 7, tid = otid(), lane = tid & 63, wid = tid >> 6, r32 = lane & 31, hi = lane >> 5;
    const int qloc = wid * 32 + r32;
    const bf16_t* Q = (const bf16_t*)((const unsigned char*)p.out + DO_Q) + ((size_t)(b * 4096 + qb * 256 + qloc)) * 768 + hd * 96 + hi * 8;
    const bf16_t* Kg = (const bf16_t*)((const unsigned char*)p.out + DO_K) + ((size_t)(b * 4096)) * 768 + hd * 96;
    const bf16_t* Vg = (const bf16_t*)((const unsigned char*)p.out + DO_VT) + ((size_t)(b * 8 + hd) * 64) * 4096;
    bf16x8 qf[6];
#pragma unroll
    for (int s = 0; s < 6; ++s) qf[s] = *(const bf16x8*)(Q + s * 16);
    f32x16 o0, o1;
#pragma unroll
    for (int r = 0; r < 16; ++r) { o0[r] = 0.f; o1[r] = 0.f; }
    float l = 0.f;
    const int nkt = 4 * qb + 4, mylast = 4 * qb + (wid >> 1);
    u32x4 stA[3], stB[3];
    auto gload = [&](int ktK, int ktV, u32x4 (&st)[3]) {
#pragma unroll
        for (int i = 0; i < 3; ++i) { const int c = tid + NTHREADS * i;
            if (c < 768) { if (ktK < nkt) { const int row = c / 12, cc = c - row * 12; st[i] = *(const u32x4*)(Kg + (size_t)(ktK * 64 + row) * 768 + cc * 8); } }
            else if (c < 1280) { if (ktV < nkt) { const int c2 = c - 768, dv = c2 >> 3, kc = c2 & 7; st[i] = *(const u32x4*)(Vg + (size_t)dv * 4096 + ktV * 64 + kc * 8); } } }
    };
    auto swrite = [&](int ktK, int ktV, const u32x4 (&st)[3]) {
#pragma unroll
        for (int i = 0; i < 3; ++i) { const int c = tid + NTHREADS * i;
            if (c < 768) { if (ktK < nkt) { const int row = c / 12, cc = c - row * 12; *(u32x4*)(lds + (ktK & 1) * AT_STAGE + row * AT_KLD + cc * 16) = st[i]; } }
            else if (c < 1280) { if (ktV < nkt) { const int c2 = c - 768, dv = c2 >> 3, kc = c2 & 7; *(u32x4*)(lds + (ktV & 1) * AT_STAGE + AT_KBYTES + dv * AT_VLD + kc * 16) = st[i]; } } }
    };
    auto qk = [&](int kt, f32x16& a0, f32x16& a1) {
        const unsigned char* sk = lds + (kt & 1) * AT_STAGE + r32 * AT_KLD + hi * 16;
        bf16x8 kf[12];
#pragma unroll
        for (int s = 0; s < 6; ++s) { kf[2 * s] = *(const bf16x8*)(sk + s * 32); kf[2 * s + 1] = *(const bf16x8*)(sk + 32 * AT_KLD + s * 32); }
        __builtin_amdgcn_sched_barrier(0);
#pragma unroll
        for (int r = 0; r < 16; ++r) { a0[r] = 0.f; a1[r] = 0.f; }
#pragma unroll
        for (int s = 0; s < 6; ++s) { a0 = MFMA32(kf[2 * s], qf[s], a0); a1 = MFMA32(kf[2 * s + 1], qf[s], a1); }
    };
    auto body = [&](int kt, f32x16& c0, f32x16& c1, f32x16& x0, f32x16& x1, const u32x4 (&stW)[3], u32x4 (&stL)[3]) {
        gload(kt + 3, kt + 2, stL);
        if (kt + 1 <= mylast) qk(kt + 1, x0, x1);
        if (kt <= mylast) {
            const unsigned char* sv = lds + (kt & 1) * AT_STAGE + AT_KBYTES + r32 * AT_VLD + hi * 16;
            bf16x8 vf[8];
#pragma unroll
            for (int ks = 0; ks < 4; ++ks) { vf[2 * ks] = *(const bf16x8*)(sv + ks * 32); vf[2 * ks + 1] = *(const bf16x8*)(sv + 32 * AT_VLD + ks * 32); }
            __builtin_amdgcn_sched_barrier(0);
            if (kt == mylast) {
                const int kbase = (kt - 4 * qb) * 64;
#pragma unroll
                for (int r = 0; r < 16; ++r) { if (kbase + crow(r, hi) > qloc) c0[r] = -1e30f; if (kbase + 32 + crow(r, hi) > qloc) c1[r] = -1e30f; }
            }
            float ps = 0.f;
#pragma unroll
            for (int r = 0; r < 16; ++r) { c0[r] = __builtin_amdgcn_exp2f(c0[r]); c1[r] = __builtin_amdgcn_exp2f(c1[r]); ps += c0[r] + c1[r]; }
            l += ps;
            u32x4 pw[4];
#pragma unroll
            for (int q = 0; q < 2; ++q) {
                pw[q].x = pk2(c0[8 * q + 0], c0[8 * q + 1]); pw[q].y = pk2(c0[8 * q + 2], c0[8 * q + 3]); pw[q].z = pk2(c0[8 * q + 4], c0[8 * q + 5]); pw[q].w = pk2(c0[8 * q + 6], c0[8 * q + 7]);
                pw[2 + q].x = pk2(c1[8 * q + 0], c1[8 * q + 1]); pw[2 + q].y = pk2(c1[8 * q + 2], c1[8 * q + 3]); pw[2 + q].z = pk2(c1[8 * q + 4], c1[8 * q + 5]); pw[2 + q].w = pk2(c1[8 * q + 6], c1[8 * q + 7]);
            }
#pragma unroll
            for (int ks = 0; ks < 4; ++ks) { o0 = MFMA32(vf[2 * ks], as_bf16x8(pw[ks]), o0); o1 = MFMA32(vf[2 * ks + 1], as_bf16x8(pw[ks]), o1); }
        }
        swrite(kt + 2, kt + 1, stW);
        __syncthreads();
    };
    __syncthreads();
    gload(0, 0, stA); gload(1, nkt, stB);
    swrite(0, 0, stA); swrite(1, nkt, stB);
    gload(2, 1, stB);
    __syncthreads();
    f32x16 sa0, sa1, sb0, sb1;
    qk(0, sa0, sa1);
#pragma unroll 1
    for (int kt = 0; kt < nkt; kt += 2) { body(kt, sa0, sa1, sb0, sb1, stB, stA); body(kt + 1, sb0, sb1, sa0, sa1, stA, stB); }
    l = xhalf_sum(l);
    const float il = 1.f / l;
    bf16_t* O = (bf16_t*)(p.ws + OFF_OMLA) + ((size_t)(b * 4096 + qb * 256 + qloc)) * 512 + hd * 64 + 4 * hi;
#pragma unroll
    for (int rq = 0; rq < 4; ++rq) {
        u32x2 w0, w1;
        w0.x = pk2(o0[rq * 4 + 0] * il, o0[rq * 4 + 1] * il); w0.y = pk2(o0[rq * 4 + 2] * il, o0[rq * 4 + 3] * il);
        w1.x = pk2(o1[rq * 4 + 0] * il, o1[rq * 4 + 1] * il); w1.y = pk2(o1[rq * 4 + 2] * il, o1[rq * 4 + 3] * il);
        *(u32x2*)(O + 8 * rq) = w0; *(u32x2*)(O + 32 + 8 * rq) = w1;
    }
}
__device__ __forceinline__ void p5_attn_scan(const Params& p, unsigned char* lds) {
#ifdef CHUNKED
    p5_stageB(p);
#elif !defined(SKIP_SCAN)
    if (blockIdx.x < 128) scan_task(p, blockIdx.x, lds);
#endif
#ifdef SKIP_ATTN
    return;
#endif
    unsigned* ctr = (unsigned*)(p.ws + OFF_CTR);
    unsigned* slot = (unsigned*)(lds + 2 * AT_STAGE);
    for (;;) {
        __syncthreads();
        if (otid() == 0) *slot = atomicAdd(ctr, 1u);
        __syncthreads();
        const unsigned n = *slot;
        if (n >= 512u) break;
        attn_item(p, n & 31, 15 - (n >> 5), lds);
    }
}

__device__ __forceinline__ void p6_merge(const Params& p, PG8_LAS unsigned char* ldsl) {
    static_assert(OFF_YG == OFF_OMLA + (size_t)64 * 256 * 512 * 2 && OFF_WORWKV == OFF_WOMLA + (size_t)4 * 256 * 512 * 2, "chained second operand pair = unit (pm + 64, pn + 4)");
    pg8::ChainOrder S; S.S.init(T_TOK, 1024, gridDim.x, blockIdx.x);
    const pg8::Gemm g{(const bf16_t*)(p.ws + OFF_OMLA), (const bf16_t*)(p.ws + OFF_WOMLA), T_TOK, 1024, 512};
    const pg8::EpiMergeChain E{(bf16_t*)(p.ws + OFF_MERGED), p.ws + OFF_G8};
    pg8::gemm_phase(ldsl, g, S, E);
}
__device__ __forceinline__ void p7_mix(const Params& p, PG8_LAS unsigned char* ldsl) {
    pg8::StaticOrder S; S.init(T_TOK, 1024, gridDim.x, blockIdx.x);
    const pg8::Gemm g{(const bf16_t*)(p.ws + OFF_MERGED), (const bf16_t*)(p.ws + OFF_WOUT), T_TOK, 1024, 1024};
    const pg8::EpiMix E{p.in[0], (bf16_t*)(p.ws + OFF_X1), (const float*)(p.ws + OFF_MOD)};
    pg8::gemm_phase(ldsl, g, S, E);
}
constexpr size_t OFF_E8D = OFF_S + 32 * MiB, OFF_E8U = OFF_E8D + 16 * MiB, OFF_ESC = OFF_E8U + 16 * MiB;
__device__ __forceinline__ unsigned fp4_code(float y) {
    const float a = fabsf(y);
    const unsigned c = (unsigned)(a > 0.25f) + (unsigned)(a > 0.75f) + (unsigned)(a > 1.25f) + (unsigned)(a > 1.75f) + (unsigned)(a > 2.5f) + (unsigned)(a > 3.5f) + (unsigned)(a > 5.f);
    return c | ((__float_as_uint(y) >> 28) & 8u);
}
__device__ __forceinline__ void p8_cvt_experts(const Params& p) {
    const int lane = otid() & 63, gw = blockIdx.x * 8 + (otid() >> 6), nw = gridDim.x * 8;
    f32x4 v[4], vn[4];
    {   const int which = gw >> 14, e = gw & 16383; const float* src = p.in[which ? 32 : 31] + (size_t)e * 1024 + lane * 16;
#pragma unroll
        for (int i = 0; i < 4; ++i) vn[i] = *(const f32x4*)(src + 4 * i); }
#pragma unroll 1
    for (int row = gw; row < 2 * 16384; row += nw) {
        const int which = row >> 14, e = row & 16383;
#pragma unroll
        for (int i = 0; i < 4; ++i) v[i] = vn[i];
        {   const int rn = (row + nw < 2 * 16384) ? row + nw : row; const int wn = rn >> 14, en = rn & 16383;
            const float* src = p.in[wn ? 32 : 31] + (size_t)en * 1024 + lane * 16;
#pragma unroll
            for (int i = 0; i < 4; ++i) vn[i] = *(const f32x4*)(src + 4 * i); }
        float am = 0.f;
#pragma unroll
        for (int i = 0; i < 4; ++i) am = fmaxf(am, fmaxf(fmaxf(fabsf(v[i][0]), fabsf(v[i][1])), fmaxf(fabsf(v[i][2]), fabsf(v[i][3]))));
#pragma unroll
        for (int o = 32; o; o >>= 1) am = fmaxf(am, __shfl_xor(am, o));
        am = fmaxf(am, 1e-30f);
        const float q = 6.f / am;
        u32x2 w = {0u, 0u};
#pragma unroll
        for (int i = 0; i < 4; ++i) {
            const unsigned nb = fp4_code(v[i][0] * q) | (fp4_code(v[i][1] * q) << 4) | (fp4_code(v[i][2] * q) << 8) | (fp4_code(v[i][3] * q) << 12);
            if (i < 2) w.x |= nb << (16 * i); else w.y |= nb << (16 * (i - 2));
        }
        *(u32x2*)(p.ws + (which ? OFF_E8U : OFF_E8D) + (size_t)e * 512 + lane * 8) = w;
        if (lane == 0) ((float*)(p.ws + OFF_ESC))[row] = am * (1.f / 6.f);
    }
}
__device__ __forceinline__ void p9_query(const Params& p, PG8_LAS unsigned char* ldsl) {
    pg8::StaticOrder S; S.init(T_TOK, 2048, gridDim.x, blockIdx.x);
    const pg8::Gemm g{(const bf16_t*)(p.ws + OFF_H), (const bf16_t*)(p.ws + OFF_WQRY), T_TOK, 2048, 1024};
    const pg8::EpiStoreBf16 E{(bf16_t*)((unsigned char*)p.out + DO_Q2), 2048};
    pg8::gemm_phase(ldsl, g, S, E);
}
__device__ constexpr int CAND_A[50] = {0,0,0,0,0,0,0,0,0,0,0,0,0,0,0,0, 1,1,1,1,1,1,1,1, 2,2,2,2,2, 3,3,3,3, 4,4,4, 5,5, 6,6, 7,7, 8, 9, 10, 11, 12, 13, 14, 15};
__device__ constexpr int CAND_B[50] = {0,1,2,3,4,5,6,7,8,9,10,11,12,13,14,15, 0,1,2,3,4,5,6,7, 0,1,2,3,4, 0,1,2,3, 0,1,2, 0,1, 0,1, 0,1, 0, 0, 0, 0, 0, 0, 0, 0};
__device__ __forceinline__ float knock(float v, float m, float neg) { float o; asm volatile("v_cmp_eq_f32 vcc, %1, %2\n\tv_cndmask_b32 %0, %1, %3, vcc" : "=v"(o) : "v"(v), "v"(m), "v"(neg) : "vcc"); return o; }
__device__ __forceinline__ void knock_sel(float& v, int& e, float m, float neg, int ce) { asm volatile("v_cmp_eq_f32 vcc, %0, %2\n\tv_cndmask_b32 %0, %0, %3, vcc\n\tv_cndmask_b32 %1, %1, %4, vcc" : "+v"(v), "+v"(e) : "v"(m), "v"(neg), "v"(ce) : "vcc"); }
__device__ __forceinline__ void ce_desc(float& a, float& b) { const float mx = __builtin_fmaxf(a, b), mn = __builtin_fminf(a, b); a = mx; b = mn; }
template <int OFF> __device__ __forceinline__ void sort16_desc(float (&v)[64]) {
#pragma unroll
    for (int k = 2; k <= 16; k <<= 1)
#pragma unroll
        for (int j = k >> 1; j > 0; j >>= 1)
#pragma unroll
            for (int i = 0; i < 16; ++i) { const int l = i ^ j; if (l > i) { if ((i & k) == 0) ce_desc(v[OFF + i], v[OFF + l]); else ce_desc(v[OFF + l], v[OFF + i]); } }
}
template <int A, int B> __device__ __forceinline__ void merge16_desc(float (&v)[64]) {
#pragma unroll
    for (int i = 0; i < 16; ++i) v[A + i] = __builtin_fmaxf(v[A + i], v[B + 15 - i]);
#pragma unroll
    for (int j = 8; j > 0; j >>= 1)
#pragma unroll
        for (int i = 0; i < 16; ++i) { const int l = i ^ j; if (l > i) ce_desc(v[A + i], v[A + l]); }
}
__device__ __forceinline__ void top16_of_64(float (&v)[64]) {
    sort16_desc<0>(v); sort16_desc<16>(v); sort16_desc<32>(v); sort16_desc<48>(v);
    merge16_desc<0, 16>(v); merge16_desc<32, 48>(v); merge16_desc<0, 32>(v);
}
template <int J>
__device__ __forceinline__ void p10_half(const Params& p, int t, int head, int r32, int hi, int lane, float* wl, const unsigned char* ksh, const bf16x8 (&bqv)[8]) {
    const unsigned char* krow = ksh + J * 34816 + r32 * 272 + hi * 16;
    f32x16 acc[4];
#pragma unroll
    for (int f = 0; f < 4; ++f)
#pragma unroll
        for (int r = 0; r < 16; ++r) acc[f][r] = 0.f;
#pragma unroll
    for (int s = 0; s < 8; ++s) {
        const bf16x8 bq = bqv[s];
#pragma unroll
        for (int f = 0; f < 4; ++f) { const bf16x8 ak = *(const bf16x8*)(krow + f * 32 * 272 + s * 32); acc[f] = MFMA32(ak, bq, acc[f]); }
    }
    float v[64];
#pragma unroll
    for (int f = 0; f < 4; ++f)
#pragma unroll
        for (int r = 0; r < 16; ++r) v[f * 16 + r] = __uint_as_float((__float_as_uint(acc[f][r]) & ~0x7Fu) | (unsigned)(f * 32 + (r & 3) + 8 * (r >> 2) + 4 * hi));
    top16_of_64(v);
#pragma unroll
    for (int i = 0; i < 16; ++i) v[16 + i] = __shfl_xor(v[i], 32);
    merge16_desc<0, 16>(v);
    float* res = wl + J * 1024;
#pragma unroll
    for (int i = 0; i < 16; ++i) res[i * 64 + lane] = v[i];
}
__device__ __forceinline__ void p10_task(const Params& p, int task, int lane, float* wl, const unsigned char* ksh) {
    const int head = task & 7, tile = task >> 3, r32 = lane & 31, hi = lane >> 5, t = tile * 32 + r32;
    const float NEG = -3.0e38f;
    bf16x8 bq0[8], bq1[8];
    {   const bf16_t* qrow = (const bf16_t*)((const unsigned char*)p.out + DO_Q2) + (size_t)t * 2048 + head * 256 + hi * 8;
#pragma unroll
        for (int s = 0; s < 8; ++s) { bq0[s] = *(const bf16x8*)(qrow + s * 16); bq1[s] = *(const bf16x8*)(qrow + 128 + s * 16); } }
    p10_half<0>(p, t, head, r32, hi, lane, wl, ksh, bq0);
    p10_half<1>(p, t, head, r32, hi, lane, wl, ksh, bq1);
    __builtin_amdgcn_wave_barrier(); asm volatile("s_waitcnt lgkmcnt(0)" ::: "memory");
    float tv0[16], tv1[16];
#pragma unroll
    for (int it = 0; it < 16; ++it) { tv0[it] = __uint_as_float(__float_as_uint(wl[it * 64 + lane]) & ~0x7Fu); tv1[it] = __uint_as_float(__float_as_uint(wl[1024 + it * 64 + lane]) & ~0x7Fu); }
    float cs[64];
#pragma unroll
    for (int c = 0; c < 64; ++c) cs[c] = c < 50 ? __uint_as_float((__float_as_uint(tv0[CAND_A[c < 50 ? c : 0]] + tv1[CAND_B[c < 50 ? c : 0]]) & ~0xFFu) | (unsigned)(CAND_A[c < 50 ? c : 0] * 16 + CAND_B[c < 50 ? c : 0])) : NEG;
    top16_of_64(cs);
    float gv[16]; int ge[16];
#pragma unroll
    for (int it = 0; it < 16; ++it) {
        const unsigned w = __float_as_uint(cs[it]); const int a = (w >> 4) & 15, b = w & 15;
        gv[it] = __uint_as_float(w & ~0xFFu);
        ge[it] = (int)(__float_as_uint(wl[a * 64 + lane]) & 0x7Fu) * 128 + (int)(__float_as_uint(wl[1024 + b * 64 + lane]) & 0x7Fu);
    }
    float sum = 0.f; const float gmax = gv[0];
#pragma unroll
    for (int it = 0; it < 16; ++it) { gv[it] = __expf(gv[it] - gmax); sum += gv[it]; }
    const float inv = 1.f / sum;
    if (hi == 0) {
        int* io = (int*)(p.ws + OFF_IDX) + (size_t)t * 128 + head * 16; float* go = (float*)(p.ws + OFF_GATES) + (size_t)t * 128 + head * 16;
#pragma unroll
        for (int q = 0; q < 4; ++q) {
            *(int4*)(io + 4 * q) = make_int4(ge[4 * q], ge[4 * q + 1], ge[4 * q + 2], ge[4 * q + 3]);
            *(f32x4*)(go + 4 * q) = (f32x4){gv[4 * q] * inv, gv[4 * q + 1] * inv, gv[4 * q + 2] * inv, gv[4 * q + 3] * inv};
        }
    }
    __builtin_amdgcn_wave_barrier(); asm volatile("s_waitcnt lgkmcnt(0)" ::: "memory");
}
__device__ __forceinline__ void p10_route(const Params& p, unsigned char* lds) {
    const int lane = otid() & 63, wid = otid() >> 6, gw = blockIdx.x * 8 + wid, nw = gridDim.x * 8;
    float* wl = (float*)lds + wid * 2048;
    unsigned char* ksh = lds + 65536;
    __syncthreads();
    for (int c = otid(); c < 2 * 128 * 16; c += NTHREADS) { const int tb = c >> 11, row = (c >> 4) & 127, ch = c & 15;
        *(u32x4*)(ksh + tb * 34816 + row * 272 + ch * 16) = *(const u32x4*)((const bf16_t*)(p.ws + (tb ? OFF_SK2 : OFF_SK1)) + row * 128 + ch * 8); }
    __syncthreads();
    for (int task = gw; task < 512 * 8; task += nw) p10_task(p, task, lane, wl, ksh);
}
__device__ __forceinline__ void p9_query_route(const Params& p, unsigned char* lds, PG8_LAS unsigned char* ldsl) {
    p9_query(p, ldsl);
    asm volatile("s_waitcnt vmcnt(0)" ::: "memory");
    const int lane = otid() & 63, wid = otid() >> 6;
    float* wl = (float*)lds + wid * 2048;
    unsigned char* ksh = lds + 65536;
    __syncthreads();
    for (int c = otid(); c < 2 * 128 * 16; c += NTHREADS) { const int tb = c >> 11, row = (c >> 4) & 127, ch = c & 15;
        *(u32x4*)(ksh + tb * 34816 + row * 272 + ch * 16) = *(const u32x4*)((const bf16_t*)(p.ws + (tb ? OFF_SK2 : OFF_SK1)) + row * 128 + ch * 8); }
    __syncthreads();
    pg8::StaticOrder S; S.init(T_TOK, 2048, gridDim.x, blockIdx.x);
#pragma unroll 1
    for (int r = 0; r < 2; ++r) {
        pg8::Unit u;
        if (!S.next(r, u)) break;
        int pm = u.pm, pn = u.pn; asm volatile("" : "+s"(pm), "+s"(pn));
        p10_task(p, (pm * 8 + wid) * 8 + pn, lane, wl, ksh);
    }
}
__device__ __forceinline__ float gelu_tanh(float x) { const float u = 0.7978845608028654f * (x + 0.044715f * x * x * x); return 0.5f * x * (1.f + tanhf_(u)); }
__device__ __forceinline__ float dot16_fp8(const f32x2 (&hv)[8], u32x4 d) {
    f32x2 s = {0.f, 0.f};
#pragma unroll
    for (int i = 0; i < 4; ++i) {
        const f32x2 a = __builtin_amdgcn_cvt_pk_f32_fp8((int)d[i], false), b = __builtin_amdgcn_cvt_pk_f32_fp8((int)d[i], true);
        s += hv[2 * i] * a; s += hv[2 * i + 1] * b;
    }
    return s.x + s.y;
}
__device__ __forceinline__ void axpy16_fp8(f32x2 (&acc)[8], float a, u32x4 u) {
    const f32x2 a2 = {a, a};
#pragma unroll
    for (int i = 0; i < 4; ++i) {
        const f32x2 x = __builtin_amdgcn_cvt_pk_f32_fp8((int)u[i], false), y = __builtin_amdgcn_cvt_pk_f32_fp8((int)u[i], true);
        acc[2 * i] += a2 * x; acc[2 * i + 1] += a2 * y;
    }
}
__device__ __forceinline__ float gelu_fast(float x) {
    const float u2 = 1.5957691216057308f * (x + 0.044715f * x * x * x);
    return x * __builtin_amdgcn_rcpf(1.f + __expf(-u2));
}
typedef long i64_t;
typedef short s16x4_t __attribute__((ext_vector_type(4)));
typedef int i32x8_t __attribute__((ext_vector_type(8)));
#define MFMA128_F8F4(a, b, c) __builtin_amdgcn_mfma_scale_f32_16x16x128_f8f6f4((a), (b), (c), 0, 4, 0, 0, 0, 0)
constexpr int P11_TPW = 4;
#ifndef P11_NB1
#define P11_NB1 32
#define P11_NB2 16
#endif
#ifndef P11_EMASK
#define P11_EMASK 0x3FFFu
#endif
constexpr int P11_RING = 0, P11_H8 = 0, P11_H8P = 1040, P11_REC = 16384, P11_DOT = 18432, P11_WAVE = 19456;
static_assert(P11_WAVE * 8 <= LDS_MAIN, "P11 LDS");
__device__ __forceinline__ float clamp440(float x) { return fminf(fmaxf(x, -440.f), 440.f); }
__device__ __forceinline__ void p11_gather(const Params& p, unsigned char* lds, PG8_LAS unsigned char* ldsl) {
    const int lane = otid() & 63, wid = otid() >> 6, gw = blockIdx.x * 8 + wid, nw = gridDim.x * 8;
    const int n16 = lane & 15, g4 = lane >> 4;
    const unsigned char* ED = p.ws + OFF_E8D; const unsigned char* EUb = p.ws + OFF_E8U; const float* ESC = (const float*)(p.ws + OFF_ESC);
    unsigned char* wb = lds + wid * P11_WAVE;
    unsigned* recs = (unsigned*)(wb + P11_REC); bf16_t* dots = (bf16_t*)(wb + P11_DOT);
    PG8_LAS unsigned char* ringl = ldsl + __builtin_amdgcn_readfirstlane(wid * P11_WAVE + P11_RING);
    const unsigned char* ringg = wb + P11_RING;
    const unsigned long long lt = (1ull << lane) - 1ull;
#define P11_ISSUE(TAB, ea, OFFB, bufo) { _Pragma("unroll") for (int i_ = 0; i_ < 4; ++i_) \
        __builtin_amdgcn_global_load_lds((const unsigned*)((TAB) + (size_t)ea[i_] + (OFFB)), (PG8_LAS unsigned*)(ringl + (bufo) + i_ * 1024), 16, 0, 0); }
#define P11_NEXTBUF(bufo) { bufo = (bufo + 4096) & 16383; }
    __syncthreads();
    for (int t0 = gw * P11_TPW; t0 < T_TOK; t0 += nw * P11_TPW) {
        {
            unsigned ev[8], rk[8];
#pragma unroll
            for (int k = 0; k < 4; ++k) { const int* ip = (const int*)(p.ws + OFF_IDX) + (size_t)(t0 + k) * 128; ev[2 * k] = (unsigned)ip[lane]; ev[2 * k + 1] = (unsigned)ip[64 + lane]; }
#pragma unroll
            for (int j = 0; j < 8; ++j) rk[j] = 0;
            unsigned base = 0;
#pragma unroll 1
            for (unsigned bk = 0; bk < 16; ++bk) {
#pragma unroll
                for (int j = 0; j < 8; ++j) {
                    const bool hit = (ev[j] >> 10) == bk;
                    const unsigned long long m = __ballot(hit);
                    if (hit) rk[j] = base + __builtin_popcountll(m & lt);
                    base += __builtin_popcountll(m);
                }
            }
#pragma unroll
            for (int j = 0; j < 8; ++j) recs[rk[j]] = ev[j] | ((unsigned)(j >> 1) << 14) | ((unsigned)((j & 1) * 64 + lane) << 16);
        }
#pragma unroll
        for (int k = 0; k < 4; ++k) {
            const bf16_t* hrow = (const bf16_t*)(p.ws + OFF_H) + (size_t)(t0 + k) * 1024 + lane * 16;
            const u32x4 h0 = *(const u32x4*)(hrow), h1 = *(const u32x4*)(hrow + 8);
            u32x4 whi, wlo;
#pragma unroll
            for (int i = 0; i < 4; ++i) {
                const unsigned wa = i < 2 ? h0[2 * i] : h1[2 * i - 4], wb2 = i < 2 ? h0[2 * i + 1] : h1[2 * i - 3];
                const float x0 = clamp440(lo_f(wa) * 8.f), x1 = clamp440(hi_f(wa) * 8.f), x2 = clamp440(lo_f(wb2) * 8.f), x3 = clamp440(hi_f(wb2) * 8.f);
                int t = 0; t = __builtin_amdgcn_cvt_pk_fp8_f32(x0, x1, t, false); t = __builtin_amdgcn_cvt_pk_fp8_f32(x2, x3, t, true);
                const f32x2 d01 = __builtin_amdgcn_cvt_pk_f32_fp8(t, false), d23 = __builtin_amdgcn_cvt_pk_f32_fp8(t, true);
                int u = 0; u = __builtin_amdgcn_cvt_pk_fp8_f32((x0 - d01.x) * 16.f, (x1 - d01.y) * 16.f, u, false); u = __builtin_amdgcn_cvt_pk_fp8_f32((x2 - d23.x) * 16.f, (x3 - d23.y) * 16.f, u, true);
                whi[i] = (unsigned)t; wlo[i] = (unsigned)u;
            }
            *(u32x4*)(wb + P11_H8 + (2 * k) * P11_H8P + lane * 16) = whi; *(u32x4*)(wb + P11_H8 + (2 * k + 1) * P11_H8P + lane * 16) = wlo;
        }
        __builtin_amdgcn_wave_barrier(); asm volatile("s_waitcnt lgkmcnt(0)" ::: "memory");
        u32x4 hf[16];
#pragma unroll
        for (int c = 0; c < 16; ++c) hf[c] = *(const u32x4*)(wb + P11_H8 + (lane & 7) * P11_H8P + c * 64 + g4 * 16);
        {
            const unsigned rotn = (((unsigned)n16 << 1) | ((unsigned)n16 >> 3)) & 15u;
            const unsigned rd0 = (unsigned)n16 * 256u + ((((unsigned)g4) ^ rotn) << 4);
            const unsigned xg = ((unsigned)lane & 15u) ^ (2u * (unsigned)g4);
            const unsigned goff0 = (xg ^ 0u) << 4, goff1 = (xg ^ 8u) << 4, goff2 = (xg ^ 1u) << 4, goff3 = (xg ^ 9u) << 4;
#define P11_EA1(dst, bb) { dst[0] = ((recs[(bb) * 16 + 0 + g4] & P11_EMASK) << 9) + goff0; dst[1] = ((recs[(bb) * 16 + 4 + g4] & P11_EMASK) << 9) + goff1; \
                           dst[2] = ((recs[(bb) * 16 + 8 + g4] & P11_EMASK) << 9) + goff2; dst[3] = ((recs[(bb) * 16 + 12 + g4] & P11_EMASK) << 9) + goff3; }
#define P11_RD1(F) { _Pragma("unroll") for (int c4 = 0; c4 < 4; ++c4) F[c4] = *(const u32x4*)(ringg + bufo + (rd0 ^ (unsigned)(c4 << 6))); }
#define P11_T1(Q, eaI, QI, FC, FN) { asm volatile("s_waitcnt lgkmcnt(0)" : "+v"(FC[0]), "+v"(FC[1]), "+v"(FC[2]), "+v"(FC[3]) :: "memory"); \
                P11_ISSUE(ED, eaI, 256 * (QI), bufo); P11_NEXTBUF(bufo); \
                asm volatile("s_waitcnt vmcnt(12)" ::: "memory"); P11_RD1(FN); \
                _Pragma("unroll") for (int c4 = 0; c4 < 4; ++c4) { const int S_ = 4 * (Q) + c4; \
                    const i32x8_t A_ = {(int)hf[2 * S_][0], (int)hf[2 * S_][1], (int)hf[2 * S_][2], (int)hf[2 * S_][3], (int)hf[2 * S_ + 1][0], (int)hf[2 * S_ + 1][1], (int)hf[2 * S_ + 1][2], (int)hf[2 * S_ + 1][3]}; \
                    const i32x8_t B_ = {(int)FC[c4][0], (int)FC[c4][1], (int)FC[c4][2], (int)FC[c4][3], 0, 0, 0, 0}; \
                    if (c4 & 1) a1 = MFMA128_F8F4(A_, B_, a1); else a0 = MFMA128_F8F4(A_, B_, a0); } \
                asm volatile("s_nop 7" : "+v"(a0), "+v"(a1) : "v"(FC[0]), "v"(FC[1]), "v"(FC[2]), "v"(FC[3])); }
            unsigned ea0[4], ea1[4], ea2[4];
            P11_EA1(ea0, 0); P11_EA1(ea1, 1);
            int bufo = 0;
            asm volatile("s_waitcnt lgkmcnt(0)" ::: "memory");
            P11_ISSUE(ED, ea0, 0, 0); P11_ISSUE(ED, ea0, 256, 4096); P11_ISSUE(ED, ea1, 0, 8192); P11_ISSUE(ED, ea1, 256, 12288);
            u32x4 fA[4], fB[4];
            asm volatile("s_waitcnt vmcnt(12)" ::: "memory"); P11_RD1(fA);
#pragma unroll 1
            for (int b = 0; b < P11_NB1; ++b) {
                const unsigned rec = recs[b * 16 + n16];
                const int b2 = b < 30 ? b + 2 : 31;
                P11_EA1(ea2, b2);
                f32x4 a0 = {0.f, 0.f, 0.f, 0.f}, a1 = {0.f, 0.f, 0.f, 0.f};
                asm volatile("" : "+v"(a0), "+v"(a1));
                P11_T1(0, ea2, 0, fA, fB) P11_T1(1, ea2, 1, fB, fA)
                const f32x4 cs = a0 + a1;
                const unsigned tl = (rec >> 14) & 3u;
                const float val = (tl & 1u) ? (cs[2] + cs[3] * 0.0625f) : (cs[0] + cs[1] * 0.0625f);
                if ((unsigned)g4 == (tl >> 1)) dots[b * 16 + n16] = f2bf(val * 0.125f);
            }
            asm volatile("s_waitcnt vmcnt(0)" ::: "memory");
        }
        __builtin_amdgcn_wave_barrier(); asm volatile("s_waitcnt lgkmcnt(0)" ::: "memory");
        float inv_s;
        {
            float av[8]; unsigned rc[8]; float am = 0.f;
#pragma unroll
            for (int i = 0; i < 8; ++i) {
                const unsigned rec = recs[i * 64 + lane]; const float d = bf2f(dots[i * 64 + lane]);
                const unsigned e = rec & 0x3FFFu, tl = (rec >> 14) & 3u, slot = (rec >> 16) & 127u;
                const float gt = ((const float*)(p.ws + OFF_GATES))[(size_t)(t0 + tl) * 128 + slot];
                av[i] = gelu_fast(d * ESC[e]) * gt * ESC[16384 + e]; rc[i] = rec & 0xFFFFu; am = fmaxf(am, fabsf(av[i]));
            }
#pragma unroll
            for (int o = 32; o; o >>= 1) am = fmaxf(am, __shfl_xor(am, o));
            const float sc = __uint_as_float(__float_as_uint(240.f / fmaxf(am, 1e-30f)) & 0x7f800000u);
            inv_s = 1.f / sc;
#pragma unroll
            for (int i = 0; i < 8; ++i) {
                const int th = __builtin_amdgcn_cvt_pk_fp8_f32(av[i] * sc, 0.f, 0, false);
                recs[i * 64 + lane] = rc[i] | (((unsigned)th & 0xFFu) << 16);
            }
        }
        __builtin_amdgcn_wave_barrier(); asm volatile("s_waitcnt lgkmcnt(0)" ::: "memory");
        {
            const unsigned pc = (unsigned)lane & 7u, q8 = (unsigned)lane >> 3;
            const unsigned goff0 = (pc ^ (q8 & 2u)) << 4, goff1 = (pc ^ (q8 & 2u) ^ 4u) << 4;
            const unsigned r4 = (unsigned)n16 >> 2, c4l = (unsigned)n16 & 3u;
            const unsigned fsw = (r4 & 2u) | (((unsigned)g4 & 1u) << 2);
            const unsigned tr0 = (8u * (unsigned)g4 + r4) * 128u + 8u * (c4l & 1u) + (((c4l >> 1) ^ fsw) << 4);
            const unsigned tlm = (unsigned)n16 >> 2, dsm = (unsigned)n16 & 3u;
            const unsigned trb = (unsigned)(size_t)ringl;
            const unsigned selA = 0x0c0c0c0cu ^ (0x0eu << (8u * dsm));
            f32x4 acc[16];
#pragma unroll
            for (int i = 0; i < 16; ++i) acc[i] = (f32x4){0.f, 0.f, 0.f, 0.f};
#define P11_EA2(dst, bb) { dst[0] = ((recs[(bb) * 32 + 0 + q8] & P11_EMASK) << 9) + goff0; dst[1] = ((recs[(bb) * 32 + 8 + q8] & P11_EMASK) << 9) + goff1; \
                           dst[2] = ((recs[(bb) * 32 + 16 + q8] & P11_EMASK) << 9) + goff0; dst[3] = ((recs[(bb) * 32 + 24 + q8] & P11_EMASK) << 9) + goff1; }
#define P11_RD2(F) { _Pragma("unroll") for (int nt = 0; nt < 4; ++nt) { const unsigned ta_ = trb + (unsigned)bufo + (tr0 ^ (unsigned)(nt << 5)); \
                    asm volatile("ds_read_b64_tr_b16 %0, %1" : "=v"(F[nt][0]) : "v"(ta_) : "memory"); \
                    asm volatile("ds_read_b64_tr_b16 %0, %1 offset:512" : "=v"(F[nt][1]) : "v"(ta_) : "memory"); } }
#define P11_T2(Q, eaI, QI, FC, FN) { \
                asm volatile("s_waitcnt lgkmcnt(0)" : "+v"(FC[0][0]), "+v"(FC[0][1]), "+v"(FC[1][0]), "+v"(FC[1][1]), "+v"(FC[2][0]), "+v"(FC[2][1]), "+v"(FC[3][0]), "+v"(FC[3][1]) :: "memory"); \
                P11_ISSUE(EUb, eaI, 128 * (QI), bufo); P11_NEXTBUF(bufo); \
                asm volatile("s_waitcnt vmcnt(12)" ::: "memory"); P11_RD2(FN); \
                _Pragma("unroll") for (int nt = 0; nt < 4; ++nt) { \
                    const i32x8_t B_ = {(int)(unsigned)FC[nt][0], (int)(unsigned)((unsigned long long)FC[nt][0] >> 32), (int)(unsigned)FC[nt][1], (int)(unsigned)((unsigned long long)FC[nt][1] >> 32), 0, 0, 0, 0}; \
                    acc[4 * (Q) + nt] = MFMA128_F8F4(Aop, B_, acc[4 * (Q) + nt]); } \
                asm volatile("s_nop 7" : "+v"(acc[4 * (Q)]), "+v"(acc[4 * (Q) + 1]), "+v"(acc[4 * (Q) + 2]), "+v"(acc[4 * (Q) + 3]) \
                             : "v"(FC[0][0]), "v"(FC[0][1]), "v"(FC[1][0]), "v"(FC[1][1]), "v"(FC[2][0]), "v"(FC[2][1]), "v"(FC[3][0]), "v"(FC[3][1]), "v"(Aop)); }
            unsigned eaC[4], eaN[4];
            P11_EA2(eaC, 0);
            int bufo = 0;
            asm volatile("s_waitcnt lgkmcnt(0)" ::: "memory");
            P11_ISSUE(EUb, eaC, 0, 0); P11_ISSUE(EUb, eaC, 128, 4096); P11_ISSUE(EUb, eaC, 256, 8192); P11_ISSUE(EUb, eaC, 384, 12288);
            i64_t gA[4][2], gB[4][2];
            asm volatile("s_waitcnt vmcnt(12)" ::: "memory"); P11_RD2(gA);
#pragma unroll 1
            for (int b = 0; b < P11_NB2; ++b) {
                const u32x4 Ra = *(const u32x4*)(recs + b * 32 + 4 * g4), Rb = *(const u32x4*)(recs + b * 32 + 16 + 4 * g4);
                const int bn = b < 15 ? b + 1 : 15;
                P11_EA2(eaN, bn);
                i32x8_t Aop;
#pragma unroll
                for (int w = 0; w < 8; ++w) { const unsigned R = w < 4 ? Ra[w] : Rb[w - 4]; Aop[w] = (((R >> 14) & 3u) == tlm) ? (int)__builtin_amdgcn_perm(0u, R, selA) : 0; }
                P11_T2(0, eaN, 0, gA, gB) P11_T2(1, eaN, 1, gB, gA) P11_T2(2, eaN, 2, gA, gB) P11_T2(3, eaN, 3, gB, gA)
            }
            asm volatile("s_waitcnt vmcnt(0) lgkmcnt(0)" : "+v"(gA[0][0]), "+v"(gA[0][1]), "+v"(gA[1][0]), "+v"(gA[1][1]), "+v"(gA[2][0]), "+v"(gA[2][1]), "+v"(gA[3][0]), "+v"(gA[3][1]) :: "memory");
            const int t = t0 + g4, bb = t >> 12;
            const float* gt2 = (const float*)(p.ws + OFF_MOD) + bb * 6144 + 5120 + 4 * n16;
            const bf16_t* x1 = (const bf16_t*)(p.ws + OFF_X1) + (size_t)t * 1024 + 4 * n16; float* o = p.out + (size_t)t * 1024 + 4 * n16;
            const float k0 = inv_s * DBG_FFN;
#pragma unroll
            for (int h = 0; h < 2; ++h) {
                u32x2 xr[8]; f32x4 gv[8];
#pragma unroll
                for (int i = 0; i < 8; ++i) { xr[i] = *(const u32x2*)(x1 + 64 * (8 * h + i)); gv[i] = *(const f32x4*)(gt2 + 64 * (8 * h + i)); }
#pragma unroll
                for (int i = 0; i < 8; ++i) *(f32x4*)(o + 64 * (8 * h + i)) = bf4(xr[i]) + gv[i] * (acc[8 * h + i] * k0);
            }
        }
    }
}

__global__ void __launch_bounds__(NTHREADS) mega(Params p) {
    __shared__ __attribute__((aligned(16))) unsigned char lds[LDS_MAIN + 16];
    PG8_LAS unsigned char* ldsl = (PG8_LAS unsigned char*)&lds[0];
    cg::grid_group grid = cg::this_grid();
    if (threadIdx.x == 0) *(uint4*)(&lds[LDS_MAIN]) = make_uint4(0u, 0u, 0u, 0u);
    __syncthreads();
    const XcdBarrier xb = xcd_barrier_post((unsigned*)(p.ws + OFF_BAR), (volatile LAS unsigned*)(&lds[LDS_MAIN]));
#ifdef PROBE
    int phase_no_ = 0;
#define TSTAMP() { if (blockIdx.x == 0 && threadIdx.x == 0) ((unsigned long long*)(p.ws + OFF_CTR + 2048))[phase_no_] = __builtin_amdgcn_s_memrealtime(); ++phase_no_; }
    TSTAMP()
#define PHASE(BODY) { BODY; xcd_barrier(xb); TSTAMP() }
#else
#define PHASE(BODY) { BODY; xcd_barrier(xb); }
#endif
    p0_prep(p, lds); xcd_barrier(xb);
    if (p.pad0 != 0) grid.sync();
#ifdef PROBE
    TSTAMP()
#endif
    PHASE((modnorm_phase<true>(p, p.in[0], p.in[5], 0, (bf16_t*)((unsigned char*)p.out + DO_H), lds), p1_finalize_mod(p)))
    PHASE(p2_proj(p, ldsl, lds))
#if defined(CHUNKED) && !defined(SCAN_VERIFY)
    PHASE((p3_small(p, lds), p5_stageA_local(p, lds, xb)))
#else
    PHASE(p3_small(p, lds))
#endif
#if defined(SCAN_VERIFY)
    PHASE(p4_rwkv_prep(p))
    PHASE(if (blockIdx.x < 128) scan_task(p, blockIdx.x, lds))
    PHASE(p3_small(p, lds, true))
    PHASE(p4_rwkv_prep_chunked(p))
    PHASE(p5_stageA(p, lds))
    PHASE(p5_stageB(p))
    PHASE(p5_stageC(p, lds))
#ifdef VTEST_NAIVE
    PHASE({ const int gw_ = blockIdx.x * 8 + (otid() >> 6); if (gw_ < 32) scan_naive0(p, gw_, otid() & 63); })
#endif
    PHASE(scan_compare(p))
    { const float* cc = (const float*)(p.ws + OFF_CTR); const float rel = sqrtf(cc[8] / fmaxf(cc[9], 1e-30f));
      for (int i = blockIdx.x * NTHREADS + threadIdx.x; i < T_TOK * DM; i += gridDim.x * NTHREADS) p.out[i] = p.in[0][i] + (i == 0 ? ((rel == rel) ? 100.f * (log10f(fminf(fmaxf(rel, 1e-6f), 1e12f)) + 6.f) : 5000.f + 100.f * (float)(((const unsigned*)cc)[10] & 31u)) : 0.f); }
    return;
#elif defined(CHUNKED)
    PHASE(p5_attn_scan(p, lds))
    PHASE(p5_stageC(p, lds))
#else
    PHASE(p4_rwkv_prep(p))
    PHASE(p5_attn_scan(p, lds))
    PHASE(p5b_scan_epilogue(p))
#endif
    PHASE(p6_merge(p, ldsl))
    PHASE(p7_mix(p, ldsl))
    PHASE((modnorm_phase<false>(p, (const float*)(p.ws + OFF_X1), p.in[27], 3072, (bf16_t*)(p.ws + OFF_H), lds), p8_cvt_experts(p)))
#ifdef EMPTY_PHASES
    PHASE({}) PHASE({}) PHASE({}) PHASE({}) PHASE({}) PHASE({}) PHASE({}) PHASE({}) PHASE({}) PHASE({})
#endif
    PHASE(p9_query_route(p, lds, ldsl))
    p11_gather(p, lds, ldsl);
#ifdef PROBE
    grid.sync(); TSTAMP()
    if (blockIdx.x == 0 && threadIdx.x == 0) { const unsigned long long* tsp = (const unsigned long long*)(p.ws + OFF_CTR + 2048); p.out[0] += (float)(tsp[PROBE + 1] - tsp[PROBE]) * 0.0001f; }
#endif
}

extern "C" void kernel_launch(void* const* d_in, const int* in_sizes, int n_in,
                              void* d_out, int out_size, void* d_ws, size_t ws_size,
                              hipStream_t stream) {
    static int grid_blocks = 0;
    if (!grid_blocks) {
        int dev = 0, cus = 0, per_cu = 0;
        (void)hipGetDevice(&dev);
        (void)hipDeviceGetAttribute(&cus, hipDeviceAttributeMultiprocessorCount, dev);
        (void)hipOccupancyMaxActiveBlocksPerMultiprocessor(&per_cu, mega, NTHREADS, 0);
        if (per_cu > 1) per_cu = 1;
        grid_blocks = cus * per_cu;
    }
    Params p{};
    for (int i = 0; i < 33; ++i) p.in[i] = (const float*)d_in[i];
    p.out = (float*)d_out; p.ws = (unsigned char*)d_ws; p.pad0 = 0; p.pad1 = 0;
    (void)hipMemsetAsync((unsigned char*)d_ws + OFF_BAR, 0, 16384, stream);
    void* args[] = {&p};
    hipError_t e = hipLaunchCooperativeKernel((void*)mega, dim3(grid_blocks), dim3(NTHREADS), args, 0, stream);
    if (e != hipSuccess) fprintf(stderr, "cooperative launch failed: %s (grid %d)\n", hipGetErrorString(e), grid_blocks);
}
```
